# Optimizing an MI355X kernel written in HIP

```python
import jax, jax.numpy as jnp
from jax import lax
import numpy as np

D_MODEL = 2048
BATCH = 32
SEQ = 256
DEPTH = 4
DEC_BATCH = 4
DEC_SEQ = 2048
PAST_LEN = 512

GRID_W = 64
N_MIXERS = 3
N_CONV_LAYERS = (DEPTH + 2) // 3
N_GMLP_LAYERS = (DEPTH + 1) // 3
N_MLA_LAYERS = DEPTH // 3
CONV_WIDTH = 3
CHUNK = 128
GMLP_WIDTH = D_MODEL
GMLP_GROUPS = 16
GMLP_GROUP_DIM = GMLP_WIDTH // GMLP_GROUPS
N_HEADS = 16
QK_NOPE = 128
QK_ROPE = 64
V_DIM = 128
Q_RANK = 512
KV_RANK = 512
ROPE_THETA = 10000.0
D_FF = 4 * D_MODEL
N_MOD = 6
EPS = 1e-6
Q_BLOCK = 128

kernel_name = 'hybrid_dit_conv_gmlp_mla_step'


def rms_norm(x, g):
    x32 = x.astype(jnp.float32)
    y = x32 * lax.rsqrt(jnp.mean(x32 * x32, axis=-1, keepdims=True) + EPS)
    return (y * g.astype(jnp.float32)).astype(x.dtype)


def modulate(h, shift, scale):
    return h * (1 + scale) + shift


def short_conv_mixer(h, w_in, w_conv, w_out):
    L = h.shape[1]
    bg, cg, hv = jnp.split(h @ w_in, 3, axis=-1)
    pad = CONV_WIDTH // 2
    zp = jnp.pad(cg * hv, ((0, 0), (pad, CONV_WIDTH - 1 - pad), (0, 0)))
    conv = sum(zp[:, k:k + L] * w_conv[k] for k in range(CONV_WIDTH))
    return (bg * conv) @ w_out


def chunk_gmlp_mixer(h, w_in, g_v, w_s, b_s, w_out):
    Bn, L, _ = h.shape
    u, v = jnp.split(h @ w_in, 2, axis=-1)
    v = rms_norm(v, g_v).reshape(Bn, L // CHUNK, CHUNK, GMLP_GROUPS, GMLP_GROUP_DIM)
    v = jnp.einsum('gpq,bnqgd->bnpgd', w_s, v) + b_s.T[:, :, None]
    return (u * v.reshape(Bn, L, GMLP_WIDTH)) @ w_out


def rope_tables(L):
    n_rows = L // GRID_W
    rows = jnp.broadcast_to(jnp.arange(n_rows)[:, None], (n_rows, GRID_W)).reshape(-1)
    cols = jnp.broadcast_to(jnp.arange(GRID_W)[None, :], (n_rows, GRID_W)).reshape(-1)
    nf = QK_ROPE // 4
    inv = 1.0 / (ROPE_THETA ** (jnp.arange(nf, dtype=jnp.float32) / nf))
    ang_r = rows.astype(jnp.float32)[:, None] * inv
    ang_c = cols.astype(jnp.float32)[:, None] * inv
    return (jnp.cos(ang_r), jnp.sin(ang_r), jnp.cos(ang_c), jnp.sin(ang_c))


def rotate(x, cos, sin):
    x1, x2 = jnp.split(x, 2, axis=-1)
    return jnp.concatenate([x1 * cos - x2 * sin, x1 * sin + x2 * cos], axis=-1)


def apply_rope_2d(x, tables):
    cr, sr, cc, sc = [t.reshape((t.shape[0],) + (1,) * (x.ndim - 3) + (t.shape[1],)).astype(x.dtype) for t in tables]
    xr, xc = jnp.split(x, 2, axis=-1)
    return jnp.concatenate([rotate(xr, cr, sr), rotate(xc, cc, sc)], axis=-1)


def mla_project(h, w_q_a, g_q, w_q_b, w_kv_a, g_kv):
    Bn, L, _ = h.shape
    q = (rms_norm(h @ w_q_a, g_q) @ w_q_b).reshape(Bn, L, N_HEADS, QK_NOPE + QK_ROPE)
    kv = h @ w_kv_a
    ckv = rms_norm(kv[..., :KV_RANK], g_kv)
    kpe = kv[..., KV_RANK:]
    return q[..., :QK_NOPE], q[..., QK_NOPE:], ckv, kpe


def mla_attend(q_nope, q_pe, ckv, kpe, w_kv_b, w_o):
    Bn, Lq = q_nope.shape[:2]
    Lk = ckv.shape[1]
    kv = (ckv @ w_kv_b).reshape(Bn, Lk, N_HEADS, QK_NOPE + V_DIM)
    k_nope, v = kv[..., :QK_NOPE], kv[..., QK_NOPE:]
    nb = Lq // Q_BLOCK
    scale = (QK_NOPE + QK_ROPE) ** -0.5

    def to_blocks(t):
        return jnp.moveaxis(t.reshape((Bn, nb, Q_BLOCK) + t.shape[2:]), 1, 0)

    def block(args):
        qn, qp = args
        s = jnp.einsum('bqhd,bkhd->bhqk', qn, k_nope) + jnp.einsum('bqhr,bkr->bhqk', qp, kpe)
        p = jax.nn.softmax(s.astype(jnp.float32) * scale, axis=-1).astype(v.dtype)
        return jnp.einsum('bhqk,bkhd->bqhd', p, v)

    o = lax.map(block, (to_blocks(q_nope), to_blocks(q_pe)))
    o = jnp.moveaxis(o, 0, 1).reshape(Bn, Lq, N_HEADS * V_DIM)
    return o @ w_o


def sq_relu_mlp(h, w1, w2):
    return jnp.square(jax.nn.relu(h @ w1)) @ w2


def setup_inputs(seed: int = 0) -> dict:
    key = jax.random.key(seed)
    ks = iter(jax.random.split(key, 32))

    def nrm(shape, scale=1.0):
        return jax.random.normal(next(ks), shape, jnp.float32) * scale

    D = D_MODEL
    return {
        'x_prompt': nrm((BATCH, SEQ, D)),
        'x_sample': nrm((DEC_BATCH, DEC_SEQ, D)),
        'cache_ckv': nrm((DEC_BATCH, N_MLA_LAYERS, PAST_LEN, KV_RANK)),
        'cache_kpe': nrm((DEC_BATCH, N_MLA_LAYERS, PAST_LEN, QK_ROPE)),
        'c': nrm((DEC_BATCH, D)),
        'c_ctx': nrm((D,)),
        'ada_w': nrm((DEPTH, D, N_MOD * D), 0.5 * D ** -0.5),
        'ada_b': nrm((DEPTH, N_MOD * D), 0.02),
        'norm1': 1.0 + nrm((DEPTH, D), 0.02),
        'norm2': 1.0 + nrm((DEPTH, D), 0.02),
        'conv_w_in': nrm((N_CONV_LAYERS, D, 3 * D), D ** -0.5),
        'conv_w': nrm((N_CONV_LAYERS, CONV_WIDTH, D), 0.5),
        'conv_w_out': nrm((N_CONV_LAYERS, D, D), D ** -0.5),
        'gmlp_w_in': nrm((N_GMLP_LAYERS, D, 2 * GMLP_WIDTH), D ** -0.5),
        'gmlp_g_v': 1.0 + nrm((N_GMLP_LAYERS, GMLP_WIDTH), 0.02),
        'gmlp_w_s': nrm((N_GMLP_LAYERS, GMLP_GROUPS, CHUNK, CHUNK), CHUNK ** -0.5),
        'gmlp_b_s': 1.0 + nrm((N_GMLP_LAYERS, GMLP_GROUPS, CHUNK), 0.1),
        'gmlp_w_out': nrm((N_GMLP_LAYERS, GMLP_WIDTH, D), GMLP_WIDTH ** -0.5),
        'mla_w_q_a': nrm((N_MLA_LAYERS, D, Q_RANK), D ** -0.5),
        'mla_g_q': 1.0 + nrm((N_MLA_LAYERS, Q_RANK), 0.02),
        'mla_w_q_b': nrm((N_MLA_LAYERS, Q_RANK, N_HEADS * (QK_NOPE + QK_ROPE)), Q_RANK ** -0.5),
        'mla_w_kv_a': nrm((N_MLA_LAYERS, D, KV_RANK + QK_ROPE), D ** -0.5),
        'mla_g_kv': 1.0 + nrm((N_MLA_LAYERS, KV_RANK), 0.02),
        'mla_w_kv_b': nrm((N_MLA_LAYERS, KV_RANK, N_HEADS * (QK_NOPE + V_DIM)), KV_RANK ** -0.5),
        'mla_w_o': nrm((N_MLA_LAYERS, N_HEADS * V_DIM, D), (N_HEADS * V_DIM) ** -0.5),
        'mlp_w1': nrm((DEPTH, D, D_FF), D ** -0.5),
        'mlp_w2': nrm((DEPTH, D_FF, D), 0.7 * D_FF ** -0.5),
        'final_norm': 1.0 + nrm((D,), 0.02),
    }


def reference(x_prompt, x_sample, cache_ckv, cache_kpe, c, c_ctx, ada_w, ada_b, norm1, norm2,
              conv_w_in, conv_w, conv_w_out, gmlp_w_in, gmlp_g_v, gmlp_w_s, gmlp_b_s, gmlp_w_out,
              mla_w_q_a, mla_g_q, mla_w_q_b, mla_w_kv_a, mla_g_kv, mla_w_kv_b, mla_w_o,
              mlp_w1, mlp_w2, final_norm):
    rope = rope_tables(x_sample.shape[1])
    xp, xs = x_prompt, x_sample
    new_ckv, new_kpe = [], []
    for i in range(DEPTH):
        mod_p = (jax.nn.silu(c_ctx) @ ada_w[i] + ada_b[i])[None, None, :]
        mod_s = (jax.nn.silu(c) @ ada_w[i] + ada_b[i])[:, None, :]
        sh1p, sc1p, g1p, sh2p, sc2p, g2p = jnp.split(mod_p, N_MOD, axis=-1)
        sh1s, sc1s, g1s, sh2s, sc2s, g2s = jnp.split(mod_s, N_MOD, axis=-1)
        hp = modulate(rms_norm(xp, norm1[i]), sh1p, sc1p)
        hs = modulate(rms_norm(xs, norm1[i]), sh1s, sc1s)
        kind, j = i % N_MIXERS, i // N_MIXERS
        if kind == 0:
            yp = short_conv_mixer(hp, conv_w_in[j], conv_w[j], conv_w_out[j])
            ys = short_conv_mixer(hs, conv_w_in[j], conv_w[j], conv_w_out[j])
        elif kind == 1:
            yp = chunk_gmlp_mixer(hp, gmlp_w_in[j], gmlp_g_v[j], gmlp_w_s[j], gmlp_b_s[j], gmlp_w_out[j])
            ys = chunk_gmlp_mixer(hs, gmlp_w_in[j], gmlp_g_v[j], gmlp_w_s[j], gmlp_b_s[j], gmlp_w_out[j])
        else:
            qn_p, qp_p, ckv_p, kpe_p = mla_project(hp, mla_w_q_a[j], mla_g_q[j], mla_w_q_b[j], mla_w_kv_a[j], mla_g_kv[j])
            yp = mla_attend(qn_p, qp_p, ckv_p, kpe_p, mla_w_kv_b[j], mla_w_o[j])
            new_ckv.append(ckv_p)
            new_kpe.append(kpe_p)
            qn_s, qp_s, ckv_s, kpe_s = mla_project(hs, mla_w_q_a[j], mla_g_q[j], mla_w_q_b[j], mla_w_kv_a[j], mla_g_kv[j])
            qp_s = apply_rope_2d(qp_s, rope)
            kpe_s = apply_rope_2d(kpe_s, rope)
            ckv_all = jnp.concatenate([cache_ckv[:, j], ckv_s], axis=1)
            kpe_all = jnp.concatenate([cache_kpe[:, j], kpe_s], axis=1)
            ys = mla_attend(qn_s, qp_s, ckv_all, kpe_all, mla_w_kv_b[j], mla_w_o[j])
        xp = xp + g1p * yp
        xs = xs + g1s * ys
        hp = modulate(rms_norm(xp, norm2[i]), sh2p, sc2p)
        hs = modulate(rms_norm(xs, norm2[i]), sh2s, sc2s)
        xp = xp + g2p * sq_relu_mlp(hp, mlp_w1[i], mlp_w2[i])
        xs = xs + g2s * sq_relu_mlp(hs, mlp_w1[i], mlp_w2[i])
    y_prompt = rms_norm(xp, final_norm)
    y_sample = rms_norm(xs, final_norm)
    return (y_prompt, y_sample, jnp.stack(new_ckv, axis=1), jnp.stack(new_kpe, axis=1))
```

```cpp
#include <hip/hip_runtime.h>
#include <cstdio>
#include <cstdint>
namespace pg8 {
#define PG8_LAS __attribute__((address_space(3)))
typedef unsigned short bf16_t;
typedef short bf16x8 __attribute__((ext_vector_type(8)));
typedef float f32x4 __attribute__((ext_vector_type(4)));
typedef unsigned u32x4 __attribute__((ext_vector_type(4)));
constexpr int BM = 256, BK = 64, HALF = 128, HTB = HALF * BK * 2  , STAGE_BYTES = 8 * HTB, NXCD = 8, WGM = 8;

__host__ __device__ __forceinline__ int lds_byte(int r, int c) { const int st = (r >> 4) * 2 + (c >> 5), rr = r & 15, cc = c & 31, ob = rr * 64 + cc * 2; return st * 1024 + (ob ^ (((ob >> 9) & 1) << 5)); }
__host__ __device__ __forceinline__ void stage_rc(int b, int& R, int& C) { const int st = b / 1024, sb = b % 1024, swz = sb ^ (((sb >> 9) & 1) << 5); R = (st >> 1) * 16 + swz / 64; C = (st & 1) * 32 + (swz % 64) / 2; }
__host__ __device__ __forceinline__ int perm32(int rho) { const int n = rho >> 4, i = rho & 15; return 8 * (i >> 2) + 4 * n + (i & 3); }

struct Unit { int pm, pn; };
struct Gemm { const bf16_t* A; const bf16_t* Bt; int M, N, K; };

struct StaticOrder {
    int nM, nN, nwg, G, c;
    __host__ __device__ void init(int M, int N, int G_, int c_) { nM = M / BM; nN = N / BM; nwg = nM * nN; G = G_; c = c_; }
    __host__ __device__ bool next(int i, Unit& u) const {
        const long L = (long)i * G + c; if (L >= nwg) return false;
        int wgid = (int)L; { const int q = nwg / NXCD, r = nwg % NXCD, xcd = wgid % NXCD, off = wgid / NXCD; wgid = (xcd < r ? xcd * (q + 1) : r * (q + 1) + (xcd - r) * q) + off; }
        const int nig = WGM * nN, gid = wgid / nig, fm = gid * WGM, gsz = (nM - fm) < WGM ? (nM - fm) : WGM;
        u.pm = fm + ((wgid % nig) % gsz); u.pn = (wgid % nig) / gsz; return true;
    }
    __device__ __forceinline__ void a_ready(const Unit&) const {}
    __device__ __forceinline__ void done(const Unit&) const {}
};
__device__ __forceinline__ unsigned cvt_pk_bf16(float lo, float hi) { unsigned r; asm volatile("v_cvt_pk_bf16_f32 %0, %1, %2" : "=v"(r) : "v"(lo), "v"(hi)); return r; }
__device__ __forceinline__ int cond_of_tile(int pm) { return pm < 32 ? 0 : 1 + ((pm - 32) >> 3); }

struct EpiBf16 {
    static constexpr bool PERM = true, AFTER_DRAIN = false;
    bf16_t* O; int ldc; int act;
    __device__ __forceinline__ void operator()(const f32x4 (&acc)[2][2][4][2], const Unit& u, int wr, int wc, int fr, int fq) const {
        const int row0 = u.pm * BM + wr * 64 + fr, col0 = u.pn * BM + wc * 32 + 8 * fq;
        const f32x4 z4 = (f32x4){0.f, 0.f, 0.f, 0.f};
#pragma unroll
        for (int ai = 0; ai < 2; ++ai)
#pragma unroll
            for (int m = 0; m < 4; ++m) { bf16_t* rowp = O + (size_t)(row0 + ai * HALF + m * 16) * ldc + col0;
#pragma unroll
                for (int bj = 0; bj < 2; ++bj) { f32x4 v0 = acc[ai][bj][m][0], v1 = acc[ai][bj][m][1];
                    if (act) { v0 = __builtin_elementwise_max(v0, z4); v1 = __builtin_elementwise_max(v1, z4); v0 = v0 * v0; v1 = v1 * v1; }
                    u32x4 w; w.x = cvt_pk_bf16(v0[0], v0[1]); w.y = cvt_pk_bf16(v0[2], v0[3]); w.z = cvt_pk_bf16(v1[0], v1[1]); w.w = cvt_pk_bf16(v1[2], v1[3]);
                    *(u32x4*)(rowp + bj * HALF) = w; } }
    }
};
struct EpiRes {
    static constexpr bool PERM = false, AFTER_DRAIN = false;
    float* X; const float* gate; int ldx; int gstride;
    __device__ __forceinline__ void operator()(const f32x4 (&acc)[2][2][4][2], const Unit& u, int wr, int wc, int fr, int fq) const {
        const float* g = gate + (size_t)cond_of_tile(u.pm) * gstride;
        const int row0 = u.pm * BM + wr * 64 + fr, col0 = u.pn * BM + wc * 32 + 4 * fq;
        f32x4 gv[2][2];
#pragma unroll
        for (int bj = 0; bj < 2; ++bj)
#pragma unroll
            for (int n = 0; n < 2; ++n) gv[bj][n] = *(const f32x4*)(g + col0 + bj * HALF + n * 16);
#pragma unroll
        for (int ai = 0; ai < 2; ++ai)
#pragma unroll
            for (int m = 0; m < 4; ++m) { float* rowp = X + (size_t)(row0 + ai * HALF + m * 16) * ldx + col0;
#pragma unroll
                for (int bj = 0; bj < 2; ++bj)
#pragma unroll
                    for (int n = 0; n < 2; ++n) { f32x4* p = (f32x4*)(rowp + bj * HALF + n * 16); const f32x4 old = *p; *p = old + gv[bj][n] * acc[ai][bj][m][n]; }
                asm volatile("" ::: "memory"); }
    }
};

template <class Epi, class Sched, bool ALIGN_EPI = false, bool SP2 = false>
__device__ __forceinline__ void gemm_phase(PG8_LAS unsigned char* lds, const Gemm g, const Sched& S, const Epi& E) {
    int tid_l = threadIdx.x; asm volatile("" : "+v"(tid_l));
    const int tid = tid_l, wid = __builtin_amdgcn_readfirstlane(tid >> 6), lane = tid & 63, wr = wid >> 2, wc = wid & 3, fr = lane & 15, fq = lane >> 4;
    const int K = g.K, nt = K / BK;
    unsigned voffA[2], voffB[2];
#pragma unroll
    for (int i = 0; i < 2; ++i) { int R, C; stage_rc(tid * 16 + i * 8192, R, C); const int Rb = Epi::PERM ? ((R & ~31) + perm32(R & 31)) : R;
        voffA[i] = (unsigned)(R * K + C) * 2u; voffB[i] = (unsigned)(Rb * K + C) * 2u; }
    const size_t kstep = (size_t)(BK * 2);
    const size_t hstep = (size_t)HALF * K * 2;
    const size_t tstep = 2 * hstep;
    const unsigned ldsw = (unsigned)wid * 1024u;
    const int aoff = lds_byte(wr * 64 + fr, fq * 8), boff = lds_byte(wc * 32 + fr, fq * 8);
#define PG8_SA(b, h) (((b) * 2 + (h)) * HTB)
#define PG8_SB(b, h) ((4 + (b) * 2 + (h)) * HTB)
#define PG8_STAGE(bufoff, gbase, voff) do { _Pragma("unroll") for (int _i = 0; _i < 2; ++_i) \
        __builtin_amdgcn_global_load_lds((const unsigned*)((const char*)(gbase) + (voff)[_i]), (PG8_LAS unsigned*)(lds + (bufoff) + ldsw + _i * 8192), 16, 0, 0); } while (0)
#define PG8_LDA(dst, b, h) do { _Pragma("unroll") for (int m = 0; m < 4; ++m) _Pragma("unroll") for (int k = 0; k < 2; ++k) dst[m][k] = *(const PG8_LAS bf16x8*)(lds + PG8_SA(b, h) + aoff + m * 2048 + k * 1024); } while (0)
#define PG8_LDB(dst, b, h) do { _Pragma("unroll") for (int n = 0; n < 2; ++n) _Pragma("unroll") for (int k = 0; k < 2; ++k) dst[n][k] = *(const PG8_LAS bf16x8*)(lds + PG8_SB(b, h) + boff + n * 2048 + k * 1024); } while (0)
#define PG8_MMA(ai, bj, At, Bt) do { __builtin_amdgcn_s_setprio(1); _Pragma("unroll") for (int m = 0; m < 4; ++m) _Pragma("unroll") for (int n = 0; n < 2; ++n) _Pragma("unroll") for (int k = 0; k < 2; ++k) \
        acc[ai][bj][m][n] = __builtin_amdgcn_mfma_f32_16x16x32_bf16(Bt[n][k], At[m][k], acc[ai][bj][m][n], 0, 0, 0); __builtin_amdgcn_s_setprio(0); } while (0)
#define PG8_WAIT_V(n) asm volatile("s_waitcnt vmcnt(" #n ")" ::: "memory")
#define PG8_WAIT_L(n) asm volatile("s_waitcnt lgkmcnt(" #n ")" ::: "memory")
#define PG8_BAR __builtin_amdgcn_s_barrier()
#define PG8_SCHED __builtin_amdgcn_sched_barrier(0)
    Unit cur, nxt; int ui = 0;
    if (!S.next(0, cur)) return;
    f32x4 acc[2][2][4][2];
#pragma unroll
    for (int a = 0; a < 2; ++a)
#pragma unroll
        for (int b = 0; b < 2; ++b)
#pragma unroll
            for (int m = 0; m < 4; ++m)
#pragma unroll
                for (int n = 0; n < 2; ++n) acc[a][b][m][n] = (f32x4){0.f, 0.f, 0.f, 0.f};
    bf16x8 At[4][2], B0[2][2], B1[2][2];
    const char* cA = (const char*)g.A + (size_t)cur.pm * tstep; const char* cB = (const char*)g.Bt + (size_t)cur.pn * tstep;
    S.a_ready(cur);
    if constexpr (SP2) {
        PG8_STAGE(PG8_SB(0, 0), cB, voffB); PG8_STAGE(PG8_SB(0, 1), cB + hstep, voffB); PG8_STAGE(PG8_SA(0, 0), cA, voffA); PG8_STAGE(PG8_SA(0, 1), cA + hstep, voffA);
        if (wr == 1) PG8_BAR;
        PG8_WAIT_V(2); PG8_BAR;
        PG8_STAGE(PG8_SB(1, 0), cB + kstep, voffB); PG8_STAGE(PG8_SA(1, 0), cA + kstep, voffA); PG8_STAGE(PG8_SB(1, 1), cB + hstep + kstep, voffB);
        PG8_WAIT_V(6); PG8_BAR;
    } else {
        PG8_STAGE(PG8_SB(0, 0), cB, voffB); PG8_STAGE(PG8_SA(0, 0), cA, voffA); PG8_STAGE(PG8_SB(0, 1), cB + hstep, voffB); PG8_STAGE(PG8_SA(0, 1), cA + hstep, voffA);
        if (wr == 1) PG8_BAR;
        PG8_WAIT_V(4); PG8_BAR;
        PG8_STAGE(PG8_SB(1, 0), cB + kstep, voffB); PG8_STAGE(PG8_SA(1, 0), cA + kstep, voffA); PG8_STAGE(PG8_SB(1, 1), cB + hstep + kstep, voffB);
        PG8_WAIT_V(6); PG8_BAR;
    }
    for (;;) {
        const bool has_next = S.next(ui + 1, nxt);
        const char* nA = has_next ? (const char*)g.A + (size_t)nxt.pm * tstep : cA; const char* nB = has_next ? (const char*)g.Bt + (size_t)nxt.pn * tstep : cB;
        for (int t = 0; t < nt; t += 2) {
            const bool last = (t == nt - 2);
            const char* a1 = cA + (size_t)(t + 1) * kstep;
            const char* a2 = last ? nA : cA + (size_t)(t + 2) * kstep; const char* b2 = last ? nB : cB + (size_t)(t + 2) * kstep;
            const char* a3 = a2 + kstep; const char* b3 = b2 + kstep;
            if (last && has_next) S.a_ready(nxt);
            if constexpr (SP2) {
            PG8_LDB(B0, 0, 0); PG8_LDB(B1, 0, 1); PG8_SCHED; PG8_LDA(At, 0, 0); PG8_STAGE(PG8_SA(1, 1), a1 + hstep, voffA);
            PG8_WAIT_V(8); PG8_WAIT_L(0); PG8_BAR; PG8_MMA(0, 0, At, B0); PG8_MMA(0, 1, At, B1); PG8_BAR; PG8_SCHED;
            PG8_LDA(At, 0, 1); PG8_STAGE(PG8_SB(0, 0), b2, voffB); PG8_STAGE(PG8_SB(0, 1), b2 + hstep, voffB); PG8_STAGE(PG8_SA(0, 0), a2, voffA);
            PG8_WAIT_V(8); PG8_WAIT_L(0); PG8_BAR; PG8_MMA(1, 0, At, B0); PG8_MMA(1, 1, At, B1); PG8_BAR; PG8_SCHED;
            PG8_LDB(B0, 1, 0); PG8_LDB(B1, 1, 1); PG8_SCHED; PG8_LDA(At, 1, 0); PG8_STAGE(PG8_SA(0, 1), a2 + hstep, voffA);
            PG8_WAIT_V(8); PG8_WAIT_L(0); PG8_BAR; PG8_MMA(0, 0, At, B0); PG8_MMA(0, 1, At, B1); PG8_BAR; PG8_SCHED;
            PG8_LDA(At, 1, 1); PG8_STAGE(PG8_SB(1, 0), b3, voffB); PG8_STAGE(PG8_SB(1, 1), b3 + hstep, voffB); PG8_STAGE(PG8_SA(1, 0), a3, voffA);
            PG8_WAIT_V(8); PG8_WAIT_L(0); PG8_BAR; PG8_MMA(1, 0, At, B0); PG8_MMA(1, 1, At, B1); PG8_BAR; PG8_SCHED;
            } else {
            PG8_LDB(B0, 0, 0); PG8_SCHED; PG8_LDA(At, 0, 0); PG8_STAGE(PG8_SA(1, 1), a1 + hstep, voffA);
            PG8_WAIT_L(8); PG8_BAR; PG8_WAIT_L(0); PG8_MMA(0, 0, At, B0); PG8_BAR; PG8_SCHED;
            PG8_LDB(B1, 0, 1); PG8_STAGE(PG8_SB(0, 0), b2, voffB);
            PG8_BAR; PG8_WAIT_L(0); PG8_MMA(0, 1, At, B1); PG8_BAR;
            PG8_LDA(At, 0, 1); PG8_STAGE(PG8_SA(0, 0), a2, voffA);
            PG8_BAR; PG8_WAIT_L(0); PG8_MMA(1, 0, At, B0); PG8_BAR; PG8_SCHED;
            PG8_STAGE(PG8_SB(0, 1), b2 + hstep, voffB);
            PG8_WAIT_V(6); PG8_BAR; PG8_MMA(1, 1, At, B1); PG8_BAR;
            PG8_LDB(B0, 1, 0); PG8_SCHED; PG8_LDA(At, 1, 0); PG8_STAGE(PG8_SA(0, 1), a2 + hstep, voffA);
            PG8_WAIT_L(8); PG8_BAR; PG8_WAIT_L(0); PG8_MMA(0, 0, At, B0); PG8_BAR; PG8_SCHED;
            PG8_LDB(B1, 1, 1); PG8_STAGE(PG8_SB(1, 0), b3, voffB);
            PG8_BAR; PG8_WAIT_L(0); PG8_MMA(0, 1, At, B1); PG8_BAR;
            PG8_LDA(At, 1, 1); PG8_STAGE(PG8_SA(1, 0), a3, voffA);
            PG8_BAR; PG8_WAIT_L(0); PG8_MMA(1, 0, At, B0); PG8_BAR; PG8_SCHED;
            PG8_STAGE(PG8_SB(1, 1), b3 + hstep, voffB);
            PG8_WAIT_V(6); PG8_BAR; PG8_MMA(1, 1, At, B1); PG8_BAR;
            }
        }
        if constexpr (ALIGN_EPI) { if (wr == 0) PG8_BAR; }
        if constexpr (!Epi::AFTER_DRAIN) { E(acc, cur, wr, wc, fr, fq); S.done(cur); }
        if (!has_next) break;
#pragma unroll
        for (int a = 0; a < 2; ++a)
#pragma unroll
            for (int b = 0; b < 2; ++b)
#pragma unroll
                for (int m = 0; m < 4; ++m)
#pragma unroll
                    for (int n = 0; n < 2; ++n) acc[a][b][m][n] = (f32x4){0.f, 0.f, 0.f, 0.f};
        cur = nxt; cA = nA; cB = nB; ++ui;
        if constexpr (ALIGN_EPI) { if (wr == 1) PG8_BAR; }
    }
    PG8_WAIT_V(0);
    if constexpr (!ALIGN_EPI) { if (wr == 0) PG8_BAR; }
    PG8_BAR;
    if constexpr (Epi::AFTER_DRAIN) { E.fused(acc, cur, wr, wc, fr, fq, lds, wid, lane); S.done(cur); }
#undef PG8_SA
#undef PG8_SB
#undef PG8_STAGE
#undef PG8_LDA
#undef PG8_LDB
#undef PG8_MMA
#undef PG8_WAIT_V
#undef PG8_WAIT_L
#undef PG8_BAR
#undef PG8_SCHED
}
}
namespace att {
#define ATT_LAS __attribute__((address_space(3)))
typedef unsigned short bf16_t;
using bf16x8 = __attribute__((ext_vector_type(8))) short;
using s16x4  = __attribute__((ext_vector_type(4))) short;
using f32x16 = __attribute__((ext_vector_type(16))) float;
using f32x4  = __attribute__((ext_vector_type(4))) float;
using u32x4  = __attribute__((ext_vector_type(4))) unsigned;
constexpr int NW = 8, QBLK = 32, KVBLK = 64;
constexpr int LDQ = 3072, LDKV = 4096, LDO = 2048, LDKPE = 64;
constexpr float SCALE = 0.07216878364870322f;
constexpr float THR = 8.f;
constexpr int SHM_V = KVBLK * 128 * 2, SHM_K = KVBLK * 192 * 2;
constexpr int OFF_V = 0, OFF_K = 2 * SHM_V, OFF_WS = OFF_K + 2 * SHM_K, LDS_BYTES = OFF_WS + NW * 64 * 4;
#define ATT_KSWZ(row, colB) ((row) * 384 + ((colB) ^ (((row) & 7) << 4)))
#define ATT_SBAR() __builtin_amdgcn_sched_barrier(0)
__device__ __forceinline__ int crow(int r, int hi) { return (r & 3) + 8 * (r >> 2) + 4 * hi; }
__device__ __forceinline__ unsigned cvtpk(float lo, float hi) { unsigned r; asm volatile("v_cvt_pk_bf16_f32 %0, %1, %2" : "=v"(r) : "v"(lo), "v"(hi)); return r; }
__device__ __forceinline__ float bf2f(short s) { return __uint_as_float(((unsigned)(unsigned short)s) << 16); }

__device__ __forceinline__ void partialSM(f32x16& p0, f32x16& p1, float& m_reg, float& mn, float& alpha) {
  constexpr float C = SCALE * 1.4426950408889634f;
  float pmax = p0[0];
#pragma unroll
  for (int r = 1; r < 16; ++r) pmax = fmaxf(pmax, p0[r]);
#pragma unroll
  for (int r = 0; r < 16; ++r) pmax = fmaxf(pmax, p1[r]);
  { auto rr = __builtin_amdgcn_permlane32_swap(__float_as_uint(pmax), __float_as_uint(pmax), false, false);
    pmax = fmaxf(__uint_as_float(rr[0]), __uint_as_float(rr[1])); }
  if (__builtin_expect(__all(pmax - m_reg <= THR / SCALE), 1)) { mn = m_reg; alpha = 1.f; }
  else { mn = fmaxf(m_reg, pmax); alpha = __builtin_amdgcn_exp2f((m_reg - mn) * C); m_reg = mn; }
  float mnC = -mn * C;
#pragma unroll
  for (int r = 0; r < 16; ++r) p0[r] = fmaf(p0[r], C, mnC);
#pragma unroll
  for (int r = 0; r < 16; ++r) p1[r] = fmaf(p1[r], C, mnC);
#pragma unroll
  for (int r = 0; r < 16; ++r) p0[r] = __builtin_amdgcn_exp2f(p0[r]);
}
__device__ __forceinline__ void finishSM(f32x16& p0, f32x16& p1, float alpha, float& l_reg, bf16x8& pa0, bf16x8& pa1, bf16x8& pa2, bf16x8& pa3) {
#pragma unroll
  for (int r = 0; r < 16; ++r) p1[r] = __builtin_amdgcn_exp2f(p1[r]);
  float ps = 0;
#pragma unroll
  for (int r = 0; r < 16; ++r) ps += p0[r];
#pragma unroll
  for (int r = 0; r < 16; ++r) ps += p1[r];
  { auto rr = __builtin_amdgcn_permlane32_swap(__float_as_uint(ps), __float_as_uint(ps), false, false);
    ps = __uint_as_float(rr[0]) + __uint_as_float(rr[1]); }
  l_reg = l_reg * alpha + ps;
#define ATT_PK4(P, BASE, OUT) do { unsigned a0 = cvtpk(P[BASE + 0], P[BASE + 1]), a1 = cvtpk(P[BASE + 2], P[BASE + 3]);   \
    unsigned b0 = cvtpk(P[BASE + 4], P[BASE + 5]), b1 = cvtpk(P[BASE + 6], P[BASE + 7]);                              \
    auto r0 = __builtin_amdgcn_permlane32_swap(a0, b0, false, false); auto r1 = __builtin_amdgcn_permlane32_swap(a1, b1, false, false); \
    u32x4 w = {r0[0], r1[0], r0[1], r1[1]}; OUT = __builtin_bit_cast(bf16x8, w); } while (0)
  ATT_PK4(p0, 0, pa0); ATT_PK4(p0, 8, pa1); ATT_PK4(p1, 0, pa2); ATT_PK4(p1, 8, pa3);
#undef ATT_PK4
}
__device__ __forceinline__ void qkt(f32x16& p0, f32x16& p1, const ATT_LAS char* Ks, const bf16x8 (&qr)[12], int r32, int hi) {
  p0 = f32x16{}; p1 = f32x16{};
#pragma unroll
  for (int d0 = 0; d0 < 12; ++d0) { const int cb = (d0 * 16 + hi * 8) * 2;
    const bf16x8 b0 = *reinterpret_cast<const ATT_LAS bf16x8*>(Ks + ATT_KSWZ(r32, cb));
    const bf16x8 b1 = *reinterpret_cast<const ATT_LAS bf16x8*>(Ks + ATT_KSWZ(32 + r32, cb));
    p0 = __builtin_amdgcn_mfma_f32_32x32x16_bf16(b0, qr[d0], p0, 0, 0, 0);
    p1 = __builtin_amdgcn_mfma_f32_32x32x16_bf16(b1, qr[d0], p1, 0, 0, 0); }
}
__device__ __forceinline__ int v_st(int k, int c) { const int kk = (k & ~0xC) | ((k & 4) << 1) | ((k & 8) >> 1); return ((kk >> 3) * 4 + (c >> 5)) * 512 + ((kk & 7) * 32 + (c & 31)) * 2; }
__device__ __forceinline__ int v_rd_base(int lane) { return ((lane & 3) << 3) | (((lane >> 2) & 3) << 6) | (((lane >> 4) & 1) << 5) | (((lane >> 5) & 1) << 8); }
constexpr int v_rd_off(int d0, int ks, int half) { return d0 * 512 + ks * 4096 + half * 2048; }
template <int OFF> __device__ __forceinline__ s16x4 tr_read(int vb) {
  s16x4 r; asm volatile("ds_read_b64_tr_b16 %0, %1 offset:%2" : "=&v"(r) : "v"(vb), "i"(OFF) : "memory"); return r;
}
template <int D0> __device__ __forceinline__ void pv_one(f32x16& od, int vb, bf16x8 pa0, bf16x8 pa1, bf16x8 pa2, bf16x8 pa3) {
  const s16x4 l0 = tr_read<v_rd_off(D0, 0, 0)>(vb), h0 = tr_read<v_rd_off(D0, 0, 1)>(vb), l1 = tr_read<v_rd_off(D0, 1, 0)>(vb), h1 = tr_read<v_rd_off(D0, 1, 1)>(vb);
  const s16x4 l2 = tr_read<v_rd_off(D0, 2, 0)>(vb), h2 = tr_read<v_rd_off(D0, 2, 1)>(vb), l3 = tr_read<v_rd_off(D0, 3, 0)>(vb), h3 = tr_read<v_rd_off(D0, 3, 1)>(vb);
  asm volatile("s_waitcnt lgkmcnt(0)" ::: "memory"); ATT_SBAR();
#define ATT_PK(L, H) (bf16x8){L[0], L[1], L[2], L[3], H[0], H[1], H[2], H[3]}
  od = __builtin_amdgcn_mfma_f32_32x32x16_bf16(pa0, ATT_PK(l0, h0), od, 0, 0, 0);
  od = __builtin_amdgcn_mfma_f32_32x32x16_bf16(pa1, ATT_PK(l1, h1), od, 0, 0, 0);
  od = __builtin_amdgcn_mfma_f32_32x32x16_bf16(pa2, ATT_PK(l2, h2), od, 0, 0, 0);
  od = __builtin_amdgcn_mfma_f32_32x32x16_bf16(pa3, ATT_PK(l3, h3), od, 0, 0, 0);
#undef ATT_PK
}

__device__ __forceinline__ void attn_unit(ATT_LAS unsigned char* lds, const bf16_t* __restrict__ Q, const bf16_t* __restrict__ KV, const bf16_t* __restrict__ KPE,
                                          bf16_t* __restrict__ O, int nkeys, int rope, int t0, const float* __restrict__ ROPE) {
  int tid_l = threadIdx.x; asm volatile("" : "+v"(tid_l));
  const int tid = tid_l, wid = tid >> 6, lane = tid & 63, r32 = lane & 31, hi = lane >> 5;
  ATT_LAS char* V_lds = (ATT_LAS char*)lds + OFF_V; ATT_LAS char* K_lds = (ATT_LAS char*)lds + OFF_K;
  ATT_LAS float* wsf = (ATT_LAS float*)((ATT_LAS char*)lds + OFF_WS) + wid * 64; ATT_LAS float* li_l = wsf; ATT_LAS float* al_l = wsf + 32;
  float m_reg = -1e30f, l_reg = 0.f; f32x16 o[4] = {}; bf16x8 qr[12];
  const bf16_t* Qw = Q + (size_t)(wid * QBLK + r32) * LDQ + hi * 8;
#pragma unroll
  for (int d0 = 0; d0 < 12; ++d0) qr[d0] = *reinterpret_cast<const bf16x8*>(Qw + d0 * 16);
  if (rope) {
    const int t = t0 + wid * QBLK + r32;
#pragma unroll
    for (int hf = 0; hf < 2; ++hf) {
      const int pos = hf ? (t & 63) : (t >> 6);
      const f32x4* tp = reinterpret_cast<const f32x4*>(ROPE + (size_t)(pos * 16 + hi * 8) * 2);
      const bf16x8 a = qr[8 + 2 * hf], b = qr[9 + 2 * hf]; u32x4 na, nb;
#pragma unroll
      for (int q = 0; q < 4; ++q) { const f32x4 cs = tp[q];
        const float x1a = bf2f(a[2 * q]), x2a = bf2f(b[2 * q]), x1b = bf2f(a[2 * q + 1]), x2b = bf2f(b[2 * q + 1]);
        na[q] = cvtpk(x1a * cs[0] - x2a * cs[1], x1b * cs[2] - x2b * cs[3]);
        nb[q] = cvtpk(x1a * cs[1] + x2a * cs[0], x1b * cs[3] + x2b * cs[2]); }
      qr[8 + 2 * hf] = __builtin_bit_cast(bf16x8, na); qr[9 + 2 * hf] = __builtin_bit_cast(bf16x8, nb);
    }
  }
  const int sr = tid >> 4, sc = (tid & 15) * 8, vst0 = v_st(sr, sc), vst1 = v_st(32 + sr, sc), kr = tid >> 3, kc = (tid & 7) * 8;
  const int vb0 = (int)(unsigned)(size_t)V_lds + v_rd_base(lane);
  bf16x8 vs0, vs1, ks0, ks1, kp0;
#define ATT_SLOAD(k0) do { const bf16_t* kvp = KV + (size_t)((k0) + sr) * LDKV + sc; \
    ks0 = *reinterpret_cast<const bf16x8*>(kvp); ks1 = *reinterpret_cast<const bf16x8*>(kvp + (size_t)32 * LDKV); \
    vs0 = *reinterpret_cast<const bf16x8*>(kvp + 128); vs1 = *reinterpret_cast<const bf16x8*>(kvp + (size_t)32 * LDKV + 128); \
    kp0 = *reinterpret_cast<const bf16x8*>(KPE + (size_t)((k0) + kr) * LDKPE + kc); } while (0)
#define ATT_SWRITE(b) do { *reinterpret_cast<ATT_LAS bf16x8*>(V_lds + (b) * SHM_V + vst0) = vs0; *reinterpret_cast<ATT_LAS bf16x8*>(V_lds + (b) * SHM_V + vst1) = vs1; \
    *reinterpret_cast<ATT_LAS bf16x8*>(K_lds + (b) * SHM_K + ATT_KSWZ(sr, sc * 2)) = ks0; *reinterpret_cast<ATT_LAS bf16x8*>(K_lds + (b) * SHM_K + ATT_KSWZ(32 + sr, sc * 2)) = ks1; \
    *reinterpret_cast<ATT_LAS bf16x8*>(K_lds + (b) * SHM_K + ATT_KSWZ(kr, 256 + kc * 2)) = kp0; } while (0)
  const int NT = nkeys / KVBLK;
  ATT_SLOAD(0); ATT_SWRITE(0); __syncthreads();
  for (int j = 0; j < NT; ++j) {
    const int b = j & 1;
    if (j + 1 < NT) ATT_SLOAD((j + 1) * KVBLK);
    f32x16 p0, p1; float mn, alpha; bf16x8 pa0, pa1, pa2, pa3;
    qkt(p0, p1, K_lds + b * SHM_K, qr, r32, hi);
    partialSM(p0, p1, m_reg, mn, alpha);
    if (__any(alpha < 1.f)) {
      if (hi == 0) al_l[r32] = alpha;
      asm volatile("s_waitcnt lgkmcnt(0)" ::: "memory");
#pragma unroll
      for (int r = 0; r < 16; ++r) { const float av = al_l[crow(r, hi)];
#pragma unroll
        for (int d = 0; d < 4; ++d) o[d][r] *= av; }
    }
    finishSM(p0, p1, alpha, l_reg, pa0, pa1, pa2, pa3); ATT_SBAR();
    const int vb = vb0 + b * SHM_V;
    pv_one<0>(o[0], vb, pa0, pa1, pa2, pa3); pv_one<1>(o[1], vb, pa0, pa1, pa2, pa3); pv_one<2>(o[2], vb, pa0, pa1, pa2, pa3); pv_one<3>(o[3], vb, pa0, pa1, pa2, pa3);
    if (j + 1 < NT) ATT_SWRITE(b ^ 1);
    __syncthreads();
  }
  if (hi == 0) li_l[r32] = l_reg;
  asm volatile("s_waitcnt lgkmcnt(0)" ::: "memory");
  bf16_t* Ow = O + (size_t)(wid * QBLK) * LDO;
#pragma unroll
  for (int r = 0; r < 16; ++r) { const int orow = crow(r, hi); const float rl = __builtin_amdgcn_rcpf(li_l[orow]);
#pragma unroll
    for (int d0 = 0; d0 < 4; ++d0) { const float v = o[d0][r] * rl; unsigned u = __float_as_uint(v); u += 0x7fffu + ((u >> 16) & 1u);
      Ow[(size_t)orow * LDO + d0 * 32 + r32] = (bf16_t)(u >> 16); } }
  asm volatile("s_waitcnt lgkmcnt(0)" ::: "memory");
#undef ATT_SLOAD
#undef ATT_SWRITE
}
}

constexpr int NWAVES = 8;
constexpr int DM = 2048, NTOK = 16384, NPROMPT = 8192, DFF = 8192, NLAYER = 4;
constexpr int SEQ_S = 2048, PAST = 512, LKS = PAST + SEQ_S, NKVROWS = NPROMPT + 4 * LKS;
constexpr int MODROW = 6 * DM;
constexpr int KS_MOD = 16;
constexpr float EPS = 1e-6f;
#ifndef MK_MULTI
#define MK_MULTI 0
#endif

constexpr size_t MiB = 1u << 20;
constexpr size_t WS_CTL = 0, CTL_ZERO_BYTES = 32768;
constexpr size_t WS_MODF = 1 * MiB;
constexpr size_t WS_ROPE = WS_MODF + (size_t)NLAYER * 5 * MODROW * 4;
constexpr size_t WS_MODP = 2 * MiB;
constexpr size_t WS_WS = 17 * MiB;
constexpr size_t WS_MLA_A = 18 * MiB;
constexpr size_t WS_QB = 23 * MiB, WS_KVB = 26 * MiB, WS_WO = 30 * MiB;
constexpr size_t WS_GIN = 38 * MiB, WS_GOUT = 54 * MiB;
constexpr size_t WS_COUT = 62 * MiB, WS_CIN = 78 * MiB;
constexpr size_t WS_W1 = 126 * MiB, WS_W2 = 254 * MiB;
constexpr size_t WS_X = 382 * MiB;
constexpr size_t WS_H = 510 * MiB;
constexpr size_t WS_A2 = 574 * MiB;
constexpr size_t WS_BIG = 638 * MiB;
constexpr size_t WS_ABF = WS_BIG, WS_Q = WS_BIG + 40 * MiB, WS_QAN = WS_BIG + 136 * MiB, WS_CKV = WS_BIG + 152 * MiB, WS_KPE = WS_BIG + 170 * MiB;
constexpr size_t WS_KV = 894 * MiB;
constexpr size_t WS_END = 1038 * MiB;
static_assert(WS_ROPE + 64 * 16 * 2 * 4 <= WS_MODP && WS_MODP + (size_t)KS_MOD * NLAYER * 5 * MODROW * 4 <= WS_WS && WS_KPE + (size_t)NKVROWS * 64 * 2 <= WS_KV, "d_ws map");
constexpr int CW_BAR = 1024;
constexpr size_t OUT_Y = 0, OUT_CKV = (size_t)NTOK * DM, OUT_KPE = OUT_CKV + (size_t)NPROMPT * 512, OUT_END = OUT_KPE + (size_t)NPROMPT * 64;

constexpr int RING_OFF = 0, RING_BYTES = 131072;
constexpr int MISC_OFF = RING_BYTES;
constexpr int LDS_BYTES = 147456;
static_assert(att::LDS_BYTES <= RING_BYTES, "attention LDS");

#define GAS __attribute__((address_space(1)))
#define LAS __attribute__((address_space(3)))
typedef unsigned short bf16;
typedef unsigned v4u __attribute__((ext_vector_type(4)));
typedef unsigned v2u __attribute__((ext_vector_type(2)));
typedef float f32x4 __attribute__((ext_vector_type(4)));
typedef short bf16x8 __attribute__((ext_vector_type(8)));
#define LDS_WAIT() asm volatile("s_waitcnt lgkmcnt(0)" ::: "memory")
#define VM_WAIT() asm volatile("s_waitcnt vmcnt(0)" ::: "memory")
__device__ __forceinline__ unsigned f2bf(float f) { unsigned u = __builtin_bit_cast(unsigned, f); return (u + 0x7fffu + ((u >> 16) & 1u)) >> 16; }
__device__ __forceinline__ unsigned pk2(float lo, float hi) { return f2bf(lo) | (f2bf(hi) << 16); }
__device__ __forceinline__ float bf2f(short s) { return __uint_as_float(((unsigned)(unsigned short)s) << 16); }
__device__ __forceinline__ float wave_sum(float v) {
#pragma unroll
    for (int o = 1; o < 64; o <<= 1) v += __shfl_xor(v, o);
    return v;
}
__device__ __forceinline__ int cond_of_row(int row) { return row < NPROMPT ? 0 : 1 + ((row - NPROMPT) >> 11); }

#define XB_TMO      128
#define XB_XCNT(j)  (256  + 64 * (j))
#define XB_XSUB(j)  (1280 + 64 * (j))
#define XB_XGEN(j)  (2304 + 64 * (j))
#define XB_TOP      3328
#define XB_TOPGEN   3392
#define XCD_BAR_WORDS 3456
#define XB_SPIN_CAP (1u << 18)

__device__ __forceinline__ unsigned xb_ld(unsigned* p)              { return __hip_atomic_load(p, __ATOMIC_RELAXED, __HIP_MEMORY_SCOPE_AGENT); }
__device__ __forceinline__ unsigned xb_add(unsigned* p, unsigned v) { return __hip_atomic_fetch_add(p, v, __ATOMIC_RELAXED, __HIP_MEMORY_SCOPE_AGENT); }
__device__ __forceinline__ unsigned xb_xcc_id() { return (unsigned)__builtin_amdgcn_s_getreg((3 << 11) | 20) & 0xFu; }
#define XB_SPIN(cond, bar) do { unsigned _sp = 0; while (cond) { __builtin_amdgcn_s_sleep(1); \
    if ((++_sp & 255u) == 0u) { if (xb_ld(&(bar)[XB_TMO])) break; if (_sp > XB_SPIN_CAP) { atomicAdd(&(bar)[XB_TMO], 1u); break; } } } } while (0)

struct XcdBarrier {
    unsigned* bar; unsigned x;
    volatile LAS unsigned* st;
};

__device__ __forceinline__ XcdBarrier xcd_barrier_post(unsigned* bar, volatile LAS unsigned* st) {
    XcdBarrier b; b.bar = bar; b.x = xb_xcc_id(); b.st = st;
    if (threadIdx.x == 0) (void)xb_add(&bar[XB_XCNT(b.x)], 1u);
    return b;
}
__device__ __forceinline__ void xcd_barrier_complete(unsigned* bar, unsigned x, unsigned& nloc, unsigned& nx) {
    const unsigned G = gridDim.x * gridDim.y * gridDim.z;
    unsigned sum, cnt, mine, sp = 0u;
    for (;;) {
        sum = 0u; cnt = 0u; mine = 0u;
#pragma unroll
        for (unsigned j = 0; j < 16; ++j) { const unsigned c = xb_ld(&bar[XB_XCNT(j)]); sum += c; cnt += (c > 0u) ? 1u : 0u; mine = (j == x) ? c : mine; }
        if (sum == G) break;
        __builtin_amdgcn_s_sleep(1);
        if ((++sp & 255u) == 0u) { if (xb_ld(&bar[XB_TMO])) break; if (sp > XB_SPIN_CAP) { atomicAdd(&bar[XB_TMO], 1u); break; } }
    }
    nloc = mine > 0u ? mine : 1u; nx = cnt > 0u ? cnt : 1u;
}

__device__ __forceinline__ void xcd_barrier(const XcdBarrier& b) {
    asm volatile("s_waitcnt vmcnt(0)" ::: "memory");
    __syncthreads();
    if (threadIdx.x == 0) {
        unsigned* bar = b.bar;
        __builtin_amdgcn_s_waitcnt(0);
        unsigned nloc = b.st[0], nx = b.st[1];
        if (nloc == 0u) { xcd_barrier_complete(bar, b.x, nloc, nx); b.st[0] = nloc; b.st[1] = nx; }
        const unsigned old = xb_add(&bar[XB_XSUB(b.x)], 1u);
        const unsigned gen = old / nloc;
        if (old + 1u == (gen + 1u) * nloc) {
            __builtin_amdgcn_fence(__ATOMIC_RELEASE, "agent");
            asm volatile("s_waitcnt vmcnt(0)" ::: "memory");
            const unsigned og = xb_add(&bar[XB_TOP], 1u);
            const unsigned tg = og / nx;
            if (og + 1u == (tg + 1u) * nx) xb_add(&bar[XB_TOPGEN], 1u);
            else XB_SPIN(xb_ld(&bar[XB_TOPGEN]) == tg, bar);
            __builtin_amdgcn_fence(__ATOMIC_ACQUIRE, "agent");
            xb_add(&bar[XB_XGEN(b.x)], 1u);
            asm volatile("s_waitcnt vmcnt(0)" ::: "memory");
        } else {
            XB_SPIN(xb_ld(&bar[XB_XGEN(b.x)]) == gen, bar);
            __builtin_amdgcn_fence(__ATOMIC_ACQUIRE, "agent");
            asm volatile("s_waitcnt vmcnt(0)" ::: "memory");
        }
    }
    __syncthreads();
}
constexpr int N_MOD = NLAYER * (MODROW / 256) * KS_MOD;
constexpr int I_CIN = (DM / 64) * (6144 / 32), I_SQ = (DM / 64) * (DM / 32), I_GIN = (DM / 64) * (4096 / 32), I_QA = (DM / 64) * (512 / 32), I_KVA = (DM / 64) * (576 / 32),
              I_QB = (512 / 64) * (3072 / 32), I_KVB = (512 / 64) * (4096 / 32), I_W1 = (DM / 64) * (DFF / 32), I_W2 = (DFF / 64) * (DM / 32);
constexpr int N_TR = 2 * I_CIN + 2 * I_SQ + I_GIN + I_SQ + I_QA + I_KVA + I_QB + I_KVB + I_SQ + 4 * I_W1 + 4 * I_W2;
constexpr int N_WSI = 512, N_ZI = 768, N_P0 = N_MOD + N_TR + N_WSI + N_ZI;

struct Ptrs {
    const float *xp, *xs, *cache_ckv, *cache_kpe, *c, *c_ctx, *ada_w, *ada_b, *norm1, *norm2, *conv_w_in, *conv_w, *conv_w_out, *gmlp_w_in, *gmlp_g_v, *gmlp_w_s, *gmlp_b_s, *gmlp_w_out,
                *mla_w_q_a, *mla_g_q, *mla_w_q_b, *mla_w_kv_a, *mla_g_kv, *mla_w_kv_b, *mla_w_o, *mlp_w1, *mlp_w2, *final_norm;
    float* out; unsigned char* ws;
};

struct Args { const float* in[28]; float* out; unsigned char* ws; int ph_lo, ph_hi; };
__device__ __forceinline__ Ptrs make_ptrs() {
    const __attribute__((address_space(4))) Args* ap = (const __attribute__((address_space(4))) Args*)__builtin_amdgcn_kernarg_segment_ptr();
    asm volatile("" : "+s"(ap));
    Ptrs P;
    P.xp = ap->in[0]; P.xs = ap->in[1]; P.cache_ckv = ap->in[2]; P.cache_kpe = ap->in[3]; P.c = ap->in[4]; P.c_ctx = ap->in[5]; P.ada_w = ap->in[6]; P.ada_b = ap->in[7];
    P.norm1 = ap->in[8]; P.norm2 = ap->in[9]; P.conv_w_in = ap->in[10]; P.conv_w = ap->in[11]; P.conv_w_out = ap->in[12]; P.gmlp_w_in = ap->in[13]; P.gmlp_g_v = ap->in[14];
    P.gmlp_w_s = ap->in[15]; P.gmlp_b_s = ap->in[16]; P.gmlp_w_out = ap->in[17]; P.mla_w_q_a = ap->in[18]; P.mla_g_q = ap->in[19]; P.mla_w_q_b = ap->in[20]; P.mla_w_kv_a = ap->in[21];
    P.mla_g_kv = ap->in[22]; P.mla_w_kv_b = ap->in[23]; P.mla_w_o = ap->in[24]; P.mlp_w1 = ap->in[25]; P.mlp_w2 = ap->in[26]; P.final_norm = ap->in[27];
    P.out = ap->out; P.ws = ap->ws;
    return P;
}
struct Ctx { int tid, lane, wave, G, bx, gw, NGW; };
__device__ __forceinline__ Ctx make_ctx() {
    int t = threadIdx.x; asm volatile("" : "+v"(t));
    int b = blockIdx.x; asm volatile("" : "+s"(b));
    Ctx C; C.tid = t; C.lane = t & 63; C.wave = __builtin_amdgcn_readfirstlane(t >> 6); C.G = gridDim.x; C.bx = b;
    const int vcu = (C.G % 8 == 0) ? (b % 8) * (C.G / 8) + b / 8 : b;
    C.gw = vcu * NWAVES + C.wave; C.NGW = C.G * NWAVES;
    return C;
}

__device__ __forceinline__ void p0_transpose_item(const float* W, int K, int N, bf16* WT, int row_off, LAS float* scr, int item, int lane) {
    const int nblk = N / 32, kb = item / nblk, nb = item - kb * nblk, k0 = 64 * kb, n0 = 32 * nb;
    const int lk = lane >> 3, ln = (lane & 7) * 4;
    f32x4 v[8];
#pragma unroll
    for (int i = 0; i < 8; ++i) v[i] = *(const f32x4*)(W + (size_t)(k0 + 8 * i + lk) * N + n0 + ln);
#pragma unroll
    for (int i = 0; i < 8; ++i) { LAS float* d = scr + (8 * i + lk) * 33 + ln; d[0] = v[i][0]; d[1] = v[i][1]; d[2] = v[i][2]; d[3] = v[i][3]; }
    LDS_WAIT(); asm volatile("" ::: "memory");
    const int c = lane & 7;
#pragma unroll
    for (int j = 0; j < 4; ++j) { const int n = (lane >> 3) + 8 * j; const LAS float* s = scr + (8 * c) * 33 + n;
        v4u o; o.x = pk2(s[0 * 33], s[1 * 33]); o.y = pk2(s[2 * 33], s[3 * 33]); o.z = pk2(s[4 * 33], s[5 * 33]); o.w = pk2(s[6 * 33], s[7 * 33]);
        *(v4u*)(WT + (size_t)(row_off + n0 + n) * K + k0 + 8 * c) = o; }
    LDS_WAIT(); asm volatile("" ::: "memory");
}


__device__ __forceinline__ void p0a_phase(LAS unsigned char* lds) {
    const Ctx C = make_ctx(); const Ptrs P = make_ptrs(); const int gw = C.gw, NGW = C.NGW, tid = C.tid, wave = C.wave, lane = C.lane;
    LAS float* silu = (LAS float*)lds;
    for (int i = tid; i < 5 * DM; i += NWAVES * 64) { const int cd = i >> 11, k = i & (DM - 1); const float x = cd == 0 ? P.c_ctx[k] : P.c[(cd - 1) * DM + k]; silu[i] = x / (1.f + expf(-x)); }
    __syncthreads();
    LAS float* scr = (LAS float*)(lds + 40960 + wave * 8448);
    float* modp = (float*)(P.ws + WS_MODP);
    for (int it = gw; it < N_P0; it += NGW) {
        if (it < N_MOD) {
            const int L = it / (N_MOD / NLAYER), rem = it - L * (N_MOD / NLAYER), jb = rem / KS_MOD, ks = rem - jb * KS_MOD;
            const float* W = P.ada_w + ((size_t)L * DM + (size_t)ks * 128) * MODROW + jb * 256 + lane * 4;
            f32x4 acc[5];
#pragma unroll
            for (int cd = 0; cd < 5; ++cd) acc[cd] = (f32x4){0.f, 0.f, 0.f, 0.f};
            for (int k = 0; k < 128; k += 16) { f32x4 w[16];
#pragma unroll
                for (int i = 0; i < 16; ++i) w[i] = *(const f32x4*)(W + (size_t)(k + i) * MODROW);
#pragma unroll
                for (int i = 0; i < 16; ++i)
#pragma unroll
                    for (int cd = 0; cd < 5; ++cd) acc[cd] += w[i] * silu[cd * DM + ks * 128 + k + i]; }
#pragma unroll
            for (int cd = 0; cd < 5; ++cd) *(f32x4*)(modp + ((size_t)(ks * NLAYER + L) * 5 + cd) * MODROW + jb * 256 + lane * 4) = acc[cd];
            continue; }
        int r = it - N_MOD;
        if (r < N_TR) {
            const float* W; int K, N, ro = 0; size_t dst;
            if (r < 2 * I_CIN) { const int l = r / I_CIN; r -= l * I_CIN; W = P.conv_w_in + (size_t)l * DM * 6144; K = DM; N = 6144; dst = WS_CIN + (size_t)l * 6144 * DM * 2; }
            else if ((r -= 2 * I_CIN) < 2 * I_SQ) { const int l = r / I_SQ; r -= l * I_SQ; W = P.conv_w_out + (size_t)l * DM * DM; K = DM; N = DM; dst = WS_COUT + (size_t)l * DM * DM * 2; }
            else if ((r -= 2 * I_SQ) < I_GIN) { W = P.gmlp_w_in; K = DM; N = 4096; dst = WS_GIN; }
            else if ((r -= I_GIN) < I_SQ) { W = P.gmlp_w_out; K = DM; N = DM; dst = WS_GOUT; }
            else if ((r -= I_SQ) < I_QA) { W = P.mla_w_q_a; K = DM; N = 512; dst = WS_MLA_A; }
            else if ((r -= I_QA) < I_KVA) { W = P.mla_w_kv_a; K = DM; N = 576; dst = WS_MLA_A; ro = 512; }
            else if ((r -= I_KVA) < I_QB) { W = P.mla_w_q_b; K = 512; N = 3072; dst = WS_QB; }
            else if ((r -= I_QB) < I_KVB) { W = P.mla_w_kv_b; K = 512; N = 4096; dst = WS_KVB; }
            else if ((r -= I_KVB) < I_SQ) { W = P.mla_w_o; K = DM; N = DM; dst = WS_WO; }
            else if ((r -= I_SQ) < 4 * I_W1) { const int l = r / I_W1; r -= l * I_W1; W = P.mlp_w1 + (size_t)l * DM * DFF; K = DM; N = DFF; dst = WS_W1 + (size_t)l * DFF * DM * 2; }
            else { r -= 4 * I_W1; const int l = r / I_W2; r -= l * I_W2; W = P.mlp_w2 + (size_t)l * DFF * DM; K = DFF; N = DM; dst = WS_W2 + (size_t)l * DM * DFF * 2; }
            p0_transpose_item(W, K, N, (bf16*)(P.ws + dst), ro, scr, r, lane);
            continue; }
        r -= N_TR;
        if (r < N_WSI) { const float* s = P.gmlp_w_s + (size_t)r * 512 + lane * 8; const f32x4 a = *(const f32x4*)s, b = *(const f32x4*)(s + 4);
            v4u o; o.x = pk2(a[0], a[1]); o.y = pk2(a[2], a[3]); o.z = pk2(b[0], b[1]); o.w = pk2(b[2], b[3]); *(v4u*)((bf16*)(P.ws + WS_WS) + (size_t)r * 512 + lane * 8) = o; continue; }
        r -= N_WSI;
        { v4u z; z.x = 0u; z.y = 0u; z.z = 0u; z.w = 0u; *(v4u*)((bf16*)(P.ws + WS_MLA_A) + (size_t)1088 * DM + (size_t)r * 512 + lane * 8) = z; }
    }
    __syncthreads();
}

__device__ __forceinline__ void sincos_d(double a, double& sn, double& cs) {
    const double k = rint(a * 0.63661977236758134308); double r = fma(-k, 1.57079632679489655800, a); r = fma(-k, 6.12323399573676603587e-17, r);
    const double r2 = r * r;
    const double s = r * (1.0 + r2 * (-1.0 / 6 + r2 * (1.0 / 120 + r2 * (-1.0 / 5040 + r2 * (1.0 / 362880 + r2 * (-1.0 / 39916800 + r2 * (1.0 / 6227020800.0 + r2 * (-1.0 / 1307674368000.0))))))));
    const double c = 1.0 + r2 * (-0.5 + r2 * (1.0 / 24 + r2 * (-1.0 / 720 + r2 * (1.0 / 40320 + r2 * (-1.0 / 3628800 + r2 * (1.0 / 479001600 + r2 * (-1.0 / 87178291200.0 + r2 * (1.0 / 20922789888000.0))))))));
    const int q = ((int)k) & 3;
    sn = q == 0 ? s : q == 1 ? c : q == 2 ? -s : -c;
    cs = q == 0 ? c : q == 1 ? -s : q == 2 ? -c : s;
}
__device__ __forceinline__ void p0b_phase() {
    const Ctx C = make_ctx(); const Ptrs P = make_ptrs(); const int gtid = C.bx * (NWAVES * 64) + C.tid, NT = C.G * NWAVES * 64;
    const float* modp = (const float*)(P.ws + WS_MODP); float* modf = (float*)(P.ws + WS_MODF);
    for (int i = gtid; i < NLAYER * 5 * MODROW; i += NT) {
        const int cidx = i & (DM - 1), lcs = i >> 11, slot = lcs % 6, lc = lcs / 6, L = lc / 5, cd = lc - 5 * L, j = slot * DM + cidx;
        float v = P.ada_b[L * MODROW + j];
#pragma unroll
        for (int ks = 0; ks < KS_MOD; ++ks) v += modp[((size_t)(ks * NLAYER + L) * 5 + cd) * MODROW + j];
        if (slot == 1) v = P.norm1[L * DM + cidx] * (1.f + v);
        if (slot == 4) v = P.norm2[L * DM + cidx] * (1.f + v);
        modf[i] = v; }
    float* rope = (float*)(P.ws + WS_ROPE);
    for (int i = gtid; i < 64 * 16; i += NT) { const int pos = i >> 4, j = i & 15;
        double inv = 1.0; for (int q = 0; q < j; ++q) inv *= 0.56234132519034908039;
        const float ang = (float)pos * (float)inv; double sn, cs; sincos_d((double)ang, sn, cs);
        rope[2 * i] = (float)cs; rope[2 * i + 1] = (float)sn; }
}

__device__ __forceinline__ void norm_phase(int L, int which, bool first) {
    const Ctx C = make_ctx(); const Ptrs P = make_ptrs(); const int gw = C.gw, NGW = C.NGW, lane = C.lane;
    const float* modf = (const float*)(P.ws + WS_MODF); float* X = (float*)(P.ws + WS_X); bf16* H = (bf16*)(P.ws + WS_H);
    for (int r0 = gw * 8; r0 < NTOK; r0 += NGW * 8) {
        const int cd = cond_of_row(r0);
        const f32x4* wp = (const f32x4*)(modf + ((size_t)(L * 5 + cd) * 6 + (which ? 4 : 1)) * DM) + lane;
        const f32x4* sp = (const f32x4*)(modf + ((size_t)(L * 5 + cd) * 6 + (which ? 3 : 0)) * DM) + lane;
        f32x4 wv[8], sv[8];
#pragma unroll
        for (int j = 0; j < 8; ++j) { wv[j] = wp[64 * j]; sv[j] = sp[64 * j]; }
        for (int rr = 0; rr < 8; ++rr) { const int row = r0 + rr;
            const float* src = first ? (row < NPROMPT ? P.xp + (size_t)row * DM : P.xs + (size_t)(row - NPROMPT) * DM) : X + (size_t)row * DM;
            const f32x4* xr = (const f32x4*)src + lane;
            f32x4 v[8]; float ss = 0.f;
#pragma unroll
            for (int j = 0; j < 8; ++j) { v[j] = xr[64 * j]; ss += (v[j][0] * v[j][0] + v[j][1] * v[j][1]) + (v[j][2] * v[j][2] + v[j][3] * v[j][3]); }
            const float rstd = 1.0f / sqrtf(wave_sum(ss) * (1.f / DM) + EPS);
            if (first) { f32x4* xo = (f32x4*)(X + (size_t)row * DM) + lane;
#pragma unroll
                for (int j = 0; j < 8; ++j) xo[64 * j] = v[j]; }
            v2u* ho = (v2u*)(H + (size_t)row * DM) + lane;
#pragma unroll
            for (int j = 0; j < 8; ++j) { const f32x4 h = v[j] * rstd * wv[j] + sv[j]; v2u o; o.x = pk2(h[0], h[1]); o.y = pk2(h[2], h[3]); ho[64 * j] = o; }
        }
    }
}
__device__ __forceinline__ void final_norm_phase() {
    const Ctx C = make_ctx(); const Ptrs P = make_ptrs(); const int gw = C.gw, NGW = C.NGW, lane = C.lane;
    const float* X = (const float*)(P.ws + WS_X);
    f32x4 wv[8];
#pragma unroll
    for (int j = 0; j < 8; ++j) wv[j] = ((const f32x4*)P.final_norm)[lane + 64 * j];
    for (int row = gw; row < NTOK; row += NGW) {
        const f32x4* xr = (const f32x4*)(X + (size_t)row * DM) + lane;
        f32x4 v[8]; float ss = 0.f;
#pragma unroll
        for (int j = 0; j < 8; ++j) { v[j] = xr[64 * j]; ss += (v[j][0] * v[j][0] + v[j][1] * v[j][1]) + (v[j][2] * v[j][2] + v[j][3] * v[j][3]); }
        const float rstd = 1.0f / sqrtf(wave_sum(ss) * (1.f / DM) + EPS);
        f32x4* yo = (f32x4*)(P.out + OUT_Y + (size_t)row * DM) + lane;
#pragma unroll
        for (int j = 0; j < 8; ++j) yo[64 * j] = v[j] * rstd * wv[j];
    }
}

__device__ __forceinline__ void conv_elem_phase(int jl) {
    const Ctx C = make_ctx(); const Ptrs P = make_ptrs(); const int gw = C.gw, NGW = C.NGW, lane = C.lane;
    const bf16* U = (const bf16*)(P.ws + WS_BIG); bf16* A2 = (bf16*)(P.ws + WS_A2); const float* cw = P.conv_w + (size_t)jl * 3 * DM;
    for (int item = gw; item < (NTOK / 16) * 4; item += NGW) {
        const int s = item >> 2, cb = item & 3, r0 = s * 16, c = cb * 512 + lane * 8;
        const int seqlen = r0 < NPROMPT ? 256 : SEQ_S, t0 = r0 & (seqlen - 1);
        float w0[8], w1[8], w2[8], zp[8], zc[8], zn[8];
#pragma unroll
        for (int e = 0; e < 8; ++e) { w0[e] = cw[c + e]; w1[e] = cw[DM + c + e]; w2[e] = cw[2 * DM + c + e]; }
#define CONV_Z(dst, row) do { const bf16* up = U + (size_t)(row) * 6144 + c; const bf16x8 cg = *(const bf16x8*)(up + DM), hv = *(const bf16x8*)(up + 2 * DM); \
        _Pragma("unroll") for (int e = 0; e < 8; ++e) dst[e] = bf2f(cg[e]) * bf2f(hv[e]); } while (0)
        if (t0 == 0) {
#pragma unroll
            for (int e = 0; e < 8; ++e) zp[e] = 0.f; }
        else CONV_Z(zp, r0 - 1);
        CONV_Z(zc, r0);
#pragma unroll 4
        for (int rr = 0; rr < 16; ++rr) { const int r = r0 + rr;
            if (t0 + rr == seqlen - 1) {
#pragma unroll
                for (int e = 0; e < 8; ++e) zn[e] = 0.f; }
            else CONV_Z(zn, r + 1);
            const bf16x8 bg = *(const bf16x8*)(U + (size_t)r * 6144 + c);
            float a[8];
#pragma unroll
            for (int e = 0; e < 8; ++e) { a[e] = bf2f(bg[e]) * (w0[e] * zp[e] + w1[e] * zc[e] + w2[e] * zn[e]); zp[e] = zc[e]; zc[e] = zn[e]; }
            v4u o; o.x = pk2(a[0], a[1]); o.y = pk2(a[2], a[3]); o.z = pk2(a[4], a[5]); o.w = pk2(a[6], a[7]);
            *(v4u*)(A2 + (size_t)r * DM + c) = o; }
#undef CONV_Z
    }
}

__device__ __forceinline__ void gmlp_spatial_phase(LAS unsigned char* lds) {
    const Ctx C = make_ctx(); const Ptrs P = make_ptrs(); const int G = C.G, c = C.bx;
    const int tid = C.tid, wid = tid >> 6, lane = tid & 63, r32 = lane & 31, hi = lane >> 5;
    const bf16* UV = (const bf16*)(P.ws + WS_BIG); bf16* A2 = (bf16*)(P.ws + WS_A2); const bf16* WSb = (const bf16*)(P.ws + WS_WS);
    LAS float* rs = (LAS float*)(lds + 65536);
    for (int u = c; u < 256; u += G) {
        const int n = u >> 1, hh = u & 1, R0 = n * 128;
        for (int qq = 0; qq < 16; ++qq) { const int q = wid * 16 + qq; const bf16* vr = UV + (size_t)(R0 + q) * 4096 + DM + lane * 8; float ss = 0.f;
#pragma unroll
            for (int j = 0; j < 4; ++j) { const bf16x8 x = *(const bf16x8*)(vr + 512 * j);
#pragma unroll
                for (int e = 0; e < 8; ++e) { const float f = bf2f(x[e]); ss += f * f; } }
            ss = wave_sum(ss); if (lane == 0) rs[q] = 1.0f / sqrtf(ss * (1.f / DM) + EPS); }
        __syncthreads();
        const int sr = tid >> 4, sc = (tid & 15) * 8, mi = wid & 3, dh = wid >> 2;
        for (int gi = 0; gi < 8; ++gi) { const int g = hh * 8 + gi, c0 = g * 128; LAS unsigned char* Vb = lds + (gi & 1) * 32768;
            const f32x4 ga = *(const f32x4*)(P.gmlp_g_v + c0 + sc), gb = *(const f32x4*)(P.gmlp_g_v + c0 + sc + 4);
#pragma unroll
            for (int i = 0; i < 4; ++i) { const int q = sr + 32 * i; const bf16x8 x = *(const bf16x8*)(UV + (size_t)(R0 + q) * 4096 + DM + c0 + sc); const float r = rs[q];
                v4u o; o.x = pk2(bf2f(x[0]) * r * ga[0], bf2f(x[1]) * r * ga[1]); o.y = pk2(bf2f(x[2]) * r * ga[2], bf2f(x[3]) * r * ga[3]);
                o.z = pk2(bf2f(x[4]) * r * gb[0], bf2f(x[5]) * r * gb[1]); o.w = pk2(bf2f(x[6]) * r * gb[2], bf2f(x[7]) * r * gb[3]);
                *(LAS v4u*)(Vb + (q >> 6) * 16384 + att::v_st(q & 63, sc)) = o; }
            __syncthreads();
            bf16x8 pa[2][4];
#pragma unroll
            for (int t = 0; t < 2; ++t)
#pragma unroll
                for (int s = 0; s < 4; ++s) pa[t][s] = *(const bf16x8*)(WSb + ((size_t)g * 128 + 32 * mi + r32) * 128 + 64 * t + 16 * s + 8 * hi);
            att::f32x16 od0 = {}, od1 = {};
#pragma unroll
            for (int t = 0; t < 2; ++t) { const int vb = (int)(unsigned)(size_t)Vb + t * 16384 + dh * 1024 + att::v_rd_base(lane);
                att::pv_one<0>(od0, vb, pa[t][0], pa[t][1], pa[t][2], pa[t][3]); att::pv_one<1>(od1, vb, pa[t][0], pa[t][1], pa[t][2], pa[t][3]); }
#pragma unroll
            for (int r = 0; r < 16; ++r) { const int p = 32 * mi + att::crow(r, hi); const float bias = P.gmlp_b_s[g * 128 + p]; const size_t row = (size_t)(R0 + p);
#pragma unroll
                for (int e = 0; e < 2; ++e) { const int col = c0 + 32 * (2 * dh + e) + r32; const float val = (e ? od1[r] : od0[r]) + bias;
                    const float uval = bf2f((short)UV[row * 4096 + col]); A2[row * DM + col] = (bf16)f2bf(uval * val); } }
        }
        __syncthreads();
    }
}

__device__ __forceinline__ void mla_thin_phase() {
    const Ctx C = make_ctx(); const Ptrs P = make_ptrs(); const int gw = C.gw, NGW = C.NGW, lane = C.lane;
    const bf16* ABF = (const bf16*)(P.ws + WS_ABF); bf16* QAN = (bf16*)(P.ws + WS_QAN); bf16* CKV = (bf16*)(P.ws + WS_CKV); bf16* KPE = (bf16*)(P.ws + WS_KPE); const float* rope = (const float*)(P.ws + WS_ROPE);
    const f32x4 gq0 = *(const f32x4*)(P.mla_g_q + lane * 8), gq1 = *(const f32x4*)(P.mla_g_q + lane * 8 + 4), gk0 = *(const f32x4*)(P.mla_g_kv + lane * 8), gk1 = *(const f32x4*)(P.mla_g_kv + lane * 8 + 4);
    for (int item = gw; item < NKVROWS; item += NGW) {
        if (item < NTOK) { const int row = item; const bf16* base = ABF + (size_t)row * 1280;
            const int dst = row < NPROMPT ? row : NPROMPT + ((row - NPROMPT) >> 11) * LKS + PAST + ((row - NPROMPT) & (SEQ_S - 1));
            { const bf16x8 x = *(const bf16x8*)(base + lane * 8); float f[8], ss = 0.f;
#pragma unroll
              for (int e = 0; e < 8; ++e) { f[e] = bf2f(x[e]); ss += f[e] * f[e]; }
              const float r = 1.0f / sqrtf(wave_sum(ss) * (1.f / 512) + EPS);
              v4u o; o.x = pk2(f[0] * r * gq0[0], f[1] * r * gq0[1]); o.y = pk2(f[2] * r * gq0[2], f[3] * r * gq0[3]); o.z = pk2(f[4] * r * gq1[0], f[5] * r * gq1[1]); o.w = pk2(f[6] * r * gq1[2], f[7] * r * gq1[3]);
              *(v4u*)(QAN + (size_t)row * 512 + lane * 8) = o; }
            { const bf16x8 x = *(const bf16x8*)(base + 512 + lane * 8); float f[8], ss = 0.f;
#pragma unroll
              for (int e = 0; e < 8; ++e) { f[e] = bf2f(x[e]); ss += f[e] * f[e]; }
              const float r = 1.0f / sqrtf(wave_sum(ss) * (1.f / 512) + EPS);
              f32x4 y0, y1;
#pragma unroll
              for (int e = 0; e < 4; ++e) { y0[e] = f[e] * r * gk0[e]; y1[e] = f[4 + e] * r * gk1[e]; }
              v4u o; o.x = pk2(y0[0], y0[1]); o.y = pk2(y0[2], y0[3]); o.z = pk2(y1[0], y1[1]); o.w = pk2(y1[2], y1[3]);
              *(v4u*)(CKV + (size_t)dst * 512 + lane * 8) = o;
              if (row < NPROMPT) { float* oc = P.out + OUT_CKV + (size_t)row * 512 + lane * 8; *(f32x4*)oc = y0; *(f32x4*)(oc + 4) = y1; } }
            { const float x = bf2f((short)base[1024 + lane]);
              if (row < NPROMPT) { P.out[OUT_KPE + (size_t)row * 64 + lane] = x; KPE[(size_t)dst * 64 + lane] = (bf16)f2bf(x); }
              else { const int t = (row - NPROMPT) & (SEQ_S - 1), w = lane & 31, j = w & 15, pos = (lane >> 5) ? (t & 63) : (t >> 6);
                  const float cs = rope[2 * (pos * 16 + j)], sn = rope[2 * (pos * 16 + j) + 1]; const float xo = __shfl_xor(x, 16);
                  const float y = (w >> 4) ? (xo * sn + x * cs) : (x * cs - xo * sn);
                  KPE[(size_t)dst * 64 + lane] = (bf16)f2bf(y); } }
        } else { const int cr = item - NTOK, b = cr >> 9, p = cr & (PAST - 1), dst = NPROMPT + b * LKS + p;
            const float* s = P.cache_ckv + (size_t)cr * 512 + lane * 8; const f32x4 a = *(const f32x4*)s, bb = *(const f32x4*)(s + 4);
            v4u o; o.x = pk2(a[0], a[1]); o.y = pk2(a[2], a[3]); o.z = pk2(bb[0], bb[1]); o.w = pk2(bb[2], bb[3]);
            *(v4u*)(CKV + (size_t)dst * 512 + lane * 8) = o;
            KPE[(size_t)dst * 64 + lane] = (bf16)f2bf(P.cache_kpe[(size_t)cr * 64 + lane]); }
    }
}

__device__ __forceinline__ void attn_phase(LAS unsigned char* lds) {
    const Ctx C = make_ctx(); const Ptrs P = make_ptrs(); const int G = C.G, c = C.bx;
    const bf16* Q = (const bf16*)(P.ws + WS_Q); const bf16* KV = (const bf16*)(P.ws + WS_KV); const bf16* KPE = (const bf16*)(P.ws + WS_KPE); bf16* O = (bf16*)(P.ws + WS_A2); const float* rope = (const float*)(P.ws + WS_ROPE);
    for (int id = c; id < 1024; id += G) {
        int h, qrow0, kvrow0, nkeys, rp, t0;
        if (id < 512) { const int x = id & 7, y = id >> 3, qb = y & 7, bh = x + 8 * (y >> 3), b = bh >> 4; h = bh & 15;
            qrow0 = NPROMPT + b * SEQ_S + qb * 256; kvrow0 = NPROMPT + b * LKS; nkeys = LKS; rp = 1; t0 = qb * 256; }
        else { const int i2 = id - 512, b = i2 >> 4; h = i2 & 15; qrow0 = b * 256; kvrow0 = b * 256; nkeys = 256; rp = 0; t0 = 0; }
        att::attn_unit(lds, Q + (size_t)qrow0 * att::LDQ + h * 192, KV + (size_t)kvrow0 * att::LDKV + h * 256, KPE + (size_t)kvrow0 * 64,
                       O + (size_t)qrow0 * att::LDO + h * 128, nkeys, rp, t0, rope);
    }
}

#ifndef EN_P0
#define EN_P0 1
#endif
#ifndef EN_NORM
#define EN_NORM 1
#endif
#ifndef EN_G1
#define EN_G1 1
#endif
#ifndef EN_THIN
#define EN_THIN 1
#endif
#ifndef EN_QKV
#define EN_QKV 1
#endif
#ifndef EN_ATT
#define EN_ATT 1
#endif
#ifndef EN_G2
#define EN_G2 1
#endif
#ifndef EN_W1
#define EN_W1 1
#endif
#ifndef EN_W2
#define EN_W2 1
#endif
constexpr int N_PHASE_IDS = 2 + 9 * NLAYER + 1;
__global__ void __launch_bounds__(NWAVES * 64, 2) mk_fwd(Args args) {
    extern __shared__ __attribute__((aligned(16))) unsigned char lds_raw[];
    LAS unsigned char* lds = (LAS unsigned char*)lds_raw;
    const int tid = threadIdx.x;
    unsigned char* ws0 = args.ws;
    if (tid < 4) ((LAS unsigned*)(lds + MISC_OFF))[tid] = 0u;
    __syncthreads();
    XcdBarrier bar = xcd_barrier_post((unsigned*)(ws0 + WS_CTL) + CW_BAR, (volatile LAS unsigned*)(lds + MISC_OFF));
    const int lo = args.ph_lo, hi = args.ph_hi; const bool fused = (hi - lo) > 1;
#define PH(id) (lo <= (id) && (id) < hi)
#define SEAM() do { if (fused) xcd_barrier(bar); } while (0)

    if (EN_P0 && PH(0)) { p0a_phase(lds); SEAM(); }
    if (EN_P0 && PH(1)) { p0b_phase(); SEAM(); }

    for (int L = 0; L < NLAYER; ++L) {
        const int kind = L % 3, jl = L / 3, pb = 2 + 9 * L;
        if (EN_NORM && PH(pb + 0)) { norm_phase(L, 0, L == 0); SEAM(); }
        if (EN_G1 && PH(pb + 1)) {
            const Ctx C = make_ctx(); const Ptrs P = make_ptrs(); unsigned char* ws = P.ws; const int G = C.G, bx = C.bx; const float* modf = (const float*)(ws + WS_MODF); (void)modf;
            const bf16* Bt = kind == 0 ? (const bf16*)(ws + WS_CIN) + (size_t)jl * 6144 * DM : kind == 1 ? (const bf16*)(ws + WS_GIN) : (const bf16*)(ws + WS_MLA_A);
            const int N = kind == 0 ? 6144 : kind == 1 ? 4096 : 1280;
            pg8::Gemm g{(const bf16*)(ws + WS_H), Bt, NTOK, N, DM}; pg8::StaticOrder S; S.init(NTOK, N, G, bx);
            pg8::EpiBf16 E{(bf16*)(ws + WS_BIG), N, 0};
            pg8::gemm_phase<pg8::EpiBf16, pg8::StaticOrder, true, true>(lds + RING_OFF, g, S, E);
            SEAM(); }
        if (EN_THIN && PH(pb + 2)) {
            if (kind == 0) conv_elem_phase(jl);
            else if (kind == 1) gmlp_spatial_phase(lds + RING_OFF);
            else mla_thin_phase();
            SEAM(); }
        if (kind == 2) {
            if (EN_QKV && PH(pb + 3)) {
                const Ctx C = make_ctx(); const Ptrs P = make_ptrs(); unsigned char* ws = P.ws; const int G = C.G, bx = C.bx; const float* modf = (const float*)(ws + WS_MODF); (void)modf;
                { pg8::Gemm g{(const bf16*)(ws + WS_QAN), (const bf16*)(ws + WS_QB), NTOK, 3072, 512}; pg8::StaticOrder S; S.init(NTOK, 3072, G, bx);
                  pg8::EpiBf16 E{(bf16*)(ws + WS_Q), 3072, 0};
                  pg8::gemm_phase<pg8::EpiBf16, pg8::StaticOrder, true, true>(lds + RING_OFF, g, S, E); }
                { pg8::Gemm g{(const bf16*)(ws + WS_CKV), (const bf16*)(ws + WS_KVB), NKVROWS, 4096, 512}; pg8::StaticOrder S; S.init(NKVROWS, 4096, G, bx);
                  pg8::EpiBf16 E{(bf16*)(ws + WS_KV), 4096, 0};
                  pg8::gemm_phase<pg8::EpiBf16, pg8::StaticOrder, true, true>(lds + RING_OFF, g, S, E); }
                SEAM(); }
            if (EN_ATT && PH(pb + 4)) { attn_phase(lds + RING_OFF); SEAM(); }
        }
        if (EN_G2 && PH(pb + 5)) {
            const Ctx C = make_ctx(); const Ptrs P = make_ptrs(); unsigned char* ws = P.ws; const int G = C.G, bx = C.bx; const float* modf = (const float*)(ws + WS_MODF); (void)modf;
            const bf16* Bt = kind == 0 ? (const bf16*)(ws + WS_COUT) + (size_t)jl * DM * DM : kind == 1 ? (const bf16*)(ws + WS_GOUT) : (const bf16*)(ws + WS_WO);
            pg8::Gemm g{(const bf16*)(ws + WS_A2), Bt, NTOK, DM, DM}; pg8::StaticOrder S; S.init(NTOK, DM, G, bx);
            pg8::EpiRes E{(float*)(ws + WS_X), modf + (size_t)L * 5 * MODROW + 2 * DM, DM, MODROW};
            pg8::gemm_phase<pg8::EpiRes, pg8::StaticOrder, true, true>(lds + RING_OFF, g, S, E);
            SEAM(); }
        if (EN_NORM && PH(pb + 6)) { norm_phase(L, 1, false); SEAM(); }
        if (EN_W1 && PH(pb + 7)) {
            const Ctx C = make_ctx(); const Ptrs P = make_ptrs(); unsigned char* ws = P.ws; const int G = C.G, bx = C.bx; const float* modf = (const float*)(ws + WS_MODF); (void)modf;
            pg8::Gemm g{(const bf16*)(ws + WS_H), (const bf16*)(ws + WS_W1) + (size_t)L * DFF * DM, NTOK, DFF, DM}; pg8::StaticOrder S; S.init(NTOK, DFF, G, bx);
            pg8::EpiBf16 E{(bf16*)(ws + WS_BIG), DFF, 1};
            pg8::gemm_phase<pg8::EpiBf16, pg8::StaticOrder, true, true>(lds + RING_OFF, g, S, E);
            SEAM(); }
        if (EN_W2 && PH(pb + 8)) {
            const Ctx C = make_ctx(); const Ptrs P = make_ptrs(); unsigned char* ws = P.ws; const int G = C.G, bx = C.bx; const float* modf = (const float*)(ws + WS_MODF); (void)modf;
            pg8::Gemm g{(const bf16*)(ws + WS_BIG), (const bf16*)(ws + WS_W2) + (size_t)L * DM * DFF, NTOK, DM, DFF}; pg8::StaticOrder S; S.init(NTOK, DM, G, bx);
            pg8::EpiRes E{(float*)(ws + WS_X), modf + (size_t)L * 5 * MODROW + 5 * DM, DM, MODROW};
            pg8::gemm_phase<pg8::EpiRes, pg8::StaticOrder, true, true>(lds + RING_OFF, g, S, E);
            SEAM(); }
    }
    if (EN_NORM && PH(N_PHASE_IDS - 1)) final_norm_phase();
#undef PH
#undef SEAM
}

extern "C" void kernel_launch(void* const* d_in, const int* in_sizes, int n_in, void* d_out, int out_size, void* d_ws, size_t ws_size, hipStream_t stream) {
    static int grid = 0;
    if (grid == 0) {
        if (n_in != 28 || in_sizes[0] != NPROMPT * DM || (size_t)out_size != OUT_END || ws_size < WS_END) {
            fprintf(stderr, "kernel_launch: built for 28 inputs, out of %zu floats, >= %zu bytes of workspace; got n_in %d, in0 %d, out %d, ws %zu; nothing launched\n", (size_t)OUT_END, (size_t)WS_END, n_in, n_in > 0 ? in_sizes[0] : -1, out_size, ws_size); grid = -1; return; }
        int dev = 0, cus = 0, per_cu = 0;
        if (hipGetDevice(&dev) != hipSuccess || hipDeviceGetAttribute(&cus, hipDeviceAttributeMultiprocessorCount, dev) != hipSuccess) { fprintf(stderr, "kernel_launch: device query failed\n"); grid = -1; return; }
        if (hipFuncSetAttribute((const void*)mk_fwd, hipFuncAttributeMaxDynamicSharedMemorySize, LDS_BYTES) != hipSuccess) { fprintf(stderr, "kernel_launch: hipFuncSetAttribute failed\n"); grid = -1; return; }
        if (hipOccupancyMaxActiveBlocksPerMultiprocessor(&per_cu, (const void*)mk_fwd, NWAVES * 64, LDS_BYTES) != hipSuccess || per_cu < 1)
            fprintf(stderr, "kernel_launch: note: the occupancy query reports %d workgroups per CU\n", per_cu);
        (void)hipGetLastError();
        grid = cus;
    }
    if (grid < 0) return;
    if (hipMemsetAsync((char*)d_ws + WS_CTL, 0, CTL_ZERO_BYTES, stream) != hipSuccess) { fprintf(stderr, "kernel_launch: hipMemsetAsync failed\n"); return; }
    Args a{};
    for (int i = 0; i < 28; ++i) a.in[i] = (const float*)d_in[i];
    a.out = (float*)d_out; a.ws = (unsigned char*)d_ws;
#if MK_MULTI
    for (int id = 0; id < N_PHASE_IDS; ++id) {
        if (id >= 2 && id < N_PHASE_IDS - 1) { const int L = (id - 2) / 9, slot = (id - 2) % 9; if ((slot == 3 || slot == 4) && (L % 3) != 2) continue; }
        a.ph_lo = id; a.ph_hi = id + 1;
        hipLaunchKernelGGL(mk_fwd, dim3(grid), dim3(NWAVES * 64), LDS_BYTES, stream, a);
    }
#else
    a.ph_lo = 0; a.ph_hi = N_PHASE_IDS;
    hipLaunchKernelGGL(mk_fwd, dim3(grid), dim3(NWAVES * 64), LDS_BYTES, stream, a);
#endif
    const hipError_t le = hipPeekAtLastError();
    if (le != hipSuccess) fprintf(stderr, "kernel_launch: launch failed: %s\n", hipGetErrorName(le));
}
```

```cpp
#include <hip/hip_runtime.h>
#include <cstdio>
#include <cstdint>
namespace pg8 {
#define PG8_LAS __attribute__((address_space(3)))
typedef unsigned short bf16_t;
typedef short bf16x8 __attribute__((ext_vector_type(8)));
typedef float f32x4 __attribute__((ext_vector_type(4)));
typedef unsigned u32x4 __attribute__((ext_vector_type(4)));
constexpr int BM = 256, BK = 64, HALF = 128, HTB = HALF * BK * 2  , STAGE_BYTES = 8 * HTB, NXCD = 8, WGM = 8;

__host__ __device__ __forceinline__ int lds_byte(int r, int c) { const int st = (r >> 4) * 2 + (c >> 5), rr = r & 15, cc = c & 31, ob = rr * 64 + cc * 2; return st * 1024 + (ob ^ (((ob >> 9) & 1) << 5)); }
__host__ __device__ __forceinline__ void stage_rc(int b, int& R, int& C) { const int st = b / 1024, sb = b % 1024, swz = sb ^ (((sb >> 9) & 1) << 5); R = (st >> 1) * 16 + swz / 64; C = (st & 1) * 32 + (swz % 64) / 2; }
__host__ __device__ __forceinline__ int perm32(int rho) { const int n = rho >> 4, i = rho & 15; return 8 * (i >> 2) + 4 * n + (i & 3); }

struct Unit { int pm, pn; };
struct Gemm { const bf16_t* A; const bf16_t* Bt; int M, N, K, krep; };

struct StaticOrder {
    int nM, nN, nwg, G, c;
    __host__ __device__ void init(int M, int N, int G_, int c_) { nM = M / BM; nN = N / BM; nwg = nM * nN; G = G_; c = c_; }
    __host__ __device__ bool next(int i, Unit& u) const {
        const long L = (long)i * G + c; if (L >= nwg) return false;
        int wgid = (int)L; { const int q = nwg / NXCD, r = nwg % NXCD, xcd = wgid % NXCD, off = wgid / NXCD; wgid = (xcd < r ? xcd * (q + 1) : r * (q + 1) + (xcd - r) * q) + off; }
        const int nig = WGM * nN, gid = wgid / nig, fm = gid * WGM, gsz = (nM - fm) < WGM ? (nM - fm) : WGM;
        u.pm = fm + ((wgid % nig) % gsz); u.pn = (wgid % nig) / gsz; return true;
    }
    __device__ __forceinline__ void a_ready(const Unit&) const {}
    __device__ __forceinline__ void done(const Unit&) const {}
};
__device__ __forceinline__ unsigned cvt_pk_bf16(float lo, float hi) { unsigned r; asm volatile("v_cvt_pk_bf16_f32 %0, %1, %2" : "=v"(r) : "v"(lo), "v"(hi)); return r; }
__device__ __forceinline__ int cond_of_tile(int pm) { return pm < 32 ? 0 : 1 + ((pm - 32) >> 3); }

struct EpiBf16 {
    static constexpr bool PERM = true, AFTER_DRAIN = false;
    bf16_t* O; int ldc; int act; float scale;
    __device__ __forceinline__ void operator()(const f32x4 (&acc)[2][2][4][2], const Unit& u, int wr, int wc, int fr, int fq) const {
        const int row0 = u.pm * BM + wr * 64 + fr, col0 = u.pn * BM + wc * 32 + 8 * fq;
        const f32x4 z4 = (f32x4){0.f, 0.f, 0.f, 0.f};
#pragma unroll
        for (int ai = 0; ai < 2; ++ai)
#pragma unroll
            for (int m = 0; m < 4; ++m) { bf16_t* rowp = O + (size_t)(row0 + ai * HALF + m * 16) * ldc + col0;
#pragma unroll
                for (int bj = 0; bj < 2; ++bj) { f32x4 v0 = acc[ai][bj][m][0] * scale, v1 = acc[ai][bj][m][1] * scale;
                    if (act) { v0 = __builtin_elementwise_max(v0, z4); v1 = __builtin_elementwise_max(v1, z4); v0 = v0 * v0; v1 = v1 * v1; }
                    u32x4 w; w.x = cvt_pk_bf16(v0[0], v0[1]); w.y = cvt_pk_bf16(v0[2], v0[3]); w.z = cvt_pk_bf16(v1[0], v1[1]); w.w = cvt_pk_bf16(v1[2], v1[3]);
                    *(u32x4*)(rowp + bj * HALF) = w; } }
    }
};
struct EpiRes {
    static constexpr bool PERM = true, AFTER_DRAIN = false;
    bf16_t* X; const float* gate; int ldx; int gstride; float scale;
    __device__ __forceinline__ void operator()(const f32x4 (&acc)[2][2][4][2], const Unit& u, int wr, int wc, int fr, int fq) const {
        const float* g = gate + (size_t)cond_of_tile(u.pm) * gstride;
        const int row0 = u.pm * BM + wr * 64 + fr, col0 = u.pn * BM + wc * 32 + 8 * fq;
        u32x4 old[2][4][2];
#pragma unroll
        for (int ai = 0; ai < 2; ++ai)
#pragma unroll
            for (int m = 0; m < 4; ++m)
#pragma unroll
                for (int bj = 0; bj < 2; ++bj) old[ai][m][bj] = *(const u32x4*)(X + (size_t)(row0 + ai * HALF + m * 16) * ldx + col0 + bj * HALF);
        f32x4 gv[2][2];
#pragma unroll
        for (int bj = 0; bj < 2; ++bj)
#pragma unroll
            for (int n = 0; n < 2; ++n) gv[bj][n] = *(const f32x4*)(g + col0 + bj * HALF + 4 * n) * scale;
#pragma unroll
        for (int ai = 0; ai < 2; ++ai)
#pragma unroll
            for (int m = 0; m < 4; ++m) { bf16_t* rowp = X + (size_t)(row0 + ai * HALF + m * 16) * ldx + col0;
#pragma unroll
                for (int bj = 0; bj < 2; ++bj) { const u32x4 o = old[ai][m][bj]; const f32x4 a0 = acc[ai][bj][m][0], a1 = acc[ai][bj][m][1]; const f32x4 g0 = gv[bj][0], g1 = gv[bj][1];
                    u32x4 w;
                    w.x = cvt_pk_bf16(__uint_as_float(o.x << 16) + g0[0] * a0[0], __uint_as_float(o.x & 0xffff0000u) + g0[1] * a0[1]);
                    w.y = cvt_pk_bf16(__uint_as_float(o.y << 16) + g0[2] * a0[2], __uint_as_float(o.y & 0xffff0000u) + g0[3] * a0[3]);
                    w.z = cvt_pk_bf16(__uint_as_float(o.z << 16) + g1[0] * a1[0], __uint_as_float(o.z & 0xffff0000u) + g1[1] * a1[1]);
                    w.w = cvt_pk_bf16(__uint_as_float(o.w << 16) + g1[2] * a1[2], __uint_as_float(o.w & 0xffff0000u) + g1[3] * a1[3]);
                    *(u32x4*)(rowp + bj * HALF) = w; } }
    }
};

template <class Epi, class Sched, bool ALIGN_EPI = false, bool SP2 = false>
__device__ __forceinline__ void gemm_phase(PG8_LAS unsigned char* lds, const Gemm g, const Sched& S, const Epi& E) {
    int tid_l = threadIdx.x; asm volatile("" : "+v"(tid_l));
    const int tid = tid_l, wid = __builtin_amdgcn_readfirstlane(tid >> 6), lane = tid & 63, wr = wid >> 2, wc = wid & 3, fr = lane & 15, fq = lane >> 4;
    const int K = g.K, nt = K / BK, ntt = nt * g.krep;
    unsigned voffA[2], voffB[2];
#pragma unroll
    for (int i = 0; i < 2; ++i) { int R, C; stage_rc(tid * 16 + i * 8192, R, C); const int Rb = Epi::PERM ? ((R & ~31) + perm32(R & 31)) : R;
        voffA[i] = (unsigned)(R * K + C) * 2u; voffB[i] = (unsigned)(Rb * K + C) * 2u; }
    const size_t kstep = (size_t)(BK * 2);
    const size_t hstep = (size_t)HALF * K * 2;
    const size_t tstep = 2 * hstep;
    const unsigned ldsw = (unsigned)wid * 1024u;
    const int aoff = lds_byte(wr * 64 + fr, fq * 8), boff = lds_byte(wc * 32 + fr, fq * 8);
#define PG8_SA(b, h) (((b) * 2 + (h)) * HTB)
#define PG8_SB(b, h) ((4 + (b) * 2 + (h)) * HTB)
#define PG8_STAGE(bufoff, gbase, voff) do { _Pragma("unroll") for (int _i = 0; _i < 2; ++_i) \
        __builtin_amdgcn_global_load_lds((const unsigned*)((const char*)(gbase) + (voff)[_i]), (PG8_LAS unsigned*)(lds + (bufoff) + ldsw + _i * 8192), 16, 0, 0); } while (0)
#define PG8_LDA(dst, b, h) do { _Pragma("unroll") for (int m = 0; m < 4; ++m) _Pragma("unroll") for (int k = 0; k < 2; ++k) dst[m][k] = *(const PG8_LAS bf16x8*)(lds + PG8_SA(b, h) + aoff + m * 2048 + k * 1024); } while (0)
#define PG8_LDB(dst, b, h) do { _Pragma("unroll") for (int n = 0; n < 2; ++n) _Pragma("unroll") for (int k = 0; k < 2; ++k) dst[n][k] = *(const PG8_LAS bf16x8*)(lds + PG8_SB(b, h) + boff + n * 2048 + k * 1024); } while (0)
#define PG8_MMA(ai, bj, At, Bt) do { __builtin_amdgcn_s_setprio(1); _Pragma("unroll") for (int m = 0; m < 4; ++m) _Pragma("unroll") for (int n = 0; n < 2; ++n) _Pragma("unroll") for (int k = 0; k < 2; ++k) \
        acc[ai][bj][m][n] = __builtin_amdgcn_mfma_f32_16x16x32_bf16(Bt[n][k], At[m][k], acc[ai][bj][m][n], 0, 0, 0); __builtin_amdgcn_s_setprio(0); } while (0)
#define PG8_WAIT_V(n) asm volatile("s_waitcnt vmcnt(" #n ")" ::: "memory")
#define PG8_WAIT_L(n) asm volatile("s_waitcnt lgkmcnt(" #n ")" ::: "memory")
#define PG8_BAR __builtin_amdgcn_s_barrier()
#define PG8_SCHED __builtin_amdgcn_sched_barrier(0)
    Unit cur, nxt; int ui = 0;
    if (!S.next(0, cur)) return;
    f32x4 acc[2][2][4][2];
#pragma unroll
    for (int a = 0; a < 2; ++a)
#pragma unroll
        for (int b = 0; b < 2; ++b)
#pragma unroll
            for (int m = 0; m < 4; ++m)
#pragma unroll
                for (int n = 0; n < 2; ++n) acc[a][b][m][n] = (f32x4){0.f, 0.f, 0.f, 0.f};
    bf16x8 At[4][2], B0[2][2], B1[2][2];
    const char* cA = (const char*)g.A + (size_t)cur.pm * tstep; const char* cB = (const char*)g.Bt + (size_t)cur.pn * tstep;
    S.a_ready(cur);
    if constexpr (SP2) {
        PG8_STAGE(PG8_SB(0, 0), cB, voffB); PG8_STAGE(PG8_SB(0, 1), cB + hstep, voffB); PG8_STAGE(PG8_SA(0, 0), cA, voffA); PG8_STAGE(PG8_SA(0, 1), cA + hstep, voffA);
        if (wr == 1) PG8_BAR;
        PG8_WAIT_V(2); PG8_BAR;
        PG8_STAGE(PG8_SB(1, 0), cB + kstep, voffB); PG8_STAGE(PG8_SA(1, 0), cA + kstep, voffA); PG8_STAGE(PG8_SB(1, 1), cB + hstep + kstep, voffB);
        PG8_WAIT_V(6); PG8_BAR;
    } else {
        PG8_STAGE(PG8_SB(0, 0), cB, voffB); PG8_STAGE(PG8_SA(0, 0), cA, voffA); PG8_STAGE(PG8_SB(0, 1), cB + hstep, voffB); PG8_STAGE(PG8_SA(0, 1), cA + hstep, voffA);
        if (wr == 1) PG8_BAR;
        PG8_WAIT_V(4); PG8_BAR;
        PG8_STAGE(PG8_SB(1, 0), cB + kstep, voffB); PG8_STAGE(PG8_SA(1, 0), cA + kstep, voffA); PG8_STAGE(PG8_SB(1, 1), cB + hstep + kstep, voffB);
        PG8_WAIT_V(6); PG8_BAR;
    }
    for (;;) {
        const bool has_next = S.next(ui + 1, nxt);
        const char* nA = has_next ? (const char*)g.A + (size_t)nxt.pm * tstep : cA; const char* nB = has_next ? (const char*)g.Bt + (size_t)nxt.pn * tstep : cB;
        for (int t = 0, tm = 0; t < ntt; t += 2, tm = (tm + 2 == nt ? 0 : tm + 2)) {
            const bool last = (t == ntt - 2); const int tm2 = (tm + 2 == nt) ? 0 : tm + 2;
            const char* a1 = cA + (size_t)(tm + 1) * kstep;
            const char* a2 = last ? nA : cA + (size_t)tm2 * kstep; const char* b2 = last ? nB : cB + (size_t)tm2 * kstep;
            const char* a3 = a2 + kstep; const char* b3 = b2 + kstep;
            if (last && has_next) S.a_ready(nxt);
            if constexpr (SP2) {
            PG8_LDB(B0, 0, 0); PG8_LDB(B1, 0, 1); PG8_SCHED; PG8_LDA(At, 0, 0); PG8_STAGE(PG8_SA(1, 1), a1 + hstep, voffA);
            PG8_WAIT_V(8); PG8_WAIT_L(0); PG8_BAR; PG8_MMA(0, 0, At, B0); PG8_MMA(0, 1, At, B1); PG8_BAR; PG8_SCHED;
            PG8_LDA(At, 0, 1); PG8_STAGE(PG8_SB(0, 0), b2, voffB); PG8_STAGE(PG8_SB(0, 1), b2 + hstep, voffB); PG8_STAGE(PG8_SA(0, 0), a2, voffA);
            PG8_WAIT_V(8); PG8_WAIT_L(0); PG8_BAR; PG8_MMA(1, 0, At, B0); PG8_MMA(1, 1, At, B1); PG8_BAR; PG8_SCHED;
            PG8_LDB(B0, 1, 0); PG8_LDB(B1, 1, 1); PG8_SCHED; PG8_LDA(At, 1, 0); PG8_STAGE(PG8_SA(0, 1), a2 + hstep, voffA);
            PG8_WAIT_V(8); PG8_WAIT_L(0); PG8_BAR; PG8_MMA(0, 0, At, B0); PG8_MMA(0, 1, At, B1); PG8_BAR; PG8_SCHED;
            PG8_LDA(At, 1, 1); PG8_STAGE(PG8_SB(1, 0), b3, voffB); PG8_STAGE(PG8_SB(1, 1), b3 + hstep, voffB); PG8_STAGE(PG8_SA(1, 0), a3, voffA);
            PG8_WAIT_V(8); PG8_WAIT_L(0); PG8_BAR; PG8_MMA(1, 0, At, B0); PG8_MMA(1, 1, At, B1); PG8_BAR; PG8_SCHED;
            } else {
            PG8_LDB(B0, 0, 0); PG8_SCHED; PG8_LDA(At, 0, 0); PG8_STAGE(PG8_SA(1, 1), a1 + hstep, voffA);
            PG8_WAIT_L(8); PG8_BAR; PG8_WAIT_L(0); PG8_MMA(0, 0, At, B0); PG8_BAR; PG8_SCHED;
            PG8_LDB(B1, 0, 1); PG8_STAGE(PG8_SB(0, 0), b2, voffB);
            PG8_BAR; PG8_WAIT_L(0); PG8_MMA(0, 1, At, B1); PG8_BAR;
            PG8_LDA(At, 0, 1); PG8_STAGE(PG8_SA(0, 0), a2, voffA);
            PG8_BAR; PG8_WAIT_L(0); PG8_MMA(1, 0, At, B0); PG8_BAR; PG8_SCHED;
            PG8_STAGE(PG8_SB(0, 1), b2 + hstep, voffB);
            PG8_WAIT_V(6); PG8_BAR; PG8_MMA(1, 1, At, B1); PG8_BAR;
            PG8_LDB(B0, 1, 0); PG8_SCHED; PG8_LDA(At, 1, 0); PG8_STAGE(PG8_SA(0, 1), a2 + hstep, voffA);
            PG8_WAIT_L(8); PG8_BAR; PG8_WAIT_L(0); PG8_MMA(0, 0, At, B0); PG8_BAR; PG8_SCHED;
            PG8_LDB(B1, 1, 1); PG8_STAGE(PG8_SB(1, 0), b3, voffB);
            PG8_BAR; PG8_WAIT_L(0); PG8_MMA(0, 1, At, B1); PG8_BAR;
            PG8_LDA(At, 1, 1); PG8_STAGE(PG8_SA(1, 0), a3, voffA);
            PG8_BAR; PG8_WAIT_L(0); PG8_MMA(1, 0, At, B0); PG8_BAR; PG8_SCHED;
            PG8_STAGE(PG8_SB(1, 1), b3 + hstep, voffB);
            PG8_WAIT_V(6); PG8_BAR; PG8_MMA(1, 1, At, B1); PG8_BAR;
            }
        }
        if constexpr (ALIGN_EPI) { if (wr == 0) PG8_BAR; }
        if constexpr (!Epi::AFTER_DRAIN) { E(acc, cur, wr, wc, fr, fq); S.done(cur); }
        if (!has_next) break;
#pragma unroll
        for (int a = 0; a < 2; ++a)
#pragma unroll
            for (int b = 0; b < 2; ++b)
#pragma unroll
                for (int m = 0; m < 4; ++m)
#pragma unroll
                    for (int n = 0; n < 2; ++n) acc[a][b][m][n] = (f32x4){0.f, 0.f, 0.f, 0.f};
        cur = nxt; cA = nA; cB = nB; ++ui;
        if constexpr (ALIGN_EPI) { if (wr == 1) PG8_BAR; }
    }
    PG8_WAIT_V(0);
    if constexpr (!ALIGN_EPI) { if (wr == 0) PG8_BAR; }
    PG8_BAR;
    if constexpr (Epi::AFTER_DRAIN) { E.fused(acc, cur, wr, wc, fr, fq, lds, wid, lane); S.done(cur); }
#undef PG8_SA
#undef PG8_SB
#undef PG8_STAGE
#undef PG8_LDA
#undef PG8_LDB
#undef PG8_MMA
#undef PG8_WAIT_V
#undef PG8_WAIT_L
#undef PG8_BAR
#undef PG8_SCHED
}
}
namespace att {
#define ATT_LAS __attribute__((address_space(3)))
typedef unsigned short bf16_t;
using bf16x8 = __attribute__((ext_vector_type(8))) short;
using s16x4  = __attribute__((ext_vector_type(4))) short;
using f32x16 = __attribute__((ext_vector_type(16))) float;
using f32x4  = __attribute__((ext_vector_type(4))) float;
using u32x4  = __attribute__((ext_vector_type(4))) unsigned;
constexpr int NW = 8, QBLK = 32, KVBLK = 64;
constexpr int LDQ = 3072, LDKV = 4096, LDO = 2048, LDKPE = 64;
constexpr float SCALE = 0.07216878364870322f;
constexpr float THR = 8.f;
constexpr int SHM_V = KVBLK * 128 * 2, SHM_K = KVBLK * 192 * 2;
constexpr int OFF_V = 0, OFF_K = 2 * SHM_V, OFF_WS = OFF_K + 2 * SHM_K, LDS_BYTES = OFF_WS + NW * 64 * 4;
#define ATT_KSWZ(row, colB) ((row) * 384 + ((colB) ^ (((row) & 7) << 4)))
#define ATT_SBAR() __builtin_amdgcn_sched_barrier(0)
__device__ __forceinline__ int crow(int r, int hi) { return (r & 3) + 8 * (r >> 2) + 4 * hi; }
__device__ __forceinline__ unsigned cvtpk(float lo, float hi) { unsigned r; asm volatile("v_cvt_pk_bf16_f32 %0, %1, %2" : "=v"(r) : "v"(lo), "v"(hi)); return r; }
__device__ __forceinline__ float bf2f(short s) { return __uint_as_float(((unsigned)(unsigned short)s) << 16); }

__device__ __forceinline__ void partialSM(f32x16& p0, f32x16& p1, float& m_reg, float& mn, float& alpha) {
  constexpr float C = SCALE * 1.4426950408889634f;
  float pmax = p0[0];
#pragma unroll
  for (int r = 1; r < 16; ++r) pmax = fmaxf(pmax, p0[r]);
#pragma unroll
  for (int r = 0; r < 16; ++r) pmax = fmaxf(pmax, p1[r]);
  { auto rr = __builtin_amdgcn_permlane32_swap(__float_as_uint(pmax), __float_as_uint(pmax), false, false);
    pmax = fmaxf(__uint_as_float(rr[0]), __uint_as_float(rr[1])); }
  if (__builtin_expect(__all(pmax - m_reg <= THR / SCALE), 1)) { mn = m_reg; alpha = 1.f; }
  else { mn = fmaxf(m_reg, pmax); alpha = __builtin_amdgcn_exp2f((m_reg - mn) * C); m_reg = mn; }
  float mnC = -mn * C;
#pragma unroll
  for (int r = 0; r < 16; ++r) p0[r] = fmaf(p0[r], C, mnC);
#pragma unroll
  for (int r = 0; r < 16; ++r) p1[r] = fmaf(p1[r], C, mnC);
#pragma unroll
  for (int r = 0; r < 16; ++r) p0[r] = __builtin_amdgcn_exp2f(p0[r]);
}
__device__ __forceinline__ void finishSM(f32x16& p0, f32x16& p1, float alpha, float& l_reg, bf16x8& pa0, bf16x8& pa1, bf16x8& pa2, bf16x8& pa3) {
#pragma unroll
  for (int r = 0; r < 16; ++r) p1[r] = __builtin_amdgcn_exp2f(p1[r]);
  float ps = 0;
#pragma unroll
  for (int r = 0; r < 16; ++r) ps += p0[r];
#pragma unroll
  for (int r = 0; r < 16; ++r) ps += p1[r];
  { auto rr = __builtin_amdgcn_permlane32_swap(__float_as_uint(ps), __float_as_uint(ps), false, false);
    ps = __uint_as_float(rr[0]) + __uint_as_float(rr[1]); }
  l_reg = l_reg * alpha + ps;
#define ATT_PK4(P, BASE, OUT) do { unsigned a0 = cvtpk(P[BASE + 0], P[BASE + 1]), a1 = cvtpk(P[BASE + 2], P[BASE + 3]);   \
    unsigned b0 = cvtpk(P[BASE + 4], P[BASE + 5]), b1 = cvtpk(P[BASE + 6], P[BASE + 7]);                              \
    auto r0 = __builtin_amdgcn_permlane32_swap(a0, b0, false, false); auto r1 = __builtin_amdgcn_permlane32_swap(a1, b1, false, false); \
    u32x4 w = {r0[0], r1[0], r0[1], r1[1]}; OUT = __builtin_bit_cast(bf16x8, w); } while (0)
  ATT_PK4(p0, 0, pa0); ATT_PK4(p0, 8, pa1); ATT_PK4(p1, 0, pa2); ATT_PK4(p1, 8, pa3);
#undef ATT_PK4
}
__device__ __forceinline__ void qkt(f32x16& p0, f32x16& p1, const ATT_LAS char* Ks, const bf16x8 (&qr)[12], int r32, int hi) {
  p0 = f32x16{}; p1 = f32x16{};
#pragma unroll
  for (int d0 = 0; d0 < 12; ++d0) { const int cb = (d0 * 16 + hi * 8) * 2;
    const bf16x8 b0 = *reinterpret_cast<const ATT_LAS bf16x8*>(Ks + ATT_KSWZ(r32, cb));
    const bf16x8 b1 = *reinterpret_cast<const ATT_LAS bf16x8*>(Ks + ATT_KSWZ(32 + r32, cb));
    p0 = __builtin_amdgcn_mfma_f32_32x32x16_bf16(b0, qr[d0], p0, 0, 0, 0);
    p1 = __builtin_amdgcn_mfma_f32_32x32x16_bf16(b1, qr[d0], p1, 0, 0, 0); }
}
__device__ __forceinline__ int v_st(int k, int c) { const int kk = (k & ~0xC) | ((k & 4) << 1) | ((k & 8) >> 1); return ((kk >> 3) * 4 + (c >> 5)) * 512 + ((kk & 7) * 32 + (c & 31)) * 2; }
__device__ __forceinline__ int v_rd_base(int lane) { return ((lane & 3) << 3) | (((lane >> 2) & 3) << 6) | (((lane >> 4) & 1) << 5) | (((lane >> 5) & 1) << 8); }
constexpr int v_rd_off(int d0, int ks, int half) { return d0 * 512 + ks * 4096 + half * 2048; }
template <int OFF> __device__ __forceinline__ s16x4 tr_read(int vb) {
  s16x4 r; asm volatile("ds_read_b64_tr_b16 %0, %1 offset:%2" : "=&v"(r) : "v"(vb), "i"(OFF) : "memory"); return r;
}
template <int D0> __device__ __forceinline__ void pv_one(f32x16& od, int vb, bf16x8 pa0, bf16x8 pa1, bf16x8 pa2, bf16x8 pa3) {
  const s16x4 l0 = tr_read<v_rd_off(D0, 0, 0)>(vb), h0 = tr_read<v_rd_off(D0, 0, 1)>(vb), l1 = tr_read<v_rd_off(D0, 1, 0)>(vb), h1 = tr_read<v_rd_off(D0, 1, 1)>(vb);
  const s16x4 l2 = tr_read<v_rd_off(D0, 2, 0)>(vb), h2 = tr_read<v_rd_off(D0, 2, 1)>(vb), l3 = tr_read<v_rd_off(D0, 3, 0)>(vb), h3 = tr_read<v_rd_off(D0, 3, 1)>(vb);
  asm volatile("s_waitcnt lgkmcnt(0)" ::: "memory"); ATT_SBAR();
#define ATT_PK(L, H) (bf16x8){L[0], L[1], L[2], L[3], H[0], H[1], H[2], H[3]}
  od = __builtin_amdgcn_mfma_f32_32x32x16_bf16(pa0, ATT_PK(l0, h0), od, 0, 0, 0);
  od = __builtin_amdgcn_mfma_f32_32x32x16_bf16(pa1, ATT_PK(l1, h1), od, 0, 0, 0);
  od = __builtin_amdgcn_mfma_f32_32x32x16_bf16(pa2, ATT_PK(l2, h2), od, 0, 0, 0);
  od = __builtin_amdgcn_mfma_f32_32x32x16_bf16(pa3, ATT_PK(l3, h3), od, 0, 0, 0);
#undef ATT_PK
}

__device__ __forceinline__ void attn_unit(ATT_LAS unsigned char* lds, const bf16_t* __restrict__ Q, const bf16_t* __restrict__ KV, const bf16_t* __restrict__ KPE,
                                          bf16_t* __restrict__ O, int nkeys, int rope, int t0, const float* __restrict__ ROPE) {
  int tid_l = threadIdx.x; asm volatile("" : "+v"(tid_l));
  const int tid = tid_l, wid = tid >> 6, lane = tid & 63, r32 = lane & 31, hi = lane >> 5;
  ATT_LAS char* V_lds = (ATT_LAS char*)lds + OFF_V; ATT_LAS char* K_lds = (ATT_LAS char*)lds + OFF_K;
  ATT_LAS float* wsf = (ATT_LAS float*)((ATT_LAS char*)lds + OFF_WS) + wid * 64; ATT_LAS float* li_l = wsf; ATT_LAS float* al_l = wsf + 32;
  float m_reg = -1e30f, l_reg = 0.f; f32x16 o[4] = {}; bf16x8 qr[12];
  const bf16_t* Qw = Q + (size_t)(wid * QBLK + r32) * LDQ + hi * 8;
#pragma unroll
  for (int d0 = 0; d0 < 12; ++d0) qr[d0] = *reinterpret_cast<const bf16x8*>(Qw + d0 * 16);
  if (rope) {
    const int t = t0 + wid * QBLK + r32;
#pragma unroll
    for (int hf = 0; hf < 2; ++hf) {
      const int pos = hf ? (t & 63) : (t >> 6);
      const f32x4* tp = reinterpret_cast<const f32x4*>(ROPE + (size_t)(pos * 16 + hi * 8) * 2);
      const bf16x8 a = qr[8 + 2 * hf], b = qr[9 + 2 * hf]; u32x4 na, nb;
#pragma unroll
      for (int q = 0; q < 4; ++q) { const f32x4 cs = tp[q];
        const float x1a = bf2f(a[2 * q]), x2a = bf2f(b[2 * q]), x1b = bf2f(a[2 * q + 1]), x2b = bf2f(b[2 * q + 1]);
        na[q] = cvtpk(x1a * cs[0] - x2a * cs[1], x1b * cs[2] - x2b * cs[3]);
        nb[q] = cvtpk(x1a * cs[1] + x2a * cs[0], x1b * cs[3] + x2b * cs[2]); }
      qr[8 + 2 * hf] = __builtin_bit_cast(bf16x8, na); qr[9 + 2 * hf] = __builtin_bit_cast(bf16x8, nb);
    }
  }
  const int sr = tid >> 4, sc = (tid & 15) * 8, vst0 = v_st(sr, sc), vst1 = v_st(32 + sr, sc), kr = tid >> 3, kc = (tid & 7) * 8;
  const int vb0 = (int)(unsigned)(size_t)V_lds + v_rd_base(lane);
  bf16x8 vs0, vs1, ks0, ks1, kp0;
#define ATT_SLOAD(k0) do { const bf16_t* kvp = KV + (size_t)((k0) + sr) * LDKV + sc; \
    ks0 = *reinterpret_cast<const bf16x8*>(kvp); ks1 = *reinterpret_cast<const bf16x8*>(kvp + (size_t)32 * LDKV); \
    vs0 = *reinterpret_cast<const bf16x8*>(kvp + 128); vs1 = *reinterpret_cast<const bf16x8*>(kvp + (size_t)32 * LDKV + 128); \
    kp0 = *reinterpret_cast<const bf16x8*>(KPE + (size_t)((k0) + kr) * LDKPE + kc); } while (0)
#define ATT_SWRITE(b) do { *reinterpret_cast<ATT_LAS bf16x8*>(V_lds + (b) * SHM_V + vst0) = vs0; *reinterpret_cast<ATT_LAS bf16x8*>(V_lds + (b) * SHM_V + vst1) = vs1; \
    *reinterpret_cast<ATT_LAS bf16x8*>(K_lds + (b) * SHM_K + ATT_KSWZ(sr, sc * 2)) = ks0; *reinterpret_cast<ATT_LAS bf16x8*>(K_lds + (b) * SHM_K + ATT_KSWZ(32 + sr, sc * 2)) = ks1; \
    *reinterpret_cast<ATT_LAS bf16x8*>(K_lds + (b) * SHM_K + ATT_KSWZ(kr, 256 + kc * 2)) = kp0; } while (0)
  const int NT = nkeys / KVBLK;
  ATT_SLOAD(0); ATT_SWRITE(0); __syncthreads();
  for (int j = 0; j < NT; ++j) {
    const int b = j & 1;
    if (j + 1 < NT) ATT_SLOAD((j + 1) * KVBLK);
    f32x16 p0, p1; float mn, alpha; bf16x8 pa0, pa1, pa2, pa3;
    qkt(p0, p1, K_lds + b * SHM_K, qr, r32, hi);
    partialSM(p0, p1, m_reg, mn, alpha);
    if (__any(alpha < 1.f)) {
      if (hi == 0) al_l[r32] = alpha;
      asm volatile("s_waitcnt lgkmcnt(0)" ::: "memory");
#pragma unroll
      for (int r = 0; r < 16; ++r) { const float av = al_l[crow(r, hi)];
#pragma unroll
        for (int d = 0; d < 4; ++d) o[d][r] *= av; }
    }
    finishSM(p0, p1, alpha, l_reg, pa0, pa1, pa2, pa3); ATT_SBAR();
    const int vb = vb0 + b * SHM_V;
    pv_one<0>(o[0], vb, pa0, pa1, pa2, pa3); pv_one<1>(o[1], vb, pa0, pa1, pa2, pa3); pv_one<2>(o[2], vb, pa0, pa1, pa2, pa3); pv_one<3>(o[3], vb, pa0, pa1, pa2, pa3);
    if (j + 1 < NT) ATT_SWRITE(b ^ 1);
    __syncthreads();
  }
  if (hi == 0) li_l[r32] = l_reg;
  asm volatile("s_waitcnt lgkmcnt(0)" ::: "memory");
  bf16_t* Ow = O + (size_t)(wid * QBLK) * LDO;
#pragma unroll
  for (int r = 0; r < 16; ++r) { const int orow = crow(r, hi); const float rl = __builtin_amdgcn_rcpf(li_l[orow]);
#pragma unroll
    for (int d0 = 0; d0 < 4; ++d0) { const float v = o[d0][r] * rl; unsigned u = __float_as_uint(v); u += 0x7fffu + ((u >> 16) & 1u);
      Ow[(size_t)orow * LDO + d0 * 32 + r32] = (bf16_t)(u >> 16); } }
  asm volatile("s_waitcnt lgkmcnt(0)" ::: "memory");
#undef ATT_SLOAD
#undef ATT_SWRITE
}
}

constexpr int NWAVES = 8;
constexpr int DM = 2048, NTOK = 16384, NPROMPT = 8192, DFF = 8192, NLAYER = 4;
constexpr int SEQ_S = 2048, PAST = 512, LKS = PAST + SEQ_S, NKVROWS = NPROMPT + 4 * LKS;
constexpr int MODROW = 6 * DM;
constexpr int KS_MOD = 16;
constexpr float EPS = 1e-6f;
#ifndef MK_MULTI
#define MK_MULTI 0
#endif

constexpr size_t MiB = 1u << 20;
constexpr size_t WS_CTL = 0, CTL_ZERO_BYTES = 32768;
constexpr size_t WS_MODF = 1 * MiB;
constexpr size_t WS_ROPE = WS_MODF + (size_t)NLAYER * 5 * MODROW * 4;
constexpr size_t WS_MODP = 2 * MiB;
constexpr size_t WS_WS = 17 * MiB;
constexpr size_t WS_MLA_A = 18 * MiB;
constexpr size_t WS_QB = 23 * MiB, WS_KVB = 26 * MiB, WS_WO = 30 * MiB;
constexpr size_t WS_GIN = 38 * MiB, WS_GOUT = 54 * MiB;
constexpr size_t WS_COUT = 62 * MiB, WS_CIN = 78 * MiB;
constexpr size_t WS_W1 = 126 * MiB, WS_W2 = 254 * MiB;
constexpr size_t WS_X = 382 * MiB;
constexpr size_t WS_H = 510 * MiB;
constexpr size_t WS_A2 = 574 * MiB;
constexpr size_t WS_BIG = 638 * MiB;
constexpr size_t WS_ABF = WS_BIG, WS_Q = WS_BIG + 40 * MiB, WS_QAN = WS_BIG + 136 * MiB, WS_CKV = WS_BIG + 152 * MiB, WS_KPE = WS_BIG + 170 * MiB;
constexpr size_t WS_KV = 894 * MiB;
constexpr size_t WS_END = 1038 * MiB;
static_assert(WS_ROPE + 64 * 16 * 2 * 4 <= WS_MODP && WS_MODP + (size_t)KS_MOD * NLAYER * 5 * MODROW * 4 <= WS_WS && WS_KPE + (size_t)NKVROWS * 64 * 2 <= WS_KV, "d_ws map");
constexpr int CW_BAR = 4096;
constexpr size_t OUT_Y = 0, OUT_CKV = (size_t)NTOK * DM, OUT_KPE = OUT_CKV + (size_t)NPROMPT * 512, OUT_END = OUT_KPE + (size_t)NPROMPT * 64;

constexpr int RING_OFF = 0, RING_BYTES = 131072;
constexpr int MISC_OFF = RING_BYTES;
constexpr int LDS_BYTES = 147456;
static_assert(att::LDS_BYTES <= RING_BYTES, "attention LDS");

#define GAS __attribute__((address_space(1)))
#define LAS __attribute__((address_space(3)))
typedef unsigned short bf16;
typedef unsigned v4u __attribute__((ext_vector_type(4)));
typedef unsigned v2u __attribute__((ext_vector_type(2)));
typedef float f32x4 __attribute__((ext_vector_type(4)));
typedef short bf16x8 __attribute__((ext_vector_type(8)));
#define LDS_WAIT() asm volatile("s_waitcnt lgkmcnt(0)" ::: "memory")
#define VM_WAIT() asm volatile("s_waitcnt vmcnt(0)" ::: "memory")
__device__ __forceinline__ unsigned f2bf(float f) { unsigned u = __builtin_bit_cast(unsigned, f); return (u + 0x7fffu + ((u >> 16) & 1u)) >> 16; }
__device__ __forceinline__ unsigned pk2(float lo, float hi) { return f2bf(lo) | (f2bf(hi) << 16); }
__device__ __forceinline__ float bf2f(short s) { return __uint_as_float(((unsigned)(unsigned short)s) << 16); }
__device__ __forceinline__ float wave_sum(float v) {
#pragma unroll
    for (int o = 1; o < 64; o <<= 1) v += __shfl_xor(v, o);
    return v;
}
__device__ __forceinline__ int cond_of_row(int row) { return row < NPROMPT ? 0 : 1 + ((row - NPROMPT) >> 11); }

#define XB_TMO      128
#define XB_XCNT(j)  (256  + 64 * (j))
#define XB_XSUB(j)  (1280 + 64 * (j))
#define XB_XGEN(j)  (2304 + 64 * (j))
#define XB_TOP      3328
#define XB_TOPGEN   3392
#define XCD_BAR_WORDS 3456
#define XB_SPIN_CAP (1u << 18)

__device__ __forceinline__ unsigned xb_ld(unsigned* p)              { return __hip_atomic_load(p, __ATOMIC_RELAXED, __HIP_MEMORY_SCOPE_AGENT); }
__device__ __forceinline__ unsigned xb_add(unsigned* p, unsigned v) { return __hip_atomic_fetch_add(p, v, __ATOMIC_RELAXED, __HIP_MEMORY_SCOPE_AGENT); }
__device__ __forceinline__ unsigned xb_xcc_id() { return (unsigned)__builtin_amdgcn_s_getreg((3 << 11) | 20) & 0xFu; }
#define XB_SPIN(cond, bar) do { unsigned _sp = 0; while (cond) { __builtin_amdgcn_s_sleep(1); \
    if ((++_sp & 255u) == 0u) { if (xb_ld(&(bar)[XB_TMO])) break; if (_sp > XB_SPIN_CAP) { atomicAdd(&(bar)[XB_TMO], 1u); break; } } } } while (0)

struct XcdBarrier {
    unsigned* bar; unsigned x;
    volatile LAS unsigned* st;
};

__device__ __forceinline__ XcdBarrier xcd_barrier_post(unsigned* bar, volatile LAS unsigned* st) {
    XcdBarrier b; b.bar = bar; b.x = xb_xcc_id(); b.st = st;
    if (threadIdx.x == 0) (void)xb_add(&bar[XB_XCNT(b.x)], 1u);
    return b;
}
__device__ __forceinline__ void xcd_barrier_complete(unsigned* bar, unsigned x, unsigned& nloc, unsigned& nx) {
    const unsigned G = gridDim.x * gridDim.y * gridDim.z;
    unsigned sum, cnt, mine, sp = 0u;
    for (;;) {
        sum = 0u; cnt = 0u; mine = 0u;
#pragma unroll
        for (unsigned j = 0; j < 16; ++j) { const unsigned c = xb_ld(&bar[XB_XCNT(j)]); sum += c; cnt += (c > 0u) ? 1u : 0u; mine = (j == x) ? c : mine; }
        if (sum == G) break;
        __builtin_amdgcn_s_sleep(1);
        if ((++sp & 255u) == 0u) { if (xb_ld(&bar[XB_TMO])) break; if (sp > XB_SPIN_CAP) { atomicAdd(&bar[XB_TMO], 1u); break; } }
    }
    nloc = mine > 0u ? mine : 1u; nx = cnt > 0u ? cnt : 1u;
}

__device__ __forceinline__ void xcd_barrier(const XcdBarrier& b) {
    asm volatile("s_waitcnt vmcnt(0)" ::: "memory");
    __syncthreads();
    if (threadIdx.x == 0) {
        unsigned* bar = b.bar;
        __builtin_amdgcn_s_waitcnt(0);
        unsigned nloc = b.st[0], nx = b.st[1];
        if (nloc == 0u) { xcd_barrier_complete(bar, b.x, nloc, nx); b.st[0] = nloc; b.st[1] = nx; }
        const unsigned old = xb_add(&bar[XB_XSUB(b.x)], 1u);
        const unsigned gen = old / nloc;
        if (old + 1u == (gen + 1u) * nloc) {
            __builtin_amdgcn_fence(__ATOMIC_RELEASE, "agent");
            asm volatile("s_waitcnt vmcnt(0)" ::: "memory");
            const unsigned og = xb_add(&bar[XB_TOP], 1u);
            const unsigned tg = og / nx;
            if (og + 1u == (tg + 1u) * nx) xb_add(&bar[XB_TOPGEN], 1u);
            else XB_SPIN(xb_ld(&bar[XB_TOPGEN]) == tg, bar);
            __builtin_amdgcn_fence(__ATOMIC_ACQUIRE, "agent");
            xb_add(&bar[XB_XGEN(b.x)], 1u);
            asm volatile("s_waitcnt vmcnt(0)" ::: "memory");
        } else {
            XB_SPIN(xb_ld(&bar[XB_XGEN(b.x)]) == gen, bar);
            __builtin_amdgcn_fence(__ATOMIC_ACQUIRE, "agent");
            asm volatile("s_waitcnt vmcnt(0)" ::: "memory");
        }
    }
    __syncthreads();
}
constexpr int N_MOD = NLAYER * (MODROW / 256) * KS_MOD;
constexpr int I_CIN = (DM / 64) * (6144 / 32), I_SQ = (DM / 64) * (DM / 32), I_GIN = (DM / 64) * (4096 / 32), I_QA = (DM / 64) * (512 / 32), I_KVA = (DM / 64) * (576 / 32),
              I_QB = (512 / 64) * (3072 / 32), I_KVB = (512 / 64) * (4096 / 32), I_W1 = (DM / 64) * (DFF / 32), I_W2 = (DFF / 64) * (DM / 32);
constexpr int N_TR = 2 * I_CIN + 2 * I_SQ + I_GIN + I_SQ + I_QA + I_KVA + I_QB + I_KVB + I_SQ + 4 * I_W1 + 4 * I_W2;
constexpr int N_WSI = 512, N_ZI = 768, N_P0 = N_MOD + N_TR + N_WSI + N_ZI;

struct Ptrs {
    const float *xp, *xs, *cache_ckv, *cache_kpe, *c, *c_ctx, *ada_w, *ada_b, *norm1, *norm2, *conv_w_in, *conv_w, *conv_w_out, *gmlp_w_in, *gmlp_g_v, *gmlp_w_s, *gmlp_b_s, *gmlp_w_out,
                *mla_w_q_a, *mla_g_q, *mla_w_q_b, *mla_w_kv_a, *mla_g_kv, *mla_w_kv_b, *mla_w_o, *mlp_w1, *mlp_w2, *final_norm;
    float* out; unsigned char* ws;
};

struct Args { const float* in[28]; float* out; unsigned char* ws; int ph_lo, ph_hi; };
__device__ __forceinline__ Ptrs make_ptrs() {
    const __attribute__((address_space(4))) Args* ap = (const __attribute__((address_space(4))) Args*)__builtin_amdgcn_kernarg_segment_ptr();
    asm volatile("" : "+s"(ap));
    Ptrs P;
    P.xp = ap->in[0]; P.xs = ap->in[1]; P.cache_ckv = ap->in[2]; P.cache_kpe = ap->in[3]; P.c = ap->in[4]; P.c_ctx = ap->in[5]; P.ada_w = ap->in[6]; P.ada_b = ap->in[7];
    P.norm1 = ap->in[8]; P.norm2 = ap->in[9]; P.conv_w_in = ap->in[10]; P.conv_w = ap->in[11]; P.conv_w_out = ap->in[12]; P.gmlp_w_in = ap->in[13]; P.gmlp_g_v = ap->in[14];
    P.gmlp_w_s = ap->in[15]; P.gmlp_b_s = ap->in[16]; P.gmlp_w_out = ap->in[17]; P.mla_w_q_a = ap->in[18]; P.mla_g_q = ap->in[19]; P.mla_w_q_b = ap->in[20]; P.mla_w_kv_a = ap->in[21];
    P.mla_g_kv = ap->in[22]; P.mla_w_kv_b = ap->in[23]; P.mla_w_o = ap->in[24]; P.mlp_w1 = ap->in[25]; P.mlp_w2 = ap->in[26]; P.final_norm = ap->in[27];
    P.out = ap->out; P.ws = ap->ws;
    return P;
}
struct Ctx { int tid, lane, wave, G, bx, gw, NGW; };
__device__ __forceinline__ Ctx make_ctx() {
    int t = threadIdx.x; asm volatile("" : "+v"(t));
    int b = blockIdx.x; asm volatile("" : "+s"(b));
    Ctx C; C.tid = t; C.lane = t & 63; C.wave = __builtin_amdgcn_readfirstlane(t >> 6); C.G = gridDim.x; C.bx = b;
    const int vcu = (C.G % 8 == 0) ? (b % 8) * (C.G / 8) + b / 8 : b;
    C.gw = vcu * NWAVES + C.wave; C.NGW = C.G * NWAVES;
    return C;
}

__device__ __forceinline__ void p0_transpose_item(const float* W, int K, int N, bf16* WT, int row_off, LAS float* scr, int item, int lane) {
    const int nblk = N / 32, kb = item / nblk, nb = item - kb * nblk, k0 = 64 * kb, n0 = 32 * nb;
    const int lk = lane >> 3, ln = (lane & 7) * 4;
    f32x4 v[8];
#pragma unroll
    for (int i = 0; i < 8; ++i) v[i] = *(const f32x4*)(W + (size_t)(k0 + 8 * i + lk) * N + n0 + ln);
#pragma unroll
    for (int i = 0; i < 8; ++i) { LAS float* d = scr + (8 * i + lk) * 33 + ln; d[0] = v[i][0]; d[1] = v[i][1]; d[2] = v[i][2]; d[3] = v[i][3]; }
    LDS_WAIT(); asm volatile("" ::: "memory");
    const int c = lane & 7;
#pragma unroll
    for (int j = 0; j < 4; ++j) { const int n = (lane >> 3) + 8 * j; const LAS float* s = scr + (8 * c) * 33 + n;
        v4u o; o.x = pk2(s[0 * 33], s[1 * 33]); o.y = pk2(s[2 * 33], s[3 * 33]); o.z = pk2(s[4 * 33], s[5 * 33]); o.w = pk2(s[6 * 33], s[7 * 33]);
        *(v4u*)(WT + (size_t)(row_off + n0 + n) * K + k0 + 8 * c) = o; }
    LDS_WAIT(); asm volatile("" ::: "memory");
}


__device__ __forceinline__ void p0a_phase(LAS unsigned char* lds) {
    const Ctx C = make_ctx(); const Ptrs P = make_ptrs(); const int gw = C.gw, NGW = C.NGW, tid = C.tid, wave = C.wave, lane = C.lane;
    LAS float* silu = (LAS float*)lds;
    for (int i = tid; i < 5 * DM; i += NWAVES * 64) { const int cd = i >> 11, k = i & (DM - 1); const float x = cd == 0 ? P.c_ctx[k] : P.c[(cd - 1) * DM + k]; silu[i] = x / (1.f + expf(-x)); }
    __syncthreads();
    LAS float* scr = (LAS float*)(lds + 40960 + wave * 8448);
    float* modp = (float*)(P.ws + WS_MODP);
    for (int it = gw; it < N_P0; it += NGW) {
        if (it < N_MOD) {
            const int L = it / (N_MOD / NLAYER), rem = it - L * (N_MOD / NLAYER), jb = rem / KS_MOD, ks = rem - jb * KS_MOD;
            const float* W = P.ada_w + ((size_t)L * DM + (size_t)ks * 128) * MODROW + jb * 256 + lane * 4;
            f32x4 acc[5];
#pragma unroll
            for (int cd = 0; cd < 5; ++cd) acc[cd] = (f32x4){0.f, 0.f, 0.f, 0.f};
            for (int k = 0; k < 128; k += 16) { f32x4 w[16];
#pragma unroll
                for (int i = 0; i < 16; ++i) w[i] = *(const f32x4*)(W + (size_t)(k + i) * MODROW);
#pragma unroll
                for (int i = 0; i < 16; ++i)
#pragma unroll
                    for (int cd = 0; cd < 5; ++cd) acc[cd] += w[i] * silu[cd * DM + ks * 128 + k + i]; }
#pragma unroll
            for (int cd = 0; cd < 5; ++cd) *(f32x4*)(modp + ((size_t)(ks * NLAYER + L) * 5 + cd) * MODROW + jb * 256 + lane * 4) = acc[cd];
            continue; }
        int r = it - N_MOD;
        if (r < N_TR) {
            const float* W; int K, N, ro = 0; size_t dst;
            if (r < 2 * I_CIN) { const int l = r / I_CIN; r -= l * I_CIN; W = P.conv_w_in + (size_t)l * DM * 6144; K = DM; N = 6144; dst = WS_CIN + (size_t)l * 6144 * DM * 2; }
            else if ((r -= 2 * I_CIN) < 2 * I_SQ) { const int l = r / I_SQ; r -= l * I_SQ; W = P.conv_w_out + (size_t)l * DM * DM; K = DM; N = DM; dst = WS_COUT + (size_t)l * DM * DM * 2; }
            else if ((r -= 2 * I_SQ) < I_GIN) { W = P.gmlp_w_in; K = DM; N = 4096; dst = WS_GIN; }
            else if ((r -= I_GIN) < I_SQ) { W = P.gmlp_w_out; K = DM; N = DM; dst = WS_GOUT; }
            else if ((r -= I_SQ) < I_QA) { W = P.mla_w_q_a; K = DM; N = 512; dst = WS_MLA_A; }
            else if ((r -= I_QA) < I_KVA) { W = P.mla_w_kv_a; K = DM; N = 576; dst = WS_MLA_A; ro = 512; }
            else if ((r -= I_KVA) < I_QB) { W = P.mla_w_q_b; K = 512; N = 3072; dst = WS_QB; }
            else if ((r -= I_QB) < I_KVB) { W = P.mla_w_kv_b; K = 512; N = 4096; dst = WS_KVB; }
            else if ((r -= I_KVB) < I_SQ) { W = P.mla_w_o; K = DM; N = DM; dst = WS_WO; }
            else if ((r -= I_SQ) < 4 * I_W1) { const int l = r / I_W1; r -= l * I_W1; W = P.mlp_w1 + (size_t)l * DM * DFF; K = DM; N = DFF; dst = WS_W1 + (size_t)l * DFF * DM * 2; }
            else { r -= 4 * I_W1; const int l = r / I_W2; r -= l * I_W2; W = P.mlp_w2 + (size_t)l * DFF * DM; K = DFF; N = DM; dst = WS_W2 + (size_t)l * DM * DFF * 2; }
            p0_transpose_item(W, K, N, (bf16*)(P.ws + dst), ro, scr, r, lane);
            continue; }
        r -= N_TR;
        if (r < N_WSI) { const float* s = P.gmlp_w_s + (size_t)r * 512 + lane * 8; const f32x4 a = *(const f32x4*)s, b = *(const f32x4*)(s + 4);
            v4u o; o.x = pk2(a[0], a[1]); o.y = pk2(a[2], a[3]); o.z = pk2(b[0], b[1]); o.w = pk2(b[2], b[3]); *(v4u*)((bf16*)(P.ws + WS_WS) + (size_t)r * 512 + lane * 8) = o; continue; }
        r -= N_WSI;
        { v4u z; z.x = 0u; z.y = 0u; z.z = 0u; z.w = 0u; *(v4u*)((bf16*)(P.ws + WS_MLA_A) + (size_t)1088 * DM + (size_t)r * 512 + lane * 8) = z; }
    }
    __syncthreads();
}

__device__ __forceinline__ void sincos_d(double a, double& sn, double& cs) {
    const double k = rint(a * 0.63661977236758134308); double r = fma(-k, 1.57079632679489655800, a); r = fma(-k, 6.12323399573676603587e-17, r);
    const double r2 = r * r;
    const double s = r * (1.0 + r2 * (-1.0 / 6 + r2 * (1.0 / 120 + r2 * (-1.0 / 5040 + r2 * (1.0 / 362880 + r2 * (-1.0 / 39916800 + r2 * (1.0 / 6227020800.0 + r2 * (-1.0 / 1307674368000.0))))))));
    const double c = 1.0 + r2 * (-0.5 + r2 * (1.0 / 24 + r2 * (-1.0 / 720 + r2 * (1.0 / 40320 + r2 * (-1.0 / 3628800 + r2 * (1.0 / 479001600 + r2 * (-1.0 / 87178291200.0 + r2 * (1.0 / 20922789888000.0))))))));
    const int q = ((int)k) & 3;
    sn = q == 0 ? s : q == 1 ? c : q == 2 ? -s : -c;
    cs = q == 0 ? c : q == 1 ? -s : q == 2 ? -c : s;
}
__device__ __forceinline__ void p0b_phase() {
    const Ctx C = make_ctx(); const Ptrs P = make_ptrs(); const int gtid = C.bx * (NWAVES * 64) + C.tid, NT = C.G * NWAVES * 64;
    const float* modp = (const float*)(P.ws + WS_MODP); float* modf = (float*)(P.ws + WS_MODF);
    for (int i = gtid; i < NLAYER * 5 * MODROW; i += NT) {
        const int cidx = i & (DM - 1), lcs = i >> 11, slot = lcs % 6, lc = lcs / 6, L = lc / 5, cd = lc - 5 * L, j = slot * DM + cidx;
        float v = P.ada_b[L * MODROW + j];
#pragma unroll
        for (int ks = 0; ks < KS_MOD; ++ks) v += modp[((size_t)(ks * NLAYER + L) * 5 + cd) * MODROW + j];
        if (slot == 1) v = P.norm1[L * DM + cidx] * (1.f + v);
        if (slot == 4) v = P.norm2[L * DM + cidx] * (1.f + v);
        modf[i] = v; }
    float* rope = (float*)(P.ws + WS_ROPE);
    for (int i = gtid; i < 64 * 16; i += NT) { const int pos = i >> 4, j = i & 15;
        double inv = 1.0; for (int q = 0; q < j; ++q) inv *= 0.56234132519034908039;
        const float ang = (float)pos * (float)inv; double sn, cs; sincos_d((double)ang, sn, cs);
        rope[2 * i] = (float)cs; rope[2 * i + 1] = (float)sn; }
}

__device__ __forceinline__ void norm_phase(int L, int which, bool first) {
    const Ctx C = make_ctx(); const Ptrs P = make_ptrs(); const int gw = C.gw, NGW = C.NGW, lane = C.lane;
    const float* modf = (const float*)(P.ws + WS_MODF); bf16* X = (bf16*)(P.ws + WS_X); bf16* H = (bf16*)(P.ws + WS_H);
    for (int r0 = gw * 8; r0 < NTOK; r0 += NGW * 8) {
        const int cd = cond_of_row(r0);
        const float* wp = modf + ((size_t)(L * 5 + cd) * 6 + (which ? 4 : 1)) * DM + lane * 8;
        const float* sp = modf + ((size_t)(L * 5 + cd) * 6 + (which ? 3 : 0)) * DM + lane * 8;
        f32x4 wv[4][2], sv[4][2];
#pragma unroll
        for (int j = 0; j < 4; ++j) { wv[j][0] = *(const f32x4*)(wp + 512 * j); wv[j][1] = *(const f32x4*)(wp + 512 * j + 4); sv[j][0] = *(const f32x4*)(sp + 512 * j); sv[j][1] = *(const f32x4*)(sp + 512 * j + 4); }
        for (int rr = 0; rr < 8; ++rr) { const int row = r0 + rr;
            f32x4 v[4][2]; float ss = 0.f;
            if (first) { const float* src = (row < NPROMPT ? P.xp + (size_t)row * DM : P.xs + (size_t)(row - NPROMPT) * DM) + lane * 8;
#pragma unroll
                for (int j = 0; j < 4; ++j) { v[j][0] = *(const f32x4*)(src + 512 * j); v[j][1] = *(const f32x4*)(src + 512 * j + 4); }
#pragma unroll
                for (int j = 0; j < 4; ++j) { v4u o; o.x = pk2(v[j][0][0], v[j][0][1]); o.y = pk2(v[j][0][2], v[j][0][3]); o.z = pk2(v[j][1][0], v[j][1][1]); o.w = pk2(v[j][1][2], v[j][1][3]);
                    *(v4u*)(X + (size_t)row * DM + lane * 8 + 512 * j) = o;
                    v[j][0] = (f32x4){__uint_as_float(o.x << 16), __uint_as_float(o.x & 0xffff0000u), __uint_as_float(o.y << 16), __uint_as_float(o.y & 0xffff0000u)};
                    v[j][1] = (f32x4){__uint_as_float(o.z << 16), __uint_as_float(o.z & 0xffff0000u), __uint_as_float(o.w << 16), __uint_as_float(o.w & 0xffff0000u)}; }
            } else { const bf16* src = X + (size_t)row * DM + lane * 8;
                v4u o[4];
#pragma unroll
                for (int j = 0; j < 4; ++j) o[j] = *(const v4u*)(src + 512 * j);
#pragma unroll
                for (int j = 0; j < 4; ++j) {
                    v[j][0] = (f32x4){__uint_as_float(o[j].x << 16), __uint_as_float(o[j].x & 0xffff0000u), __uint_as_float(o[j].y << 16), __uint_as_float(o[j].y & 0xffff0000u)};
                    v[j][1] = (f32x4){__uint_as_float(o[j].z << 16), __uint_as_float(o[j].z & 0xffff0000u), __uint_as_float(o[j].w << 16), __uint_as_float(o[j].w & 0xffff0000u)}; } }
#pragma unroll
            for (int j = 0; j < 4; ++j)
#pragma unroll
                for (int h = 0; h < 2; ++h) ss += (v[j][h][0] * v[j][h][0] + v[j][h][1] * v[j][h][1]) + (v[j][h][2] * v[j][h][2] + v[j][h][3] * v[j][h][3]);
            const float rstd = 1.0f / sqrtf(wave_sum(ss) * (1.f / DM) + EPS);
#pragma unroll
            for (int j = 0; j < 4; ++j) { const f32x4 h0 = v[j][0] * rstd * wv[j][0] + sv[j][0], h1 = v[j][1] * rstd * wv[j][1] + sv[j][1];
                v4u o; o.x = pk2(h0[0], h0[1]); o.y = pk2(h0[2], h0[3]); o.z = pk2(h1[0], h1[1]); o.w = pk2(h1[2], h1[3]);
                *(v4u*)(H + (size_t)row * DM + lane * 8 + 512 * j) = o; }
        }
    }
}
__device__ __forceinline__ void final_norm_phase() {
    const Ctx C = make_ctx(); const Ptrs P = make_ptrs(); const int gw = C.gw, NGW = C.NGW, lane = C.lane;
    const bf16* X = (const bf16*)(P.ws + WS_X);
    f32x4 wv[4][2];
#pragma unroll
    for (int j = 0; j < 4; ++j) { wv[j][0] = *(const f32x4*)(P.final_norm + lane * 8 + 512 * j); wv[j][1] = *(const f32x4*)(P.final_norm + lane * 8 + 512 * j + 4); }
    for (int row = gw; row < NTOK; row += NGW) {
        const bf16* src = X + (size_t)row * DM + lane * 8;
        v4u o[4]; f32x4 v[4][2]; float ss = 0.f;
#pragma unroll
        for (int j = 0; j < 4; ++j) o[j] = *(const v4u*)(src + 512 * j);
#pragma unroll
        for (int j = 0; j < 4; ++j) {
            v[j][0] = (f32x4){__uint_as_float(o[j].x << 16), __uint_as_float(o[j].x & 0xffff0000u), __uint_as_float(o[j].y << 16), __uint_as_float(o[j].y & 0xffff0000u)};
            v[j][1] = (f32x4){__uint_as_float(o[j].z << 16), __uint_as_float(o[j].z & 0xffff0000u), __uint_as_float(o[j].w << 16), __uint_as_float(o[j].w & 0xffff0000u)};
#pragma unroll
            for (int h = 0; h < 2; ++h) ss += (v[j][h][0] * v[j][h][0] + v[j][h][1] * v[j][h][1]) + (v[j][h][2] * v[j][h][2] + v[j][h][3] * v[j][h][3]); }
        const float rstd = 1.0f / sqrtf(wave_sum(ss) * (1.f / DM) + EPS);
        float* yo = P.out + OUT_Y + (size_t)row * DM + lane * 8;
#pragma unroll
        for (int j = 0; j < 4; ++j) { *(f32x4*)(yo + 512 * j) = v[j][0] * rstd * wv[j][0]; *(f32x4*)(yo + 512 * j + 4) = v[j][1] * rstd * wv[j][1]; }
    }
}

__device__ __forceinline__ void conv_elem_phase(int jl) {
    const Ctx C = make_ctx(); const Ptrs P = make_ptrs(); const int gw = C.gw, NGW = C.NGW, lane = C.lane;
    const bf16* U = (const bf16*)(P.ws + WS_BIG); bf16* A2 = (bf16*)(P.ws + WS_A2); const float* cw = P.conv_w + (size_t)jl * 3 * DM;
    for (int item = gw; item < (NTOK / 16) * 4; item += NGW) {
        const int s = item >> 2, cb = item & 3, r0 = s * 16, c = cb * 512 + lane * 8;
        const int seqlen = r0 < NPROMPT ? 256 : SEQ_S, t0 = r0 & (seqlen - 1);
        float w0[8], w1[8], w2[8], zp[8], zc[8], zn[8];
#pragma unroll
        for (int e = 0; e < 8; ++e) { w0[e] = cw[c + e]; w1[e] = cw[DM + c + e]; w2[e] = cw[2 * DM + c + e]; }
#define CONV_Z(dst, row) do { const bf16* up = U + (size_t)(row) * 6144 + c; const bf16x8 cg = *(const bf16x8*)(up + DM), hv = *(const bf16x8*)(up + 2 * DM); \
        _Pragma("unroll") for (int e = 0; e < 8; ++e) dst[e] = bf2f(cg[e]) * bf2f(hv[e]); } while (0)
        if (t0 == 0) {
#pragma unroll
            for (int e = 0; e < 8; ++e) zp[e] = 0.f; }
        else CONV_Z(zp, r0 - 1);
        CONV_Z(zc, r0);
#pragma unroll 4
        for (int rr = 0; rr < 16; ++rr) { const int r = r0 + rr;
            if (t0 + rr == seqlen - 1) {
#pragma unroll
                for (int e = 0; e < 8; ++e) zn[e] = 0.f; }
            else CONV_Z(zn, r + 1);
            const bf16x8 bg = *(const bf16x8*)(U + (size_t)r * 6144 + c);
            float a[8];
#pragma unroll
            for (int e = 0; e < 8; ++e) { a[e] = bf2f(bg[e]) * (w0[e] * zp[e] + w1[e] * zc[e] + w2[e] * zn[e]); zp[e] = zc[e]; zc[e] = zn[e]; }
            v4u o; o.x = pk2(a[0], a[1]); o.y = pk2(a[2], a[3]); o.z = pk2(a[4], a[5]); o.w = pk2(a[6], a[7]);
            *(v4u*)(A2 + (size_t)r * DM + c) = o; }
#undef CONV_Z
    }
}

__device__ __forceinline__ void gmlp_spatial_phase(LAS unsigned char* lds) {
    const Ctx C = make_ctx(); const Ptrs P = make_ptrs(); const int G = C.G, c = C.bx;
    const int tid = C.tid, wid = tid >> 6, lane = tid & 63, r32 = lane & 31, hi = lane >> 5;
    const bf16* UV = (const bf16*)(P.ws + WS_BIG); bf16* A2 = (bf16*)(P.ws + WS_A2); const bf16* WSb = (const bf16*)(P.ws + WS_WS);
    LAS float* rs = (LAS float*)(lds + 65536);
    for (int u = c; u < 256; u += G) {
        const int n = u >> 1, hh = u & 1, R0 = n * 128;
        for (int qq = 0; qq < 16; ++qq) { const int q = wid * 16 + qq; const bf16* vr = UV + (size_t)(R0 + q) * 4096 + DM + lane * 8; float ss = 0.f;
#pragma unroll
            for (int j = 0; j < 4; ++j) { const bf16x8 x = *(const bf16x8*)(vr + 512 * j);
#pragma unroll
                for (int e = 0; e < 8; ++e) { const float f = bf2f(x[e]); ss += f * f; } }
            ss = wave_sum(ss); if (lane == 0) rs[q] = 1.0f / sqrtf(ss * (1.f / DM) + EPS); }
        __syncthreads();
        const int sr = tid >> 4, sc = (tid & 15) * 8, mi = wid & 3, dh = wid >> 2;
        for (int gi = 0; gi < 8; ++gi) { const int g = hh * 8 + gi, c0 = g * 128; LAS unsigned char* Vb = lds + (gi & 1) * 32768;
            const f32x4 ga = *(const f32x4*)(P.gmlp_g_v + c0 + sc), gb = *(const f32x4*)(P.gmlp_g_v + c0 + sc + 4);
#pragma unroll
            for (int i = 0; i < 4; ++i) { const int q = sr + 32 * i; const bf16x8 x = *(const bf16x8*)(UV + (size_t)(R0 + q) * 4096 + DM + c0 + sc); const float r = rs[q];
                v4u o; o.x = pk2(bf2f(x[0]) * r * ga[0], bf2f(x[1]) * r * ga[1]); o.y = pk2(bf2f(x[2]) * r * ga[2], bf2f(x[3]) * r * ga[3]);
                o.z = pk2(bf2f(x[4]) * r * gb[0], bf2f(x[5]) * r * gb[1]); o.w = pk2(bf2f(x[6]) * r * gb[2], bf2f(x[7]) * r * gb[3]);
                *(LAS v4u*)(Vb + (q >> 6) * 16384 + att::v_st(q & 63, sc)) = o; }
            __syncthreads();
            bf16x8 pa[2][4];
#pragma unroll
            for (int t = 0; t < 2; ++t)
#pragma unroll
                for (int s = 0; s < 4; ++s) pa[t][s] = *(const bf16x8*)(WSb + ((size_t)g * 128 + 32 * mi + r32) * 128 + 64 * t + 16 * s + 8 * hi);
            att::f32x16 od0 = {}, od1 = {};
#pragma unroll
            for (int t = 0; t < 2; ++t) { const int vb = (int)(unsigned)(size_t)Vb + t * 16384 + dh * 1024 + att::v_rd_base(lane);
                att::pv_one<0>(od0, vb, pa[t][0], pa[t][1], pa[t][2], pa[t][3]); att::pv_one<1>(od1, vb, pa[t][0], pa[t][1], pa[t][2], pa[t][3]); }
#pragma unroll
            for (int r = 0; r < 16; ++r) { const int p = 32 * mi + att::crow(r, hi); const float bias = P.gmlp_b_s[g * 128 + p]; const size_t row = (size_t)(R0 + p);
#pragma unroll
                for (int e = 0; e < 2; ++e) { const int col = c0 + 32 * (2 * dh + e) + r32; const float val = (e ? od1[r] : od0[r]) + bias;
                    const float uval = bf2f((short)UV[row * 4096 + col]); A2[row * DM + col] = (bf16)f2bf(uval * val); } }
        }
        __syncthreads();
    }
}

__device__ __forceinline__ void mla_thin_phase() {
    const Ctx C = make_ctx(); const Ptrs P = make_ptrs(); const int gw = C.gw, NGW = C.NGW, lane = C.lane;
    const bf16* ABF = (const bf16*)(P.ws + WS_ABF); bf16* QAN = (bf16*)(P.ws + WS_QAN); bf16* CKV = (bf16*)(P.ws + WS_CKV); bf16* KPE = (bf16*)(P.ws + WS_KPE); const float* rope = (const float*)(P.ws + WS_ROPE);
    const f32x4 gq0 = *(const f32x4*)(P.mla_g_q + lane * 8), gq1 = *(const f32x4*)(P.mla_g_q + lane * 8 + 4), gk0 = *(const f32x4*)(P.mla_g_kv + lane * 8), gk1 = *(const f32x4*)(P.mla_g_kv + lane * 8 + 4);
    for (int item = gw; item < NKVROWS; item += NGW) {
        if (item < NTOK) { const int row = item; const bf16* base = ABF + (size_t)row * 1280;
            const int dst = row < NPROMPT ? row : NPROMPT + ((row - NPROMPT) >> 11) * LKS + PAST + ((row - NPROMPT) & (SEQ_S - 1));
            { const bf16x8 x = *(const bf16x8*)(base + lane * 8); float f[8], ss = 0.f;
#pragma unroll
              for (int e = 0; e < 8; ++e) { f[e] = bf2f(x[e]); ss += f[e] * f[e]; }
              const float r = 1.0f / sqrtf(wave_sum(ss) * (1.f / 512) + EPS);
              v4u o; o.x = pk2(f[0] * r * gq0[0], f[1] * r * gq0[1]); o.y = pk2(f[2] * r * gq0[2], f[3] * r * gq0[3]); o.z = pk2(f[4] * r * gq1[0], f[5] * r * gq1[1]); o.w = pk2(f[6] * r * gq1[2], f[7] * r * gq1[3]);
              *(v4u*)(QAN + (size_t)row * 512 + lane * 8) = o; }
            { const bf16x8 x = *(const bf16x8*)(base + 512 + lane * 8); float f[8], ss = 0.f;
#pragma unroll
              for (int e = 0; e < 8; ++e) { f[e] = bf2f(x[e]); ss += f[e] * f[e]; }
              const float r = 1.0f / sqrtf(wave_sum(ss) * (1.f / 512) + EPS);
              f32x4 y0, y1;
#pragma unroll
              for (int e = 0; e < 4; ++e) { y0[e] = f[e] * r * gk0[e]; y1[e] = f[4 + e] * r * gk1[e]; }
              v4u o; o.x = pk2(y0[0], y0[1]); o.y = pk2(y0[2], y0[3]); o.z = pk2(y1[0], y1[1]); o.w = pk2(y1[2], y1[3]);
              *(v4u*)(CKV + (size_t)dst * 512 + lane * 8) = o;
              if (row < NPROMPT) { float* oc = P.out + OUT_CKV + (size_t)row * 512 + lane * 8; *(f32x4*)oc = y0; *(f32x4*)(oc + 4) = y1; } }
            { const float x = bf2f((short)base[1024 + lane]);
              if (row < NPROMPT) { P.out[OUT_KPE + (size_t)row * 64 + lane] = x; KPE[(size_t)dst * 64 + lane] = (bf16)f2bf(x); }
              else { const int t = (row - NPROMPT) & (SEQ_S - 1), w = lane & 31, j = w & 15, pos = (lane >> 5) ? (t & 63) : (t >> 6);
                  const float cs = rope[2 * (pos * 16 + j)], sn = rope[2 * (pos * 16 + j) + 1]; const float xo = __shfl_xor(x, 16);
                  const float y = (w >> 4) ? (xo * sn + x * cs) : (x * cs - xo * sn);
                  KPE[(size_t)dst * 64 + lane] = (bf16)f2bf(y); } }
        } else { const int cr = item - NTOK, b = cr >> 9, p = cr & (PAST - 1), dst = NPROMPT + b * LKS + p;
            const float* s = P.cache_ckv + (size_t)cr * 512 + lane * 8; const f32x4 a = *(const f32x4*)s, bb = *(const f32x4*)(s + 4);
            v4u o; o.x = pk2(a[0], a[1]); o.y = pk2(a[2], a[3]); o.z = pk2(bb[0], bb[1]); o.w = pk2(bb[2], bb[3]);
            *(v4u*)(CKV + (size_t)dst * 512 + lane * 8) = o;
            KPE[(size_t)dst * 64 + lane] = (bf16)f2bf(P.cache_kpe[(size_t)cr * 64 + lane]); }
    }
}

__device__ __forceinline__ void attn_phase(LAS unsigned char* lds) {
    const Ctx C = make_ctx(); const Ptrs P = make_ptrs(); const int G = C.G, c = C.bx;
    const bf16* Q = (const bf16*)(P.ws + WS_Q); const bf16* KV = (const bf16*)(P.ws + WS_KV); const bf16* KPE = (const bf16*)(P.ws + WS_KPE); bf16* O = (bf16*)(P.ws + WS_A2); const float* rope = (const float*)(P.ws + WS_ROPE);
    for (int id = c; id < 1024; id += G) {
        int h, qrow0, kvrow0, nkeys, rp, t0;
        if (id < 512) { const int x = id & 7, y = id >> 3, qb = y & 7, bh = x + 8 * (y >> 3), b = bh >> 4; h = bh & 15;
            qrow0 = NPROMPT + b * SEQ_S + qb * 256; kvrow0 = NPROMPT + b * LKS; nkeys = LKS; rp = 1; t0 = qb * 256; }
        else { const int i2 = id - 512, b = i2 >> 4; h = i2 & 15; qrow0 = b * 256; kvrow0 = b * 256; nkeys = 256; rp = 0; t0 = 0; }
        att::attn_unit(lds, Q + (size_t)qrow0 * att::LDQ + h * 192, KV + (size_t)kvrow0 * att::LDKV + h * 256, KPE + (size_t)kvrow0 * 64,
                       O + (size_t)qrow0 * att::LDO + h * 128, nkeys, rp, t0, rope);
    }
}

#ifndef KREP_G1
#define KREP_G1 1
#endif
#ifndef KREP_G2
#define KREP_G2 1
#endif
#ifndef KREP_W1
#define KREP_W1 1
#endif
#ifndef KREP_W2
#define KREP_W2 1
#endif
#ifndef REP_P0
#define REP_P0 1
#endif
#ifndef REP_NORM
#define REP_NORM 1
#endif
#ifndef REP_G1
#define REP_G1 1
#endif
#ifndef REP_THIN
#define REP_THIN 1
#endif
#ifndef REP_QKV
#define REP_QKV 1
#endif
#ifndef REP_ATT
#define REP_ATT 1
#endif
#ifndef REP_G2
#define REP_G2 1
#endif
#ifndef REP_W1
#define REP_W1 1
#endif
#ifndef REP_W2
#define REP_W2 1
#endif
#ifndef EN_P0
#define EN_P0 1
#endif
#ifndef EN_NORM
#define EN_NORM 1
#endif
#ifndef EN_G1
#define EN_G1 1
#endif
#ifndef EN_THIN
#define EN_THIN 1
#endif
#ifndef EN_QKV
#define EN_QKV 1
#endif
#ifndef EN_ATT
#define EN_ATT 1
#endif
#ifndef EN_G2
#define EN_G2 1
#endif
#ifndef EN_W1
#define EN_W1 1
#endif
#ifndef EN_W2
#define EN_W2 1
#endif
constexpr int N_PHASE_IDS = 2 + 9 * NLAYER + 1;
__global__ void __launch_bounds__(NWAVES * 64, 2) mk_fwd(Args args) {
    extern __shared__ __attribute__((aligned(16))) unsigned char lds_raw[];
    LAS unsigned char* lds = (LAS unsigned char*)lds_raw;
    const int tid = threadIdx.x;
    unsigned char* ws0 = args.ws;
    if (tid < 4) ((LAS unsigned*)(lds + MISC_OFF))[tid] = 0u;
    __syncthreads();
    XcdBarrier bar = xcd_barrier_post((unsigned*)(ws0 + WS_CTL) + CW_BAR, (volatile LAS unsigned*)(lds + MISC_OFF));
    const int lo = args.ph_lo, hi = args.ph_hi; const bool fused = (hi - lo) > 1;
#define PH(id) (lo <= (id) && (id) < hi)
#define SEAM() do { if (fused) xcd_barrier(bar); } while (0)

    if (EN_P0 && PH(0)) {
_Pragma("unroll 1") for (int rep = 0; rep < REP_P0; ++rep) { p0a_phase(lds); SEAM(); } }
    if (EN_P0 && PH(1)) {
_Pragma("unroll 1") for (int rep = 0; rep < REP_P0; ++rep) { p0b_phase(); SEAM(); } }

    for (int L = 0; L < NLAYER; ++L) {
        const int kind = L % 3, jl = L / 3, pb = 2 + 9 * L;
        if (EN_NORM && PH(pb + 0)) {
_Pragma("unroll 1") for (int rep = 0; rep < REP_NORM; ++rep) { norm_phase(L, 0, L == 0); SEAM(); } }
        if (EN_G1 && PH(pb + 1)) {
_Pragma("unroll 1") for (int rep = 0; rep < REP_G1; ++rep) {
            const Ctx C = make_ctx(); const Ptrs P = make_ptrs(); unsigned char* ws = P.ws; const int G = C.G, bx = C.bx; const float* modf = (const float*)(ws + WS_MODF); (void)modf;
            const bf16* Bt = kind == 0 ? (const bf16*)(ws + WS_CIN) + (size_t)jl * 6144 * DM : kind == 1 ? (const bf16*)(ws + WS_GIN) : (const bf16*)(ws + WS_MLA_A);
            const int N = kind == 0 ? 6144 : kind == 1 ? 4096 : 1280;
            pg8::Gemm g{(const bf16*)(ws + WS_H), Bt, NTOK, N, DM, KREP_G1}; pg8::StaticOrder S; S.init(NTOK, N, G, bx);
            pg8::EpiBf16 E{(bf16*)(ws + WS_BIG), N, 0, 1.0f / KREP_G1};
            pg8::gemm_phase<pg8::EpiBf16, pg8::StaticOrder, true, true>(lds + RING_OFF, g, S, E);
            SEAM(); } }
        if (EN_THIN && PH(pb + 2)) {
_Pragma("unroll 1") for (int rep = 0; rep < REP_THIN; ++rep) {
            if (kind == 0) conv_elem_phase(jl);
            else if (kind == 1) gmlp_spatial_phase(lds + RING_OFF);
            else mla_thin_phase();
            SEAM(); } }
        if (kind == 2) {
            if (EN_QKV && PH(pb + 3)) {
_Pragma("unroll 1") for (int rep = 0; rep < REP_QKV; ++rep) {
                const Ctx C = make_ctx(); const Ptrs P = make_ptrs(); unsigned char* ws = P.ws; const int G = C.G, bx = C.bx; const float* modf = (const float*)(ws + WS_MODF); (void)modf;
                { pg8::Gemm g{(const bf16*)(ws + WS_QAN), (const bf16*)(ws + WS_QB), NTOK, 3072, 512, 1}; pg8::StaticOrder S; S.init(NTOK, 3072, G, bx);
                  pg8::EpiBf16 E{(bf16*)(ws + WS_Q), 3072, 0, 1.0f};
                  pg8::gemm_phase<pg8::EpiBf16, pg8::StaticOrder, true, true>(lds + RING_OFF, g, S, E); }
                { pg8::Gemm g{(const bf16*)(ws + WS_CKV), (const bf16*)(ws + WS_KVB), NKVROWS, 4096, 512, 1}; pg8::StaticOrder S; S.init(NKVROWS, 4096, G, bx);
                  pg8::EpiBf16 E{(bf16*)(ws + WS_KV), 4096, 0, 1.0f};
                  pg8::gemm_phase<pg8::EpiBf16, pg8::StaticOrder, true, true>(lds + RING_OFF, g, S, E); }
                SEAM(); } }
            if (EN_ATT && PH(pb + 4)) {
_Pragma("unroll 1") for (int rep = 0; rep < REP_ATT; ++rep) { attn_phase(lds + RING_OFF); SEAM(); } }
        }
        if (EN_G2 && PH(pb + 5)) {
_Pragma("unroll 1") for (int rep = 0; rep < REP_G2; ++rep) {
            const Ctx C = make_ctx(); const Ptrs P = make_ptrs(); unsigned char* ws = P.ws; const int G = C.G, bx = C.bx; const float* modf = (const float*)(ws + WS_MODF); (void)modf;
            const bf16* Bt = kind == 0 ? (const bf16*)(ws + WS_COUT) + (size_t)jl * DM * DM : kind == 1 ? (const bf16*)(ws + WS_GOUT) : (const bf16*)(ws + WS_WO);
            pg8::Gemm g{(const bf16*)(ws + WS_A2), Bt, NTOK, DM, DM, KREP_G2}; pg8::StaticOrder S; S.init(NTOK, DM, G, bx);
            pg8::EpiRes E{(bf16*)(ws + WS_X), rep ? (const float*)(ws + WS_CTL) : modf + (size_t)L * 5 * MODROW + 2 * DM, DM, rep ? 0 : MODROW, 1.0f / KREP_G2};
            pg8::gemm_phase<pg8::EpiRes, pg8::StaticOrder, true, true>(lds + RING_OFF, g, S, E);
            SEAM(); } }
        if (EN_NORM && PH(pb + 6)) {
_Pragma("unroll 1") for (int rep = 0; rep < REP_NORM; ++rep) { norm_phase(L, 1, false); SEAM(); } }
        if (EN_W1 && PH(pb + 7)) {
_Pragma("unroll 1") for (int rep = 0; rep < REP_W1; ++rep) {
            const Ctx C = make_ctx(); const Ptrs P = make_ptrs(); unsigned char* ws = P.ws; const int G = C.G, bx = C.bx; const float* modf = (const float*)(ws + WS_MODF); (void)modf;
            pg8::Gemm g{(const bf16*)(ws + WS_H), (const bf16*)(ws + WS_W1) + (size_t)L * DFF * DM, NTOK, DFF, DM, KREP_W1}; pg8::StaticOrder S; S.init(NTOK, DFF, G, bx);
            pg8::EpiBf16 E{(bf16*)(ws + WS_BIG), DFF, 1, 1.0f / KREP_W1};
            pg8::gemm_phase<pg8::EpiBf16, pg8::StaticOrder, true, true>(lds + RING_OFF, g, S, E);
            SEAM(); } }
        if (EN_W2 && PH(pb + 8)) {
_Pragma("unroll 1") for (int rep = 0; rep < REP_W2; ++rep) {
            const Ctx C = make_ctx(); const Ptrs P = make_ptrs(); unsigned char* ws = P.ws; const int G = C.G, bx = C.bx; const float* modf = (const float*)(ws + WS_MODF); (void)modf;
            pg8::Gemm g{(const bf16*)(ws + WS_BIG), (const bf16*)(ws + WS_W2) + (size_t)L * DM * DFF, NTOK, DM, DFF, KREP_W2}; pg8::StaticOrder S; S.init(NTOK, DM, G, bx);
            pg8::EpiRes E{(bf16*)(ws + WS_X), rep ? (const float*)(ws + WS_CTL) : modf + (size_t)L * 5 * MODROW + 5 * DM, DM, rep ? 0 : MODROW, 1.0f / KREP_W2};
            pg8::gemm_phase<pg8::EpiRes, pg8::StaticOrder, true, true>(lds + RING_OFF, g, S, E);
            SEAM(); } }
    }
    if (EN_NORM && PH(N_PHASE_IDS - 1)) final_norm_phase();
#undef PH
#undef SEAM
}

extern "C" void kernel_launch(void* const* d_in, const int* in_sizes, int n_in, void* d_out, int out_size, void* d_ws, size_t ws_size, hipStream_t stream) {
    static int grid = 0;
    if (grid == 0) {
        if (n_in != 28 || in_sizes[0] != NPROMPT * DM || (size_t)out_size != OUT_END || ws_size < WS_END) {
            fprintf(stderr, "kernel_launch: built for 28 inputs, out of %zu floats, >= %zu bytes of workspace; got n_in %d, in0 %d, out %d, ws %zu; nothing launched\n", (size_t)OUT_END, (size_t)WS_END, n_in, n_in > 0 ? in_sizes[0] : -1, out_size, ws_size); grid = -1; return; }
        int dev = 0, cus = 0, per_cu = 0;
        if (hipGetDevice(&dev) != hipSuccess || hipDeviceGetAttribute(&cus, hipDeviceAttributeMultiprocessorCount, dev) != hipSuccess) { fprintf(stderr, "kernel_launch: device query failed\n"); grid = -1; return; }
        if (hipFuncSetAttribute((const void*)mk_fwd, hipFuncAttributeMaxDynamicSharedMemorySize, LDS_BYTES) != hipSuccess) { fprintf(stderr, "kernel_launch: hipFuncSetAttribute failed\n"); grid = -1; return; }
        if (hipOccupancyMaxActiveBlocksPerMultiprocessor(&per_cu, (const void*)mk_fwd, NWAVES * 64, LDS_BYTES) != hipSuccess || per_cu < 1)
            fprintf(stderr, "kernel_launch: note: the occupancy query reports %d workgroups per CU\n", per_cu);
        (void)hipGetLastError();
        grid = cus;
    }
    if (grid < 0) return;
    if (hipMemsetAsync((char*)d_ws + WS_CTL, 0, CTL_ZERO_BYTES, stream) != hipSuccess) { fprintf(stderr, "kernel_launch: hipMemsetAsync failed\n"); return; }
    Args a{};
    for (int i = 0; i < 28; ++i) a.in[i] = (const float*)d_in[i];
    a.out = (float*)d_out; a.ws = (unsigned char*)d_ws;
#if MK_MULTI
    for (int id = 0; id < N_PHASE_IDS; ++id) {
        if (id >= 2 && id < N_PHASE_IDS - 1) { const int L = (id - 2) / 9, slot = (id - 2) % 9; if ((slot == 3 || slot == 4) && (L % 3) != 2) continue; }
        a.ph_lo = id; a.ph_hi = id + 1;
        hipLaunchKernelGGL(mk_fwd, dim3(grid), dim3(NWAVES * 64), LDS_BYTES, stream, a);
    }
#else
    a.ph_lo = 0; a.ph_hi = N_PHASE_IDS;
    hipLaunchKernelGGL(mk_fwd, dim3(grid), dim3(NWAVES * 64), LDS_BYTES, stream, a);
#endif
    const hipError_t le = hipPeekAtLastError();
    if (le != hipSuccess) fprintf(stderr, "kernel_launch: launch failed: %s\n", hipGetErrorName(le));
}
```

```cpp
#include <hip/hip_runtime.h>
#include <cstdio>
#include <cstdint>
namespace pg8 {
#define PG8_LAS __attribute__((address_space(3)))
typedef unsigned short bf16_t;
typedef short bf16x8 __attribute__((ext_vector_type(8)));
typedef float f32x4 __attribute__((ext_vector_type(4)));
typedef unsigned u32x4 __attribute__((ext_vector_type(4)));
constexpr int BM = 256, BK = 64, HALF = 128, HTB = HALF * BK * 2  , STAGE_BYTES = 8 * HTB, NXCD = 8, WGM = 8;

__host__ __device__ __forceinline__ int lds_byte(int r, int c) { const int st = (r >> 4) * 2 + (c >> 5), rr = r & 15, cc = c & 31, ob = rr * 64 + cc * 2; return st * 1024 + (ob ^ (((ob >> 9) & 1) << 5)); }
__host__ __device__ __forceinline__ void stage_rc(int b, int& R, int& C) { const int st = b / 1024, sb = b % 1024, swz = sb ^ (((sb >> 9) & 1) << 5); R = (st >> 1) * 16 + swz / 64; C = (st & 1) * 32 + (swz % 64) / 2; }
__host__ __device__ __forceinline__ int perm32(int rho) { const int n = rho >> 4, i = rho & 15; return 8 * (i >> 2) + 4 * n + (i & 3); }

struct Unit { int pm, pn; };
struct Gemm { const bf16_t* A; const bf16_t* Bt; int M, N, K, krep; };

struct StaticOrder {
    int nM, nN, nwg, G, c;
    __host__ __device__ void init(int M, int N, int G_, int c_) { nM = M / BM; nN = N / BM; nwg = nM * nN; G = G_; c = c_; }
    __host__ __device__ bool next(int i, Unit& u) const {
        const long L = (long)i * G + c; if (L >= nwg) return false;
        int wgid = (int)L; { const int q = nwg / NXCD, r = nwg % NXCD, xcd = wgid % NXCD, off = wgid / NXCD; wgid = (xcd < r ? xcd * (q + 1) : r * (q + 1) + (xcd - r) * q) + off; }
        const int nig = WGM * nN, gid = wgid / nig, fm = gid * WGM, gsz = (nM - fm) < WGM ? (nM - fm) : WGM;
        u.pm = fm + ((wgid % nig) % gsz); u.pn = (wgid % nig) / gsz; return true;
    }
    __device__ __forceinline__ void a_ready(const Unit&) const {}
    __device__ __forceinline__ void done(const Unit&) const {}
};
__device__ __forceinline__ unsigned cvt_pk_bf16(float lo, float hi) { unsigned r; asm volatile("v_cvt_pk_bf16_f32 %0, %1, %2" : "=v"(r) : "v"(lo), "v"(hi)); return r; }
__device__ __forceinline__ int cond_of_tile(int pm) { return pm < 32 ? 0 : 1 + ((pm - 32) >> 3); }

struct EpiBf16 {
    static constexpr bool PERM = true, AFTER_DRAIN = false;
    bf16_t* O; int ldc; int act; float scale;
    __device__ __forceinline__ void operator()(const f32x4 (&acc)[2][2][4][2], const Unit& u, int wr, int wc, int fr, int fq) const {
        const int row0 = u.pm * BM + wr * 64 + fr, col0 = u.pn * BM + wc * 32 + 8 * fq;
        const f32x4 z4 = (f32x4){0.f, 0.f, 0.f, 0.f};
#pragma unroll
        for (int ai = 0; ai < 2; ++ai)
#pragma unroll
            for (int m = 0; m < 4; ++m) { bf16_t* rowp = O + (size_t)(row0 + ai * HALF + m * 16) * ldc + col0;
#pragma unroll
                for (int bj = 0; bj < 2; ++bj) { f32x4 v0 = acc[ai][bj][m][0] * scale, v1 = acc[ai][bj][m][1] * scale;
                    if (act) { v0 = __builtin_elementwise_max(v0, z4); v1 = __builtin_elementwise_max(v1, z4); v0 = v0 * v0; v1 = v1 * v1; }
                    u32x4 w; w.x = cvt_pk_bf16(v0[0], v0[1]); w.y = cvt_pk_bf16(v0[2], v0[3]); w.z = cvt_pk_bf16(v1[0], v1[1]); w.w = cvt_pk_bf16(v1[2], v1[3]);
                    *(u32x4*)(rowp + bj * HALF) = w; } }
    }
};
struct EpiRes {
    static constexpr bool PERM = true, AFTER_DRAIN = false;
    bf16_t* X; const float* gate; int ldx; int gstride; float scale;
    __device__ __forceinline__ void operator()(const f32x4 (&acc)[2][2][4][2], const Unit& u, int wr, int wc, int fr, int fq) const {
        const float* g = gate + (size_t)cond_of_tile(u.pm) * gstride;
        const int row0 = u.pm * BM + wr * 64 + fr, col0 = u.pn * BM + wc * 32 + 8 * fq;
        f32x4 gv[2][2];
#pragma unroll
        for (int bj = 0; bj < 2; ++bj)
#pragma unroll
            for (int n = 0; n < 2; ++n) gv[bj][n] = *(const f32x4*)(g + col0 + bj * HALF + 4 * n) * scale;
#pragma unroll
        for (int ai = 0; ai < 2; ++ai) {
            u32x4 old[4][2];
#pragma unroll
            for (int m = 0; m < 4; ++m)
#pragma unroll
                for (int bj = 0; bj < 2; ++bj) old[m][bj] = *(const u32x4*)(X + (size_t)(row0 + ai * HALF + m * 16) * ldx + col0 + bj * HALF);
#pragma unroll
            for (int m = 0; m < 4; ++m) { bf16_t* rowp = X + (size_t)(row0 + ai * HALF + m * 16) * ldx + col0;
#pragma unroll
                for (int bj = 0; bj < 2; ++bj) { const u32x4 o = old[m][bj]; const f32x4 a0 = acc[ai][bj][m][0], a1 = acc[ai][bj][m][1]; const f32x4 g0 = gv[bj][0], g1 = gv[bj][1];
                    u32x4 w;
                    w.x = cvt_pk_bf16(__uint_as_float(o.x << 16) + g0[0] * a0[0], __uint_as_float(o.x & 0xffff0000u) + g0[1] * a0[1]);
                    w.y = cvt_pk_bf16(__uint_as_float(o.y << 16) + g0[2] * a0[2], __uint_as_float(o.y & 0xffff0000u) + g0[3] * a0[3]);
                    w.z = cvt_pk_bf16(__uint_as_float(o.z << 16) + g1[0] * a1[0], __uint_as_float(o.z & 0xffff0000u) + g1[1] * a1[1]);
                    w.w = cvt_pk_bf16(__uint_as_float(o.w << 16) + g1[2] * a1[2], __uint_as_float(o.w & 0xffff0000u) + g1[3] * a1[3]);
                    *(u32x4*)(rowp + bj * HALF) = w; } }
            asm volatile("" ::: "memory"); }
    }
};

template <class Epi, class Sched, bool ALIGN_EPI = false, bool SP2 = false>
__device__ __forceinline__ void gemm_phase(PG8_LAS unsigned char* lds, const Gemm g, const Sched& S, const Epi& E) {
    int tid_l = threadIdx.x; asm volatile("" : "+v"(tid_l));
    const int tid = tid_l, wid = __builtin_amdgcn_readfirstlane(tid >> 6), lane = tid & 63, wr = wid >> 2, wc = wid & 3, fr = lane & 15, fq = lane >> 4;
    const int K = g.K, nt = K / BK, ntt = nt * g.krep;
    unsigned voffA[2], voffB[2];
#pragma unroll
    for (int i = 0; i < 2; ++i) { int R, C; stage_rc(tid * 16 + i * 8192, R, C); const int Rb = Epi::PERM ? ((R & ~31) + perm32(R & 31)) : R;
        voffA[i] = (unsigned)(R * K + C) * 2u; voffB[i] = (unsigned)(Rb * K + C) * 2u; }
    const size_t kstep = (size_t)(BK * 2);
    const size_t hstep = (size_t)HALF * K * 2;
    const size_t tstep = 2 * hstep;
    const unsigned ldsw = (unsigned)wid * 1024u;
    const int aoff = lds_byte(wr * 64 + fr, fq * 8), boff = lds_byte(wc * 32 + fr, fq * 8);
#define PG8_SA(b, h) (((b) * 2 + (h)) * HTB)
#define PG8_SB(b, h) ((4 + (b) * 2 + (h)) * HTB)
#define PG8_STAGE(bufoff, gbase, voff) do { _Pragma("unroll") for (int _i = 0; _i < 2; ++_i) \
        __builtin_amdgcn_global_load_lds((const unsigned*)((const char*)(gbase) + (voff)[_i]), (PG8_LAS unsigned*)(lds + (bufoff) + ldsw + _i * 8192), 16, 0, 0); } while (0)
#define PG8_LDA(dst, b, h) do { _Pragma("unroll") for (int m = 0; m < 4; ++m) _Pragma("unroll") for (int k = 0; k < 2; ++k) dst[m][k] = *(const PG8_LAS bf16x8*)(lds + PG8_SA(b, h) + aoff + m * 2048 + k * 1024); } while (0)
#define PG8_LDB(dst, b, h) do { _Pragma("unroll") for (int n = 0; n < 2; ++n) _Pragma("unroll") for (int k = 0; k < 2; ++k) dst[n][k] = *(const PG8_LAS bf16x8*)(lds + PG8_SB(b, h) + boff + n * 2048 + k * 1024); } while (0)
#define PG8_MMA(ai, bj, At, Bt) do { __builtin_amdgcn_s_setprio(1); _Pragma("unroll") for (int m = 0; m < 4; ++m) _Pragma("unroll") for (int n = 0; n < 2; ++n) _Pragma("unroll") for (int k = 0; k < 2; ++k) \
        acc[ai][bj][m][n] = __builtin_amdgcn_mfma_f32_16x16x32_bf16(Bt[n][k], At[m][k], acc[ai][bj][m][n], 0, 0, 0); __builtin_amdgcn_s_setprio(0); } while (0)
#define PG8_WAIT_V(n) asm volatile("s_waitcnt vmcnt(" #n ")" ::: "memory")
#define PG8_WAIT_L(n) asm volatile("s_waitcnt lgkmcnt(" #n ")" ::: "memory")
#define PG8_BAR __builtin_amdgcn_s_barrier()
#define PG8_SCHED __builtin_amdgcn_sched_barrier(0)
    Unit cur, nxt; int ui = 0;
    if (!S.next(0, cur)) return;
    f32x4 acc[2][2][4][2];
#pragma unroll
    for (int a = 0; a < 2; ++a)
#pragma unroll
        for (int b = 0; b < 2; ++b)
#pragma unroll
            for (int m = 0; m < 4; ++m)
#pragma unroll
                for (int n = 0; n < 2; ++n) acc[a][b][m][n] = (f32x4){0.f, 0.f, 0.f, 0.f};
    bf16x8 At[4][2], B0[2][2], B1[2][2];
    const char* cA = (const char*)g.A + (size_t)cur.pm * tstep; const char* cB = (const char*)g.Bt + (size_t)cur.pn * tstep;
    S.a_ready(cur);
    if constexpr (SP2) {
        PG8_STAGE(PG8_SB(0, 0), cB, voffB); PG8_STAGE(PG8_SB(0, 1), cB + hstep, voffB); PG8_STAGE(PG8_SA(0, 0), cA, voffA); PG8_STAGE(PG8_SA(0, 1), cA + hstep, voffA);
        if (wr == 1) PG8_BAR;
        PG8_WAIT_V(2); PG8_BAR;
        PG8_STAGE(PG8_SB(1, 0), cB + kstep, voffB); PG8_STAGE(PG8_SA(1, 0), cA + kstep, voffA); PG8_STAGE(PG8_SB(1, 1), cB + hstep + kstep, voffB);
        PG8_WAIT_V(6); PG8_BAR;
    } else {
        PG8_STAGE(PG8_SB(0, 0), cB, voffB); PG8_STAGE(PG8_SA(0, 0), cA, voffA); PG8_STAGE(PG8_SB(0, 1), cB + hstep, voffB); PG8_STAGE(PG8_SA(0, 1), cA + hstep, voffA);
        if (wr == 1) PG8_BAR;
        PG8_WAIT_V(4); PG8_BAR;
        PG8_STAGE(PG8_SB(1, 0), cB + kstep, voffB); PG8_STAGE(PG8_SA(1, 0), cA + kstep, voffA); PG8_STAGE(PG8_SB(1, 1), cB + hstep + kstep, voffB);
        PG8_WAIT_V(6); PG8_BAR;
    }
    for (;;) {
        const bool has_next = S.next(ui + 1, nxt);
        const char* nA = has_next ? (const char*)g.A + (size_t)nxt.pm * tstep : cA; const char* nB = has_next ? (const char*)g.Bt + (size_t)nxt.pn * tstep : cB;
        for (int t = 0, tm = 0; t < ntt; t += 2, tm = (tm + 2 == nt ? 0 : tm + 2)) {
            const bool last = (t == ntt - 2); const int tm2 = (tm + 2 == nt) ? 0 : tm + 2;
            const char* a1 = cA + (size_t)(tm + 1) * kstep;
            const char* a2 = last ? nA : cA + (size_t)tm2 * kstep; const char* b2 = last ? nB : cB + (size_t)tm2 * kstep;
            const char* a3 = a2 + kstep; const char* b3 = b2 + kstep;
            if (last && has_next) S.a_ready(nxt);
            if constexpr (SP2) {
            PG8_LDB(B0, 0, 0); PG8_LDB(B1, 0, 1); PG8_SCHED; PG8_LDA(At, 0, 0); PG8_STAGE(PG8_SA(1, 1), a1 + hstep, voffA);
            PG8_WAIT_V(8); PG8_WAIT_L(0); PG8_BAR; PG8_MMA(0, 0, At, B0); PG8_MMA(0, 1, At, B1); PG8_BAR; PG8_SCHED;
            PG8_LDA(At, 0, 1); PG8_STAGE(PG8_SB(0, 0), b2, voffB); PG8_STAGE(PG8_SB(0, 1), b2 + hstep, voffB); PG8_STAGE(PG8_SA(0, 0), a2, voffA);
            PG8_WAIT_V(8); PG8_WAIT_L(0); PG8_BAR; PG8_MMA(1, 0, At, B0); PG8_MMA(1, 1, At, B1); PG8_BAR; PG8_SCHED;
            PG8_LDB(B0, 1, 0); PG8_LDB(B1, 1, 1); PG8_SCHED; PG8_LDA(At, 1, 0); PG8_STAGE(PG8_SA(0, 1), a2 + hstep, voffA);
            PG8_WAIT_V(8); PG8_WAIT_L(0); PG8_BAR; PG8_MMA(0, 0, At, B0); PG8_MMA(0, 1, At, B1); PG8_BAR; PG8_SCHED;
            PG8_LDA(At, 1, 1); PG8_STAGE(PG8_SB(1, 0), b3, voffB); PG8_STAGE(PG8_SB(1, 1), b3 + hstep, voffB); PG8_STAGE(PG8_SA(1, 0), a3, voffA);
            PG8_WAIT_V(8); PG8_WAIT_L(0); PG8_BAR; PG8_MMA(1, 0, At, B0); PG8_MMA(1, 1, At, B1); PG8_BAR; PG8_SCHED;
            } else {
            PG8_LDB(B0, 0, 0); PG8_SCHED; PG8_LDA(At, 0, 0); PG8_STAGE(PG8_SA(1, 1), a1 + hstep, voffA);
            PG8_WAIT_L(8); PG8_BAR; PG8_WAIT_L(0); PG8_MMA(0, 0, At, B0); PG8_BAR; PG8_SCHED;
            PG8_LDB(B1, 0, 1); PG8_STAGE(PG8_SB(0, 0), b2, voffB);
            PG8_BAR; PG8_WAIT_L(0); PG8_MMA(0, 1, At, B1); PG8_BAR;
            PG8_LDA(At, 0, 1); PG8_STAGE(PG8_SA(0, 0), a2, voffA);
            PG8_BAR; PG8_WAIT_L(0); PG8_MMA(1, 0, At, B0); PG8_BAR; PG8_SCHED;
            PG8_STAGE(PG8_SB(0, 1), b2 + hstep, voffB);
            PG8_WAIT_V(6); PG8_BAR; PG8_MMA(1, 1, At, B1); PG8_BAR;
            PG8_LDB(B0, 1, 0); PG8_SCHED; PG8_LDA(At, 1, 0); PG8_STAGE(PG8_SA(0, 1), a2 + hstep, voffA);
            PG8_WAIT_L(8); PG8_BAR; PG8_WAIT_L(0); PG8_MMA(0, 0, At, B0); PG8_BAR; PG8_SCHED;
            PG8_LDB(B1, 1, 1); PG8_STAGE(PG8_SB(1, 0), b3, voffB);
            PG8_BAR; PG8_WAIT_L(0); PG8_MMA(0, 1, At, B1); PG8_BAR;
            PG8_LDA(At, 1, 1); PG8_STAGE(PG8_SA(1, 0), a3, voffA);
            PG8_BAR; PG8_WAIT_L(0); PG8_MMA(1, 0, At, B0); PG8_BAR; PG8_SCHED;
            PG8_STAGE(PG8_SB(1, 1), b3 + hstep, voffB);
            PG8_WAIT_V(6); PG8_BAR; PG8_MMA(1, 1, At, B1); PG8_BAR;
            }
        }
        if constexpr (ALIGN_EPI) { if (wr == 0) PG8_BAR; }
        if constexpr (!Epi::AFTER_DRAIN) { E(acc, cur, wr, wc, fr, fq); S.done(cur); }
        if (!has_next) break;
#pragma unroll
        for (int a = 0; a < 2; ++a)
#pragma unroll
            for (int b = 0; b < 2; ++b)
#pragma unroll
                for (int m = 0; m < 4; ++m)
#pragma unroll
                    for (int n = 0; n < 2; ++n) acc[a][b][m][n] = (f32x4){0.f, 0.f, 0.f, 0.f};
        cur = nxt; cA = nA; cB = nB; ++ui;
        if constexpr (ALIGN_EPI) { if (wr == 1) PG8_BAR; }
    }
    PG8_WAIT_V(0);
    if constexpr (!ALIGN_EPI) { if (wr == 0) PG8_BAR; }
    PG8_BAR;
    if constexpr (Epi::AFTER_DRAIN) { E.fused(acc, cur, wr, wc, fr, fq, lds, wid, lane); S.done(cur); }
#undef PG8_SA
#undef PG8_SB
#undef PG8_STAGE
#undef PG8_LDA
#undef PG8_LDB
#undef PG8_MMA
#undef PG8_WAIT_V
#undef PG8_WAIT_L
#undef PG8_BAR
#undef PG8_SCHED
}
}
namespace att {
#define ATT_LAS __attribute__((address_space(3)))
typedef unsigned short bf16_t;
using bf16x8 = __attribute__((ext_vector_type(8))) short;
using s16x4  = __attribute__((ext_vector_type(4))) short;
using f32x16 = __attribute__((ext_vector_type(16))) float;
using f32x4  = __attribute__((ext_vector_type(4))) float;
using u32x4  = __attribute__((ext_vector_type(4))) unsigned;
constexpr int NW = 8, QBLK = 32, KVBLK = 64;
constexpr int LDQ = 3072, LDKV = 4096, LDO = 2048, LDKPE = 64;
constexpr float SCALE = 0.07216878364870322f;
constexpr float THR = 8.f;
constexpr int SHM_V = KVBLK * 128 * 2, SHM_K = KVBLK * 192 * 2;
constexpr int OFF_V = 0, OFF_K = 2 * SHM_V, OFF_WS = OFF_K + 2 * SHM_K, LDS_BYTES = OFF_WS + NW * 64 * 4;
#define ATT_KSWZ(row, colB) ((row) * 384 + ((colB) ^ (((row) & 7) << 4)))
#define ATT_SBAR() __builtin_amdgcn_sched_barrier(0)
__device__ __forceinline__ int crow(int r, int hi) { return (r & 3) + 8 * (r >> 2) + 4 * hi; }
__device__ __forceinline__ unsigned cvtpk(float lo, float hi) { unsigned r; asm volatile("v_cvt_pk_bf16_f32 %0, %1, %2" : "=v"(r) : "v"(lo), "v"(hi)); return r; }
__device__ __forceinline__ float bf2f(short s) { return __uint_as_float(((unsigned)(unsigned short)s) << 16); }

__device__ __forceinline__ void partialSM(f32x16& p0, f32x16& p1, float& m_reg, float& mn, float& alpha) {
  constexpr float C = SCALE * 1.4426950408889634f;
  float pmax = p0[0];
#pragma unroll
  for (int r = 1; r < 16; ++r) pmax = fmaxf(pmax, p0[r]);
#pragma unroll
  for (int r = 0; r < 16; ++r) pmax = fmaxf(pmax, p1[r]);
  { auto rr = __builtin_amdgcn_permlane32_swap(__float_as_uint(pmax), __float_as_uint(pmax), false, false);
    pmax = fmaxf(__uint_as_float(rr[0]), __uint_as_float(rr[1])); }
  if (__builtin_expect(__all(pmax - m_reg <= THR / SCALE), 1)) { mn = m_reg; alpha = 1.f; }
  else { mn = fmaxf(m_reg, pmax); alpha = __builtin_amdgcn_exp2f((m_reg - mn) * C); m_reg = mn; }
  float mnC = -mn * C;
#pragma unroll
  for (int r = 0; r < 16; ++r) p0[r] = fmaf(p0[r], C, mnC);
#pragma unroll
  for (int r = 0; r < 16; ++r) p1[r] = fmaf(p1[r], C, mnC);
#pragma unroll
  for (int r = 0; r < 16; ++r) p0[r] = __builtin_amdgcn_exp2f(p0[r]);
}
__device__ __forceinline__ void finishSM(f32x16& p0, f32x16& p1, float alpha, float& l_reg, bf16x8& pa0, bf16x8& pa1, bf16x8& pa2, bf16x8& pa3) {
#pragma unroll
  for (int r = 0; r < 16; ++r) p1[r] = __builtin_amdgcn_exp2f(p1[r]);
  float ps = 0;
#pragma unroll
  for (int r = 0; r < 16; ++r) ps += p0[r];
#pragma unroll
  for (int r = 0; r < 16; ++r) ps += p1[r];
  { auto rr = __builtin_amdgcn_permlane32_swap(__float_as_uint(ps), __float_as_uint(ps), false, false);
    ps = __uint_as_float(rr[0]) + __uint_as_float(rr[1]); }
  l_reg = l_reg * alpha + ps;
#define ATT_PK4(P, BASE, OUT) do { unsigned a0 = cvtpk(P[BASE + 0], P[BASE + 1]), a1 = cvtpk(P[BASE + 2], P[BASE + 3]);   \
    unsigned b0 = cvtpk(P[BASE + 4], P[BASE + 5]), b1 = cvtpk(P[BASE + 6], P[BASE + 7]);                              \
    auto r0 = __builtin_amdgcn_permlane32_swap(a0, b0, false, false); auto r1 = __builtin_amdgcn_permlane32_swap(a1, b1, false, false); \
    u32x4 w = {r0[0], r1[0], r0[1], r1[1]}; OUT = __builtin_bit_cast(bf16x8, w); } while (0)
  ATT_PK4(p0, 0, pa0); ATT_PK4(p0, 8, pa1); ATT_PK4(p1, 0, pa2); ATT_PK4(p1, 8, pa3);
#undef ATT_PK4
}
__device__ __forceinline__ void qkt(f32x16& p0, f32x16& p1, const ATT_LAS char* Ks, const bf16x8 (&qr)[12], int r32, int hi) {
  p0 = f32x16{}; p1 = f32x16{};
#pragma unroll
  for (int d0 = 0; d0 < 12; ++d0) { const int cb = (d0 * 16 + hi * 8) * 2;
    const bf16x8 b0 = *reinterpret_cast<const ATT_LAS bf16x8*>(Ks + ATT_KSWZ(r32, cb));
    const bf16x8 b1 = *reinterpret_cast<const ATT_LAS bf16x8*>(Ks + ATT_KSWZ(32 + r32, cb));
    p0 = __builtin_amdgcn_mfma_f32_32x32x16_bf16(b0, qr[d0], p0, 0, 0, 0);
    p1 = __builtin_amdgcn_mfma_f32_32x32x16_bf16(b1, qr[d0], p1, 0, 0, 0); }
}
__device__ __forceinline__ int v_st(int k, int c) { const int kk = (k & ~0xC) | ((k & 4) << 1) | ((k & 8) >> 1); return ((kk >> 3) * 4 + (c >> 5)) * 512 + ((kk & 7) * 32 + (c & 31)) * 2; }
__device__ __forceinline__ int v_rd_base(int lane) { return ((lane & 3) << 3) | (((lane >> 2) & 3) << 6) | (((lane >> 4) & 1) << 5) | (((lane >> 5) & 1) << 8); }
constexpr int v_rd_off(int d0, int ks, int half) { return d0 * 512 + ks * 4096 + half * 2048; }
template <int OFF> __device__ __forceinline__ s16x4 tr_read(int vb) {
  s16x4 r; asm volatile("ds_read_b64_tr_b16 %0, %1 offset:%2" : "=&v"(r) : "v"(vb), "i"(OFF) : "memory"); return r;
}
template <int D0> __device__ __forceinline__ void pv_one(f32x16& od, int vb, bf16x8 pa0, bf16x8 pa1, bf16x8 pa2, bf16x8 pa3) {
  const s16x4 l0 = tr_read<v_rd_off(D0, 0, 0)>(vb), h0 = tr_read<v_rd_off(D0, 0, 1)>(vb), l1 = tr_read<v_rd_off(D0, 1, 0)>(vb), h1 = tr_read<v_rd_off(D0, 1, 1)>(vb);
  const s16x4 l2 = tr_read<v_rd_off(D0, 2, 0)>(vb), h2 = tr_read<v_rd_off(D0, 2, 1)>(vb), l3 = tr_read<v_rd_off(D0, 3, 0)>(vb), h3 = tr_read<v_rd_off(D0, 3, 1)>(vb);
  asm volatile("s_waitcnt lgkmcnt(0)" ::: "memory"); ATT_SBAR();
#define ATT_PK(L, H) (bf16x8){L[0], L[1], L[2], L[3], H[0], H[1], H[2], H[3]}
  od = __builtin_amdgcn_mfma_f32_32x32x16_bf16(pa0, ATT_PK(l0, h0), od, 0, 0, 0);
  od = __builtin_amdgcn_mfma_f32_32x32x16_bf16(pa1, ATT_PK(l1, h1), od, 0, 0, 0);
  od = __builtin_amdgcn_mfma_f32_32x32x16_bf16(pa2, ATT_PK(l2, h2), od, 0, 0, 0);
  od = __builtin_amdgcn_mfma_f32_32x32x16_bf16(pa3, ATT_PK(l3, h3), od, 0, 0, 0);
#undef ATT_PK
}

__device__ __forceinline__ void attn_unit(ATT_LAS unsigned char* lds, const bf16_t* __restrict__ Q, const bf16_t* __restrict__ KV, const bf16_t* __restrict__ KPE,
                                          bf16_t* __restrict__ O, int nkeys, int rope, int t0, const float* __restrict__ ROPE) {
  int tid_l = threadIdx.x; asm volatile("" : "+v"(tid_l));
  const int tid = tid_l, wid = tid >> 6, lane = tid & 63, r32 = lane & 31, hi = lane >> 5;
  ATT_LAS char* V_lds = (ATT_LAS char*)lds + OFF_V; ATT_LAS char* K_lds = (ATT_LAS char*)lds + OFF_K;
  ATT_LAS float* wsf = (ATT_LAS float*)((ATT_LAS char*)lds + OFF_WS) + wid * 64; ATT_LAS float* li_l = wsf; ATT_LAS float* al_l = wsf + 32;
  float m_reg = -1e30f, l_reg = 0.f; f32x16 o[4] = {}; bf16x8 qr[12];
  const bf16_t* Qw = Q + (size_t)(wid * QBLK + r32) * LDQ + hi * 8;
#pragma unroll
  for (int d0 = 0; d0 < 12; ++d0) qr[d0] = *reinterpret_cast<const bf16x8*>(Qw + d0 * 16);
  if (rope) {
    const int t = t0 + wid * QBLK + r32;
#pragma unroll
    for (int hf = 0; hf < 2; ++hf) {
      const int pos = hf ? (t & 63) : (t >> 6);
      const f32x4* tp = reinterpret_cast<const f32x4*>(ROPE + (size_t)(pos * 16 + hi * 8) * 2);
      const bf16x8 a = qr[8 + 2 * hf], b = qr[9 + 2 * hf]; u32x4 na, nb;
#pragma unroll
      for (int q = 0; q < 4; ++q) { const f32x4 cs = tp[q];
        const float x1a = bf2f(a[2 * q]), x2a = bf2f(b[2 * q]), x1b = bf2f(a[2 * q + 1]), x2b = bf2f(b[2 * q + 1]);
        na[q] = cvtpk(x1a * cs[0] - x2a * cs[1], x1b * cs[2] - x2b * cs[3]);
        nb[q] = cvtpk(x1a * cs[1] + x2a * cs[0], x1b * cs[3] + x2b * cs[2]); }
      qr[8 + 2 * hf] = __builtin_bit_cast(bf16x8, na); qr[9 + 2 * hf] = __builtin_bit_cast(bf16x8, nb);
    }
  }
  const int sr = tid >> 4, sc = (tid & 15) * 8, vst0 = v_st(sr, sc), vst1 = v_st(32 + sr, sc), kr = tid >> 3, kc = (tid & 7) * 8;
  const int vb0 = (int)(unsigned)(size_t)V_lds + v_rd_base(lane);
  bf16x8 vs0, vs1, ks0, ks1, kp0;
#define ATT_SLOAD(k0) do { const bf16_t* kvp = KV + (size_t)((k0) + sr) * LDKV + sc; \
    ks0 = *reinterpret_cast<const bf16x8*>(kvp); ks1 = *reinterpret_cast<const bf16x8*>(kvp + (size_t)32 * LDKV); \
    vs0 = *reinterpret_cast<const bf16x8*>(kvp + 128); vs1 = *reinterpret_cast<const bf16x8*>(kvp + (size_t)32 * LDKV + 128); \
    kp0 = *reinterpret_cast<const bf16x8*>(KPE + (size_t)((k0) + kr) * LDKPE + kc); } while (0)
#define ATT_SWRITE(b) do { *reinterpret_cast<ATT_LAS bf16x8*>(V_lds + (b) * SHM_V + vst0) = vs0; *reinterpret_cast<ATT_LAS bf16x8*>(V_lds + (b) * SHM_V + vst1) = vs1; \
    *reinterpret_cast<ATT_LAS bf16x8*>(K_lds + (b) * SHM_K + ATT_KSWZ(sr, sc * 2)) = ks0; *reinterpret_cast<ATT_LAS bf16x8*>(K_lds + (b) * SHM_K + ATT_KSWZ(32 + sr, sc * 2)) = ks1; \
    *reinterpret_cast<ATT_LAS bf16x8*>(K_lds + (b) * SHM_K + ATT_KSWZ(kr, 256 + kc * 2)) = kp0; } while (0)
  const int NT = nkeys / KVBLK;
  ATT_SLOAD(0); ATT_SWRITE(0); __syncthreads();
  for (int j = 0; j < NT; ++j) {
    const int b = j & 1;
    if (j + 1 < NT) ATT_SLOAD((j + 1) * KVBLK);
    f32x16 p0, p1; float mn, alpha; bf16x8 pa0, pa1, pa2, pa3;
    qkt(p0, p1, K_lds + b * SHM_K, qr, r32, hi);
    partialSM(p0, p1, m_reg, mn, alpha);
    if (__any(alpha < 1.f)) {
      if (hi == 0) al_l[r32] = alpha;
      asm volatile("s_waitcnt lgkmcnt(0)" ::: "memory");
#pragma unroll
      for (int r = 0; r < 16; ++r) { const float av = al_l[crow(r, hi)];
#pragma unroll
        for (int d = 0; d < 4; ++d) o[d][r] *= av; }
    }
    finishSM(p0, p1, alpha, l_reg, pa0, pa1, pa2, pa3); ATT_SBAR();
    const int vb = vb0 + b * SHM_V;
    pv_one<0>(o[0], vb, pa0, pa1, pa2, pa3); pv_one<1>(o[1], vb, pa0, pa1, pa2, pa3); pv_one<2>(o[2], vb, pa0, pa1, pa2, pa3); pv_one<3>(o[3], vb, pa0, pa1, pa2, pa3);
    if (j + 1 < NT) ATT_SWRITE(b ^ 1);
    __syncthreads();
  }
  if (hi == 0) li_l[r32] = l_reg;
  asm volatile("s_waitcnt lgkmcnt(0)" ::: "memory");
  bf16_t* Ow = O + (size_t)(wid * QBLK) * LDO;
#pragma unroll
  for (int r = 0; r < 16; ++r) { const int orow = crow(r, hi); const float rl = __builtin_amdgcn_rcpf(li_l[orow]);
#pragma unroll
    for (int d0 = 0; d0 < 4; ++d0) { const float v = o[d0][r] * rl; unsigned u = __float_as_uint(v); u += 0x7fffu + ((u >> 16) & 1u);
      Ow[(size_t)orow * LDO + d0 * 32 + r32] = (bf16_t)(u >> 16); } }
  asm volatile("s_waitcnt lgkmcnt(0)" ::: "memory");
#undef ATT_SLOAD
#undef ATT_SWRITE
}
}

constexpr int NWAVES = 8;
constexpr int DM = 2048, NTOK = 16384, NPROMPT = 8192, DFF = 8192, NLAYER = 4;
constexpr int SEQ_S = 2048, PAST = 512, LKS = PAST + SEQ_S, NKVROWS = NPROMPT + 4 * LKS;
constexpr int MODROW = 6 * DM;
constexpr int KS_MOD = 16;
constexpr float EPS = 1e-6f;
#ifndef MK_MULTI
#define MK_MULTI 0
#endif

constexpr size_t MiB = 1u << 20;
constexpr size_t WS_CTL = 0, CTL_ZERO_BYTES = 32768;
constexpr size_t WS_MODF = 1 * MiB;
constexpr size_t WS_ROPE = WS_MODF + (size_t)NLAYER * 5 * MODROW * 4;
constexpr size_t WS_MODP = 2 * MiB;
constexpr size_t WS_WS = 17 * MiB;
constexpr size_t WS_MLA_A = 18 * MiB;
constexpr size_t WS_QB = 23 * MiB, WS_KVB = 26 * MiB, WS_WO = 30 * MiB;
constexpr size_t WS_GIN = 38 * MiB, WS_GOUT = 54 * MiB;
constexpr size_t WS_COUT = 62 * MiB, WS_CIN = 78 * MiB;
constexpr size_t WS_W1 = 126 * MiB, WS_W2 = 254 * MiB;
constexpr size_t WS_X = 382 * MiB;
constexpr size_t WS_H = 510 * MiB;
constexpr size_t WS_A2 = 574 * MiB;
constexpr size_t WS_BIG = 638 * MiB;
constexpr size_t WS_ABF = WS_BIG, WS_Q = WS_BIG + 40 * MiB, WS_QAN = WS_BIG + 136 * MiB, WS_CKV = WS_BIG + 152 * MiB, WS_KPE = WS_BIG + 170 * MiB;
constexpr size_t WS_KV = 894 * MiB;
constexpr size_t WS_END = 1038 * MiB;
static_assert(WS_ROPE + 64 * 16 * 2 * 4 <= WS_MODP && WS_MODP + (size_t)KS_MOD * NLAYER * 5 * MODROW * 4 <= WS_WS && WS_KPE + (size_t)NKVROWS * 64 * 2 <= WS_KV, "d_ws map");
constexpr int CW_BAR = 4096;
constexpr size_t OUT_Y = 0, OUT_CKV = (size_t)NTOK * DM, OUT_KPE = OUT_CKV + (size_t)NPROMPT * 512, OUT_END = OUT_KPE + (size_t)NPROMPT * 64;

constexpr int RING_OFF = 0, RING_BYTES = 131072;
constexpr int MISC_OFF = RING_BYTES;
constexpr int LDS_BYTES = 147456;
static_assert(att::LDS_BYTES <= RING_BYTES, "attention LDS");

#define GAS __attribute__((address_space(1)))
#define LAS __attribute__((address_space(3)))
typedef unsigned short bf16;
typedef unsigned v4u __attribute__((ext_vector_type(4)));
typedef unsigned v2u __attribute__((ext_vector_type(2)));
typedef float f32x4 __attribute__((ext_vector_type(4)));
typedef short bf16x8 __attribute__((ext_vector_type(8)));
#define LDS_WAIT() asm volatile("s_waitcnt lgkmcnt(0)" ::: "memory")
#define VM_WAIT() asm volatile("s_waitcnt vmcnt(0)" ::: "memory")
__device__ __forceinline__ unsigned f2bf(float f) { unsigned u = __builtin_bit_cast(unsigned, f); return (u + 0x7fffu + ((u >> 16) & 1u)) >> 16; }
__device__ __forceinline__ unsigned pk2(float lo, float hi) { return f2bf(lo) | (f2bf(hi) << 16); }
__device__ __forceinline__ float bf2f(short s) { return __uint_as_float(((unsigned)(unsigned short)s) << 16); }
__device__ __forceinline__ float wave_sum(float v) {
#pragma unroll
    for (int o = 1; o < 64; o <<= 1) v += __shfl_xor(v, o);
    return v;
}
__device__ __forceinline__ int cond_of_row(int row) { return row < NPROMPT ? 0 : 1 + ((row - NPROMPT) >> 11); }

#define XB_TMO      128
#define XB_XCNT(j)  (256  + 64 * (j))
#define XB_XSUB(j)  (1280 + 64 * (j))
#define XB_XGEN(j)  (2304 + 64 * (j))
#define XB_TOP      3328
#define XB_TOPGEN   3392
#define XCD_BAR_WORDS 3456
#define XB_SPIN_CAP (1u << 18)

__device__ __forceinline__ unsigned xb_ld(unsigned* p)              { return __hip_atomic_load(p, __ATOMIC_RELAXED, __HIP_MEMORY_SCOPE_AGENT); }
__device__ __forceinline__ unsigned xb_add(unsigned* p, unsigned v) { return __hip_atomic_fetch_add(p, v, __ATOMIC_RELAXED, __HIP_MEMORY_SCOPE_AGENT); }
__device__ __forceinline__ unsigned xb_xcc_id() { return (unsigned)__builtin_amdgcn_s_getreg((3 << 11) | 20) & 0xFu; }
#define XB_SPIN(cond, bar) do { unsigned _sp = 0; while (cond) { __builtin_amdgcn_s_sleep(1); \
    if ((++_sp & 255u) == 0u) { if (xb_ld(&(bar)[XB_TMO])) break; if (_sp > XB_SPIN_CAP) { atomicAdd(&(bar)[XB_TMO], 1u); break; } } } } while (0)

struct XcdBarrier {
    unsigned* bar; unsigned x;
    volatile LAS unsigned* st;
};

__device__ __forceinline__ XcdBarrier xcd_barrier_post(unsigned* bar, volatile LAS unsigned* st) {
    XcdBarrier b; b.bar = bar; b.x = xb_xcc_id(); b.st = st;
    if (threadIdx.x == 0) (void)xb_add(&bar[XB_XCNT(b.x)], 1u);
    return b;
}
__device__ __forceinline__ void xcd_barrier_complete(unsigned* bar, unsigned x, unsigned& nloc, unsigned& nx) {
    const unsigned G = gridDim.x * gridDim.y * gridDim.z;
    unsigned sum, cnt, mine, sp = 0u;
    for (;;) {
        sum = 0u; cnt = 0u; mine = 0u;
#pragma unroll
        for (unsigned j = 0; j < 16; ++j) { const unsigned c = xb_ld(&bar[XB_XCNT(j)]); sum += c; cnt += (c > 0u) ? 1u : 0u; mine = (j == x) ? c : mine; }
        if (sum == G) break;
        __builtin_amdgcn_s_sleep(1);
        if ((++sp & 255u) == 0u) { if (xb_ld(&bar[XB_TMO])) break; if (sp > XB_SPIN_CAP) { atomicAdd(&bar[XB_TMO], 1u); break; } }
    }
    nloc = mine > 0u ? mine : 1u; nx = cnt > 0u ? cnt : 1u;
}

__device__ __forceinline__ void xcd_barrier(const XcdBarrier& b) {
    asm volatile("s_waitcnt vmcnt(0)" ::: "memory");
    __syncthreads();
    if (threadIdx.x == 0) {
        unsigned* bar = b.bar;
        __builtin_amdgcn_s_waitcnt(0);
        unsigned nloc = b.st[0], nx = b.st[1];
        if (nloc == 0u) { xcd_barrier_complete(bar, b.x, nloc, nx); b.st[0] = nloc; b.st[1] = nx; }
        const unsigned old = xb_add(&bar[XB_XSUB(b.x)], 1u);
        const unsigned gen = old / nloc;
        if (old + 1u == (gen + 1u) * nloc) {
            __builtin_amdgcn_fence(__ATOMIC_RELEASE, "agent");
            asm volatile("s_waitcnt vmcnt(0)" ::: "memory");
            const unsigned og = xb_add(&bar[XB_TOP], 1u);
            const unsigned tg = og / nx;
            if (og + 1u == (tg + 1u) * nx) xb_add(&bar[XB_TOPGEN], 1u);
            else XB_SPIN(xb_ld(&bar[XB_TOPGEN]) == tg, bar);
            __builtin_amdgcn_fence(__ATOMIC_ACQUIRE, "agent");
            xb_add(&bar[XB_XGEN(b.x)], 1u);
            asm volatile("s_waitcnt vmcnt(0)" ::: "memory");
        } else {
            XB_SPIN(xb_ld(&bar[XB_XGEN(b.x)]) == gen, bar);
            __builtin_amdgcn_fence(__ATOMIC_ACQUIRE, "agent");
            asm volatile("s_waitcnt vmcnt(0)" ::: "memory");
        }
    }
    __syncthreads();
}
constexpr int N_MOD = NLAYER * (MODROW / 256) * KS_MOD;
constexpr int I_CIN = (DM / 64) * (6144 / 32), I_SQ = (DM / 64) * (DM / 32), I_GIN = (DM / 64) * (4096 / 32), I_QA = (DM / 64) * (512 / 32), I_KVA = (DM / 64) * (576 / 32),
              I_QB = (512 / 64) * (3072 / 32), I_KVB = (512 / 64) * (4096 / 32), I_W1 = (DM / 64) * (DFF / 32), I_W2 = (DFF / 64) * (DM / 32);
constexpr int N_TR = 2 * I_CIN + 2 * I_SQ + I_GIN + I_SQ + I_QA + I_KVA + I_QB + I_KVB + I_SQ + 4 * I_W1 + 4 * I_W2;
constexpr int N_WSI = 512, N_ZI = 768, N_P0 = N_MOD + N_TR + N_WSI + N_ZI;

struct Ptrs {
    const float *xp, *xs, *cache_ckv, *cache_kpe, *c, *c_ctx, *ada_w, *ada_b, *norm1, *norm2, *conv_w_in, *conv_w, *conv_w_out, *gmlp_w_in, *gmlp_g_v, *gmlp_w_s, *gmlp_b_s, *gmlp_w_out,
                *mla_w_q_a, *mla_g_q, *mla_w_q_b, *mla_w_kv_a, *mla_g_kv, *mla_w_kv_b, *mla_w_o, *mlp_w1, *mlp_w2, *final_norm;
    float* out; unsigned char* ws;
};

struct Args { const float* in[28]; float* out; unsigned char* ws; int ph_lo, ph_hi; };
__device__ __forceinline__ Ptrs make_ptrs() {
    const __attribute__((address_space(4))) Args* ap = (const __attribute__((address_space(4))) Args*)__builtin_amdgcn_kernarg_segment_ptr();
    asm volatile("" : "+s"(ap));
    Ptrs P;
    P.xp = ap->in[0]; P.xs = ap->in[1]; P.cache_ckv = ap->in[2]; P.cache_kpe = ap->in[3]; P.c = ap->in[4]; P.c_ctx = ap->in[5]; P.ada_w = ap->in[6]; P.ada_b = ap->in[7];
    P.norm1 = ap->in[8]; P.norm2 = ap->in[9]; P.conv_w_in = ap->in[10]; P.conv_w = ap->in[11]; P.conv_w_out = ap->in[12]; P.gmlp_w_in = ap->in[13]; P.gmlp_g_v = ap->in[14];
    P.gmlp_w_s = ap->in[15]; P.gmlp_b_s = ap->in[16]; P.gmlp_w_out = ap->in[17]; P.mla_w_q_a = ap->in[18]; P.mla_g_q = ap->in[19]; P.mla_w_q_b = ap->in[20]; P.mla_w_kv_a = ap->in[21];
    P.mla_g_kv = ap->in[22]; P.mla_w_kv_b = ap->in[23]; P.mla_w_o = ap->in[24]; P.mlp_w1 = ap->in[25]; P.mlp_w2 = ap->in[26]; P.final_norm = ap->in[27];
    P.out = ap->out; P.ws = ap->ws;
    return P;
}
struct Ctx { int tid, lane, wave, G, bx, gw, NGW; };
__device__ __forceinline__ Ctx make_ctx() {
    int t = threadIdx.x; asm volatile("" : "+v"(t));
    int b = blockIdx.x; asm volatile("" : "+s"(b));
    Ctx C; C.tid = t; C.lane = t & 63; C.wave = __builtin_amdgcn_readfirstlane(t >> 6); C.G = gridDim.x; C.bx = b;
    const int vcu = (C.G % 8 == 0) ? (b % 8) * (C.G / 8) + b / 8 : b;
    C.gw = vcu * NWAVES + C.wave; C.NGW = C.G * NWAVES;
    return C;
}

__device__ __forceinline__ void p0_transpose_item(const float* W, int K, int N, bf16* WT, int row_off, LAS float* scr, int item, int lane) {
    const int nblk = N / 32, kb = item / nblk, nb = item - kb * nblk, k0 = 64 * kb, n0 = 32 * nb;
    const int lk = lane >> 3, ln = (lane & 7) * 4;
    f32x4 v[8];
#pragma unroll
    for (int i = 0; i < 8; ++i) v[i] = *(const f32x4*)(W + (size_t)(k0 + 8 * i + lk) * N + n0 + ln);
#pragma unroll
    for (int i = 0; i < 8; ++i) { LAS float* d = scr + (8 * i + lk) * 33 + ln; d[0] = v[i][0]; d[1] = v[i][1]; d[2] = v[i][2]; d[3] = v[i][3]; }
    LDS_WAIT(); asm volatile("" ::: "memory");
    const int c = lane & 7;
#pragma unroll
    for (int j = 0; j < 4; ++j) { const int n = (lane >> 3) + 8 * j; const LAS float* s = scr + (8 * c) * 33 + n;
        v4u o; o.x = pk2(s[0 * 33], s[1 * 33]); o.y = pk2(s[2 * 33], s[3 * 33]); o.z = pk2(s[4 * 33], s[5 * 33]); o.w = pk2(s[6 * 33], s[7 * 33]);
        *(v4u*)(WT + (size_t)(row_off + n0 + n) * K + k0 + 8 * c) = o; }
    LDS_WAIT(); asm volatile("" ::: "memory");
}


__device__ __forceinline__ void p0a_phase(LAS unsigned char* lds) {
    const Ctx C = make_ctx(); const Ptrs P = make_ptrs(); const int gw = C.gw, NGW = C.NGW, tid = C.tid, wave = C.wave, lane = C.lane;
    LAS float* silu = (LAS float*)lds;
    for (int i = tid; i < 5 * DM; i += NWAVES * 64) { const int cd = i >> 11, k = i & (DM - 1); const float x = cd == 0 ? P.c_ctx[k] : P.c[(cd - 1) * DM + k]; silu[i] = x / (1.f + expf(-x)); }
    __syncthreads();
    LAS float* scr = (LAS float*)(lds + 40960 + wave * 8448);
    float* modp = (float*)(P.ws + WS_MODP);
    for (int it = gw; it < N_P0; it += NGW) {
        if (it < N_MOD) {
            const int L = it / (N_MOD / NLAYER), rem = it - L * (N_MOD / NLAYER), jb = rem / KS_MOD, ks = rem - jb * KS_MOD;
            const float* W = P.ada_w + ((size_t)L * DM + (size_t)ks * 128) * MODROW + jb * 256 + lane * 4;
            f32x4 acc[5];
#pragma unroll
            for (int cd = 0; cd < 5; ++cd) acc[cd] = (f32x4){0.f, 0.f, 0.f, 0.f};
            for (int k = 0; k < 128; k += 16) { f32x4 w[16];
#pragma unroll
                for (int i = 0; i < 16; ++i) w[i] = *(const f32x4*)(W + (size_t)(k + i) * MODROW);
#pragma unroll
                for (int i = 0; i < 16; ++i)
#pragma unroll
                    for (int cd = 0; cd < 5; ++cd) acc[cd] += w[i] * silu[cd * DM + ks * 128 + k + i]; }
#pragma unroll
            for (int cd = 0; cd < 5; ++cd) *(f32x4*)(modp + ((size_t)(ks * NLAYER + L) * 5 + cd) * MODROW + jb * 256 + lane * 4) = acc[cd];
            continue; }
        int r = it - N_MOD;
        if (r < N_TR) {
            const float* W; int K, N, ro = 0; size_t dst;
            if (r < 2 * I_CIN) { const int l = r / I_CIN; r -= l * I_CIN; W = P.conv_w_in + (size_t)l * DM * 6144; K = DM; N = 6144; dst = WS_CIN + (size_t)l * 6144 * DM * 2; }
            else if ((r -= 2 * I_CIN) < 2 * I_SQ) { const int l = r / I_SQ; r -= l * I_SQ; W = P.conv_w_out + (size_t)l * DM * DM; K = DM; N = DM; dst = WS_COUT + (size_t)l * DM * DM * 2; }
            else if ((r -= 2 * I_SQ) < I_GIN) { W = P.gmlp_w_in; K = DM; N = 4096; dst = WS_GIN; }
            else if ((r -= I_GIN) < I_SQ) { W = P.gmlp_w_out; K = DM; N = DM; dst = WS_GOUT; }
            else if ((r -= I_SQ) < I_QA) { W = P.mla_w_q_a; K = DM; N = 512; dst = WS_MLA_A; }
            else if ((r -= I_QA) < I_KVA) { W = P.mla_w_kv_a; K = DM; N = 576; dst = WS_MLA_A; ro = 512; }
            else if ((r -= I_KVA) < I_QB) { W = P.mla_w_q_b; K = 512; N = 3072; dst = WS_QB; }
            else if ((r -= I_QB) < I_KVB) { W = P.mla_w_kv_b; K = 512; N = 4096; dst = WS_KVB; }
            else if ((r -= I_KVB) < I_SQ) { W = P.mla_w_o; K = DM; N = DM; dst = WS_WO; }
            else if ((r -= I_SQ) < 4 * I_W1) { const int l = r / I_W1; r -= l * I_W1; W = P.mlp_w1 + (size_t)l * DM * DFF; K = DM; N = DFF; dst = WS_W1 + (size_t)l * DFF * DM * 2; }
            else { r -= 4 * I_W1; const int l = r / I_W2; r -= l * I_W2; W = P.mlp_w2 + (size_t)l * DFF * DM; K = DFF; N = DM; dst = WS_W2 + (size_t)l * DM * DFF * 2; }
            p0_transpose_item(W, K, N, (bf16*)(P.ws + dst), ro, scr, r, lane);
            continue; }
        r -= N_TR;
        if (r < N_WSI) { const float* s = P.gmlp_w_s + (size_t)r * 512 + lane * 8; const f32x4 a = *(const f32x4*)s, b = *(const f32x4*)(s + 4);
            v4u o; o.x = pk2(a[0], a[1]); o.y = pk2(a[2], a[3]); o.z = pk2(b[0], b[1]); o.w = pk2(b[2], b[3]); *(v4u*)((bf16*)(P.ws + WS_WS) + (size_t)r * 512 + lane * 8) = o; continue; }
        r -= N_WSI;
        { v4u z; z.x = 0u; z.y = 0u; z.z = 0u; z.w = 0u; *(v4u*)((bf16*)(P.ws + WS_MLA_A) + (size_t)1088 * DM + (size_t)r * 512 + lane * 8) = z; }
    }
    __syncthreads();
}

__device__ __forceinline__ void sincos_d(double a, double& sn, double& cs) {
    const double k = rint(a * 0.63661977236758134308); double r = fma(-k, 1.57079632679489655800, a); r = fma(-k, 6.12323399573676603587e-17, r);
    const double r2 = r * r;
    const double s = r * (1.0 + r2 * (-1.0 / 6 + r2 * (1.0 / 120 + r2 * (-1.0 / 5040 + r2 * (1.0 / 362880 + r2 * (-1.0 / 39916800 + r2 * (1.0 / 6227020800.0 + r2 * (-1.0 / 1307674368000.0))))))));
    const double c = 1.0 + r2 * (-0.5 + r2 * (1.0 / 24 + r2 * (-1.0 / 720 + r2 * (1.0 / 40320 + r2 * (-1.0 / 3628800 + r2 * (1.0 / 479001600 + r2 * (-1.0 / 87178291200.0 + r2 * (1.0 / 20922789888000.0))))))));
    const int q = ((int)k) & 3;
    sn = q == 0 ? s : q == 1 ? c : q == 2 ? -s : -c;
    cs = q == 0 ? c : q == 1 ? -s : q == 2 ? -c : s;
}
__device__ __forceinline__ void p0b_phase() {
    const Ctx C = make_ctx(); const Ptrs P = make_ptrs(); const int gtid = C.bx * (NWAVES * 64) + C.tid, NT = C.G * NWAVES * 64;
    const float* modp = (const float*)(P.ws + WS_MODP); float* modf = (float*)(P.ws + WS_MODF);
    for (int i = gtid; i < NLAYER * 5 * MODROW; i += NT) {
        const int cidx = i & (DM - 1), lcs = i >> 11, slot = lcs % 6, lc = lcs / 6, L = lc / 5, cd = lc - 5 * L, j = slot * DM + cidx;
        float v = P.ada_b[L * MODROW + j];
#pragma unroll
        for (int ks = 0; ks < KS_MOD; ++ks) v += modp[((size_t)(ks * NLAYER + L) * 5 + cd) * MODROW + j];
        if (slot == 1) v = P.norm1[L * DM + cidx] * (1.f + v);
        if (slot == 4) v = P.norm2[L * DM + cidx] * (1.f + v);
        modf[i] = v; }
    float* rope = (float*)(P.ws + WS_ROPE);
    for (int i = gtid; i < 64 * 16; i += NT) { const int pos = i >> 4, j = i & 15;
        double inv = 1.0; for (int q = 0; q < j; ++q) inv *= 0.56234132519034908039;
        const float ang = (float)pos * (float)inv; double sn, cs; sincos_d((double)ang, sn, cs);
        rope[2 * i] = (float)cs; rope[2 * i + 1] = (float)sn; }
}

__device__ __forceinline__ void norm_phase(int L, int which, bool first) {
    const Ctx C = make_ctx(); const Ptrs P = make_ptrs(); const int gw = C.gw, NGW = C.NGW, lane = C.lane;
    const float* modf = (const float*)(P.ws + WS_MODF); bf16* X = (bf16*)(P.ws + WS_X); bf16* H = (bf16*)(P.ws + WS_H);
    for (int r0 = gw * 8; r0 < NTOK; r0 += NGW * 8) {
        const int cd = cond_of_row(r0);
        const float* wp = modf + ((size_t)(L * 5 + cd) * 6 + (which ? 4 : 1)) * DM + lane * 8;
        const float* sp = modf + ((size_t)(L * 5 + cd) * 6 + (which ? 3 : 0)) * DM + lane * 8;
        f32x4 wv[4][2], sv[4][2];
#pragma unroll
        for (int j = 0; j < 4; ++j) { wv[j][0] = *(const f32x4*)(wp + 512 * j); wv[j][1] = *(const f32x4*)(wp + 512 * j + 4); sv[j][0] = *(const f32x4*)(sp + 512 * j); sv[j][1] = *(const f32x4*)(sp + 512 * j + 4); }
        for (int rr = 0; rr < 8; ++rr) { const int row = r0 + rr;
            f32x4 v[4][2]; float ss = 0.f;
            if (first) { const float* src = (row < NPROMPT ? P.xp + (size_t)row * DM : P.xs + (size_t)(row - NPROMPT) * DM) + lane * 8;
#pragma unroll
                for (int j = 0; j < 4; ++j) { v[j][0] = *(const f32x4*)(src + 512 * j); v[j][1] = *(const f32x4*)(src + 512 * j + 4); }
#pragma unroll
                for (int j = 0; j < 4; ++j) { v4u o; o.x = pk2(v[j][0][0], v[j][0][1]); o.y = pk2(v[j][0][2], v[j][0][3]); o.z = pk2(v[j][1][0], v[j][1][1]); o.w = pk2(v[j][1][2], v[j][1][3]);
                    *(v4u*)(X + (size_t)row * DM + lane * 8 + 512 * j) = o;
                    v[j][0] = (f32x4){__uint_as_float(o.x << 16), __uint_as_float(o.x & 0xffff0000u), __uint_as_float(o.y << 16), __uint_as_float(o.y & 0xffff0000u)};
                    v[j][1] = (f32x4){__uint_as_float(o.z << 16), __uint_as_float(o.z & 0xffff0000u), __uint_as_float(o.w << 16), __uint_as_float(o.w & 0xffff0000u)}; }
            } else { const bf16* src = X + (size_t)row * DM + lane * 8;
                v4u o[4];
#pragma unroll
                for (int j = 0; j < 4; ++j) o[j] = *(const v4u*)(src + 512 * j);
#pragma unroll
                for (int j = 0; j < 4; ++j) {
                    v[j][0] = (f32x4){__uint_as_float(o[j].x << 16), __uint_as_float(o[j].x & 0xffff0000u), __uint_as_float(o[j].y << 16), __uint_as_float(o[j].y & 0xffff0000u)};
                    v[j][1] = (f32x4){__uint_as_float(o[j].z << 16), __uint_as_float(o[j].z & 0xffff0000u), __uint_as_float(o[j].w << 16), __uint_as_float(o[j].w & 0xffff0000u)}; } }
#pragma unroll
            for (int j = 0; j < 4; ++j)
#pragma unroll
                for (int h = 0; h < 2; ++h) ss += (v[j][h][0] * v[j][h][0] + v[j][h][1] * v[j][h][1]) + (v[j][h][2] * v[j][h][2] + v[j][h][3] * v[j][h][3]);
            const float rstd = 1.0f / sqrtf(wave_sum(ss) * (1.f / DM) + EPS);
#pragma unroll
            for (int j = 0; j < 4; ++j) { const f32x4 h0 = v[j][0] * rstd * wv[j][0] + sv[j][0], h1 = v[j][1] * rstd * wv[j][1] + sv[j][1];
                v4u o; o.x = pk2(h0[0], h0[1]); o.y = pk2(h0[2], h0[3]); o.z = pk2(h1[0], h1[1]); o.w = pk2(h1[2], h1[3]);
                *(v4u*)(H + (size_t)row * DM + lane * 8 + 512 * j) = o; }
        }
    }
}
__device__ __forceinline__ void final_norm_phase() {
    const Ctx C = make_ctx(); const Ptrs P = make_ptrs(); const int gw = C.gw, NGW = C.NGW, lane = C.lane;
    const bf16* X = (const bf16*)(P.ws + WS_X);
    f32x4 wv[4][2];
#pragma unroll
    for (int j = 0; j < 4; ++j) { wv[j][0] = *(const f32x4*)(P.final_norm + lane * 8 + 512 * j); wv[j][1] = *(const f32x4*)(P.final_norm + lane * 8 + 512 * j + 4); }
    for (int row = gw; row < NTOK; row += NGW) {
        const bf16* src = X + (size_t)row * DM + lane * 8;
        v4u o[4]; f32x4 v[4][2]; float ss = 0.f;
#pragma unroll
        for (int j = 0; j < 4; ++j) o[j] = *(const v4u*)(src + 512 * j);
#pragma unroll
        for (int j = 0; j < 4; ++j) {
            v[j][0] = (f32x4){__uint_as_float(o[j].x << 16), __uint_as_float(o[j].x & 0xffff0000u), __uint_as_float(o[j].y << 16), __uint_as_float(o[j].y & 0xffff0000u)};
            v[j][1] = (f32x4){__uint_as_float(o[j].z << 16), __uint_as_float(o[j].z & 0xffff0000u), __uint_as_float(o[j].w << 16), __uint_as_float(o[j].w & 0xffff0000u)};
#pragma unroll
            for (int h = 0; h < 2; ++h) ss += (v[j][h][0] * v[j][h][0] + v[j][h][1] * v[j][h][1]) + (v[j][h][2] * v[j][h][2] + v[j][h][3] * v[j][h][3]); }
        const float rstd = 1.0f / sqrtf(wave_sum(ss) * (1.f / DM) + EPS);
        float* yo = P.out + OUT_Y + (size_t)row * DM + lane * 8;
#pragma unroll
        for (int j = 0; j < 4; ++j) { *(f32x4*)(yo + 512 * j) = v[j][0] * rstd * wv[j][0]; *(f32x4*)(yo + 512 * j + 4) = v[j][1] * rstd * wv[j][1]; }
    }
}

__device__ __forceinline__ void conv_elem_phase(int jl) {
    const Ctx C = make_ctx(); const Ptrs P = make_ptrs(); const int gw = C.gw, NGW = C.NGW, lane = C.lane;
    const bf16* U = (const bf16*)(P.ws + WS_BIG); bf16* A2 = (bf16*)(P.ws + WS_A2); const float* cw = P.conv_w + (size_t)jl * 3 * DM;
    for (int item = gw; item < (NTOK / 16) * 4; item += NGW) {
        const int s = item >> 2, cb = item & 3, r0 = s * 16, c = cb * 512 + lane * 8;
        const int seqlen = r0 < NPROMPT ? 256 : SEQ_S, t0 = r0 & (seqlen - 1);
        float w0[8], w1[8], w2[8], zp[8], zc[8], zn[8];
#pragma unroll
        for (int e = 0; e < 8; ++e) { w0[e] = cw[c + e]; w1[e] = cw[DM + c + e]; w2[e] = cw[2 * DM + c + e]; }
#define CONV_Z(dst, row) do { const bf16* up = U + (size_t)(row) * 6144 + c; const bf16x8 cg = *(const bf16x8*)(up + DM), hv = *(const bf16x8*)(up + 2 * DM); \
        _Pragma("unroll") for (int e = 0; e < 8; ++e) dst[e] = bf2f(cg[e]) * bf2f(hv[e]); } while (0)
        if (t0 == 0) {
#pragma unroll
            for (int e = 0; e < 8; ++e) zp[e] = 0.f; }
        else CONV_Z(zp, r0 - 1);
        CONV_Z(zc, r0);
#pragma unroll 4
        for (int rr = 0; rr < 16; ++rr) { const int r = r0 + rr;
            if (t0 + rr == seqlen - 1) {
#pragma unroll
                for (int e = 0; e < 8; ++e) zn[e] = 0.f; }
            else CONV_Z(zn, r + 1);
            const bf16x8 bg = *(const bf16x8*)(U + (size_t)r * 6144 + c);
            float a[8];
#pragma unroll
            for (int e = 0; e < 8; ++e) { a[e] = bf2f(bg[e]) * (w0[e] * zp[e] + w1[e] * zc[e] + w2[e] * zn[e]); zp[e] = zc[e]; zc[e] = zn[e]; }
            v4u o; o.x = pk2(a[0], a[1]); o.y = pk2(a[2], a[3]); o.z = pk2(a[4], a[5]); o.w = pk2(a[6], a[7]);
            *(v4u*)(A2 + (size_t)r * DM + c) = o; }
#undef CONV_Z
    }
}

__device__ __forceinline__ void gmlp_spatial_phase(LAS unsigned char* lds) {
    const Ctx C = make_ctx(); const Ptrs P = make_ptrs(); const int G = C.G, c = C.bx;
    const int tid = C.tid, wid = tid >> 6, lane = tid & 63, r32 = lane & 31, hi = lane >> 5;
    const bf16* UV = (const bf16*)(P.ws + WS_BIG); bf16* A2 = (bf16*)(P.ws + WS_A2); const bf16* WSb = (const bf16*)(P.ws + WS_WS);
    LAS float* rs = (LAS float*)(lds + 65536);
    for (int u = c; u < 256; u += G) {
        const int n = u >> 1, hh = u & 1, R0 = n * 128;
        for (int qq = 0; qq < 16; ++qq) { const int q = wid * 16 + qq; const bf16* vr = UV + (size_t)(R0 + q) * 4096 + DM + lane * 8; float ss = 0.f;
#pragma unroll
            for (int j = 0; j < 4; ++j) { const bf16x8 x = *(const bf16x8*)(vr + 512 * j);
#pragma unroll
                for (int e = 0; e < 8; ++e) { const float f = bf2f(x[e]); ss += f * f; } }
            ss = wave_sum(ss); if (lane == 0) rs[q] = 1.0f / sqrtf(ss * (1.f / DM) + EPS); }
        __syncthreads();
        const int sr = tid >> 4, sc = (tid & 15) * 8, mi = wid & 3, dh = wid >> 2;
        for (int gi = 0; gi < 8; ++gi) { const int g = hh * 8 + gi, c0 = g * 128; LAS unsigned char* Vb = lds + (gi & 1) * 32768;
            const f32x4 ga = *(const f32x4*)(P.gmlp_g_v + c0 + sc), gb = *(const f32x4*)(P.gmlp_g_v + c0 + sc + 4);
#pragma unroll
            for (int i = 0; i < 4; ++i) { const int q = sr + 32 * i; const bf16x8 x = *(const bf16x8*)(UV + (size_t)(R0 + q) * 4096 + DM + c0 + sc); const float r = rs[q];
                v4u o; o.x = pk2(bf2f(x[0]) * r * ga[0], bf2f(x[1]) * r * ga[1]); o.y = pk2(bf2f(x[2]) * r * ga[2], bf2f(x[3]) * r * ga[3]);
                o.z = pk2(bf2f(x[4]) * r * gb[0], bf2f(x[5]) * r * gb[1]); o.w = pk2(bf2f(x[6]) * r * gb[2], bf2f(x[7]) * r * gb[3]);
                *(LAS v4u*)(Vb + (q >> 6) * 16384 + att::v_st(q & 63, sc)) = o; }
            __syncthreads();
            bf16x8 pa[2][4];
#pragma unroll
            for (int t = 0; t < 2; ++t)
#pragma unroll
                for (int s = 0; s < 4; ++s) pa[t][s] = *(const bf16x8*)(WSb + ((size_t)g * 128 + 32 * mi + r32) * 128 + 64 * t + 16 * s + 8 * hi);
            att::f32x16 od0 = {}, od1 = {};
#pragma unroll
            for (int t = 0; t < 2; ++t) { const int vb = (int)(unsigned)(size_t)Vb + t * 16384 + dh * 1024 + att::v_rd_base(lane);
                att::pv_one<0>(od0, vb, pa[t][0], pa[t][1], pa[t][2], pa[t][3]); att::pv_one<1>(od1, vb, pa[t][0], pa[t][1], pa[t][2], pa[t][3]); }
#pragma unroll
            for (int r = 0; r < 16; ++r) { const int p = 32 * mi + att::crow(r, hi); const float bias = P.gmlp_b_s[g * 128 + p]; const size_t row = (size_t)(R0 + p);
#pragma unroll
                for (int e = 0; e < 2; ++e) { const int col = c0 + 32 * (2 * dh + e) + r32; const float val = (e ? od1[r] : od0[r]) + bias;
                    const float uval = bf2f((short)UV[row * 4096 + col]); A2[row * DM + col] = (bf16)f2bf(uval * val); } }
        }
        __syncthreads();
    }
}

__device__ __forceinline__ void mla_thin_phase() {
    const Ctx C = make_ctx(); const Ptrs P = make_ptrs(); const int gw = C.gw, NGW = C.NGW, lane = C.lane;
    const bf16* ABF = (const bf16*)(P.ws + WS_ABF); bf16* QAN = (bf16*)(P.ws + WS_QAN); bf16* CKV = (bf16*)(P.ws + WS_CKV); bf16* KPE = (bf16*)(P.ws + WS_KPE); const float* rope = (const float*)(P.ws + WS_ROPE);
    const f32x4 gq0 = *(const f32x4*)(P.mla_g_q + lane * 8), gq1 = *(const f32x4*)(P.mla_g_q + lane * 8 + 4), gk0 = *(const f32x4*)(P.mla_g_kv + lane * 8), gk1 = *(const f32x4*)(P.mla_g_kv + lane * 8 + 4);
    for (int item = gw; item < NKVROWS; item += NGW) {
        if (item < NTOK) { const int row = item; const bf16* base = ABF + (size_t)row * 1280;
            const int dst = row < NPROMPT ? row : NPROMPT + ((row - NPROMPT) >> 11) * LKS + PAST + ((row - NPROMPT) & (SEQ_S - 1));
            { const bf16x8 x = *(const bf16x8*)(base + lane * 8); float f[8], ss = 0.f;
#pragma unroll
              for (int e = 0; e < 8; ++e) { f[e] = bf2f(x[e]); ss += f[e] * f[e]; }
              const float r = 1.0f / sqrtf(wave_sum(ss) * (1.f / 512) + EPS);
              v4u o; o.x = pk2(f[0] * r * gq0[0], f[1] * r * gq0[1]); o.y = pk2(f[2] * r * gq0[2], f[3] * r * gq0[3]); o.z = pk2(f[4] * r * gq1[0], f[5] * r * gq1[1]); o.w = pk2(f[6] * r * gq1[2], f[7] * r * gq1[3]);
              *(v4u*)(QAN + (size_t)row * 512 + lane * 8) = o; }
            { const bf16x8 x = *(const bf16x8*)(base + 512 + lane * 8); float f[8], ss = 0.f;
#pragma unroll
              for (int e = 0; e < 8; ++e) { f[e] = bf2f(x[e]); ss += f[e] * f[e]; }
              const float r = 1.0f / sqrtf(wave_sum(ss) * (1.f / 512) + EPS);
              f32x4 y0, y1;
#pragma unroll
              for (int e = 0; e < 4; ++e) { y0[e] = f[e] * r * gk0[e]; y1[e] = f[4 + e] * r * gk1[e]; }
              v4u o; o.x = pk2(y0[0], y0[1]); o.y = pk2(y0[2], y0[3]); o.z = pk2(y1[0], y1[1]); o.w = pk2(y1[2], y1[3]);
              *(v4u*)(CKV + (size_t)dst * 512 + lane * 8) = o;
              if (row < NPROMPT) { float* oc = P.out + OUT_CKV + (size_t)row * 512 + lane * 8; *(f32x4*)oc = y0; *(f32x4*)(oc + 4) = y1; } }
            { const float x = bf2f((short)base[1024 + lane]);
              if (row < NPROMPT) { P.out[OUT_KPE + (size_t)row * 64 + lane] = x; KPE[(size_t)dst * 64 + lane] = (bf16)f2bf(x); }
              else { const int t = (row - NPROMPT) & (SEQ_S - 1), w = lane & 31, j = w & 15, pos = (lane >> 5) ? (t & 63) : (t >> 6);
                  const float cs = rope[2 * (pos * 16 + j)], sn = rope[2 * (pos * 16 + j) + 1]; const float xo = __shfl_xor(x, 16);
                  const float y = (w >> 4) ? (xo * sn + x * cs) : (x * cs - xo * sn);
                  KPE[(size_t)dst * 64 + lane] = (bf16)f2bf(y); } }
        } else { const int cr = item - NTOK, b = cr >> 9, p = cr & (PAST - 1), dst = NPROMPT + b * LKS + p;
            const float* s = P.cache_ckv + (size_t)cr * 512 + lane * 8; const f32x4 a = *(const f32x4*)s, bb = *(const f32x4*)(s + 4);
            v4u o; o.x = pk2(a[0], a[1]); o.y = pk2(a[2], a[3]); o.z = pk2(bb[0], bb[1]); o.w = pk2(bb[2], bb[3]);
            *(v4u*)(CKV + (size_t)dst * 512 + lane * 8) = o;
            KPE[(size_t)dst * 64 + lane] = (bf16)f2bf(P.cache_kpe[(size_t)cr * 64 + lane]); }
    }
}

__device__ __forceinline__ void attn_phase(LAS unsigned char* lds) {
    const Ctx C = make_ctx(); const Ptrs P = make_ptrs(); const int G = C.G, c = C.bx;
    const bf16* Q = (const bf16*)(P.ws + WS_Q); const bf16* KV = (const bf16*)(P.ws + WS_KV); const bf16* KPE = (const bf16*)(P.ws + WS_KPE); bf16* O = (bf16*)(P.ws + WS_A2); const float* rope = (const float*)(P.ws + WS_ROPE);
    for (int id = c; id < 1024; id += G) {
        int h, qrow0, kvrow0, nkeys, rp, t0;
        if (id < 512) { const int x = id & 7, y = id >> 3, qb = y & 7, bh = x + 8 * (y >> 3), b = bh >> 4; h = bh & 15;
            qrow0 = NPROMPT + b * SEQ_S + qb * 256; kvrow0 = NPROMPT + b * LKS; nkeys = LKS; rp = 1; t0 = qb * 256; }
        else { const int i2 = id - 512, b = i2 >> 4; h = i2 & 15; qrow0 = b * 256; kvrow0 = b * 256; nkeys = 256; rp = 0; t0 = 0; }
        att::attn_unit(lds, Q + (size_t)qrow0 * att::LDQ + h * 192, KV + (size_t)kvrow0 * att::LDKV + h * 256, KPE + (size_t)kvrow0 * 64,
                       O + (size_t)qrow0 * att::LDO + h * 128, nkeys, rp, t0, rope);
    }
}

#ifndef KREP_G1
#define KREP_G1 1
#endif
#ifndef KREP_G2
#define KREP_G2 1
#endif
#ifndef KREP_W1
#define KREP_W1 1
#endif
#ifndef KREP_W2
#define KREP_W2 1
#endif
#ifndef REP_P0
#define REP_P0 1
#endif
#ifndef REP_NORM
#define REP_NORM 1
#endif
#ifndef REP_G1
#define REP_G1 1
#endif
#ifndef REP_THIN
#define REP_THIN 1
#endif
#ifndef REP_QKV
#define REP_QKV 1
#endif
#ifndef REP_ATT
#define REP_ATT 1
#endif
#ifndef REP_G2
#define REP_G2 1
#endif
#ifndef REP_W1
#define REP_W1 1
#endif
#ifndef REP_W2
#define REP_W2 1
#endif
#ifndef EN_P0
#define EN_P0 1
#endif
#ifndef EN_NORM
#define EN_NORM 1
#endif
#ifndef EN_G1
#define EN_G1 1
#endif
#ifndef EN_THIN
#define EN_THIN 1
#endif
#ifndef EN_QKV
#define EN_QKV 1
#endif
#ifndef EN_ATT
#define EN_ATT 1
#endif
#ifndef EN_G2
#define EN_G2 1
#endif
#ifndef EN_W1
#define EN_W1 1
#endif
#ifndef EN_W2
#define EN_W2 1
#endif
constexpr int N_PHASE_IDS = 2 + 9 * NLAYER + 1;
__global__ void __launch_bounds__(NWAVES * 64, 2) mk_fwd(Args args) {
    extern __shared__ __attribute__((aligned(16))) unsigned char lds_raw[];
    LAS unsigned char* lds = (LAS unsigned char*)lds_raw;
    const int tid = threadIdx.x;
    unsigned char* ws0 = args.ws;
    if (tid < 4) ((LAS unsigned*)(lds + MISC_OFF))[tid] = 0u;
    __syncthreads();
    XcdBarrier bar = xcd_barrier_post((unsigned*)(ws0 + WS_CTL) + CW_BAR, (volatile LAS unsigned*)(lds + MISC_OFF));
    const int lo = args.ph_lo, hi = args.ph_hi; const bool fused = (hi - lo) > 1;
#define PH(id) (lo <= (id) && (id) < hi)
#define SEAM() do { if (fused) xcd_barrier(bar); } while (0)

    if (EN_P0 && PH(0)) {
_Pragma("unroll 1") for (int rep = 0; rep < REP_P0; ++rep) { p0a_phase(lds); SEAM(); } }
    if (EN_P0 && PH(1)) {
_Pragma("unroll 1") for (int rep = 0; rep < REP_P0; ++rep) { p0b_phase(); SEAM(); } }

    for (int L = 0; L < NLAYER; ++L) {
        const int kind = L % 3, jl = L / 3, pb = 2 + 9 * L;
        if (EN_NORM && PH(pb + 0)) {
_Pragma("unroll 1") for (int rep = 0; rep < REP_NORM; ++rep) { norm_phase(L, 0, L == 0); SEAM(); } }
        if (EN_G1 && PH(pb + 1)) {
_Pragma("unroll 1") for (int rep = 0; rep < REP_G1; ++rep) {
            const Ctx C = make_ctx(); const Ptrs P = make_ptrs(); unsigned char* ws = P.ws; const int G = C.G, bx = C.bx; const float* modf = (const float*)(ws + WS_MODF); (void)modf;
            const bf16* Bt = kind == 0 ? (const bf16*)(ws + WS_CIN) + (size_t)jl * 6144 * DM : kind == 1 ? (const bf16*)(ws + WS_GIN) : (const bf16*)(ws + WS_MLA_A);
            const int N = kind == 0 ? 6144 : kind == 1 ? 4096 : 1280;
            pg8::Gemm g{(const bf16*)(ws + WS_H), Bt, NTOK, N, DM, KREP_G1}; pg8::StaticOrder S; S.init(NTOK, N, G, bx);
            pg8::EpiBf16 E{(bf16*)(ws + WS_BIG), N, 0, 1.0f / KREP_G1};
            pg8::gemm_phase<pg8::EpiBf16, pg8::StaticOrder, true, true>(lds + RING_OFF, g, S, E);
            SEAM(); } }
        if (EN_THIN && PH(pb + 2)) {
_Pragma("unroll 1") for (int rep = 0; rep < REP_THIN; ++rep) {
            if (kind == 0) conv_elem_phase(jl);
            else if (kind == 1) gmlp_spatial_phase(lds + RING_OFF);
            else mla_thin_phase();
            SEAM(); } }
        if (kind == 2) {
            if (EN_QKV && PH(pb + 3)) {
_Pragma("unroll 1") for (int rep = 0; rep < REP_QKV; ++rep) {
                const Ctx C = make_ctx(); const Ptrs P = make_ptrs(); unsigned char* ws = P.ws; const int G = C.G, bx = C.bx; const float* modf = (const float*)(ws + WS_MODF); (void)modf;
                { pg8::Gemm g{(const bf16*)(ws + WS_QAN), (const bf16*)(ws + WS_QB), NTOK, 3072, 512, 1}; pg8::StaticOrder S; S.init(NTOK, 3072, G, bx);
                  pg8::EpiBf16 E{(bf16*)(ws + WS_Q), 3072, 0, 1.0f};
                  pg8::gemm_phase<pg8::EpiBf16, pg8::StaticOrder, true, true>(lds + RING_OFF, g, S, E); }
                { pg8::Gemm g{(const bf16*)(ws + WS_CKV), (const bf16*)(ws + WS_KVB), NKVROWS, 4096, 512, 1}; pg8::StaticOrder S; S.init(NKVROWS, 4096, G, bx);
                  pg8::EpiBf16 E{(bf16*)(ws + WS_KV), 4096, 0, 1.0f};
                  pg8::gemm_phase<pg8::EpiBf16, pg8::StaticOrder, true, true>(lds + RING_OFF, g, S, E); }
                SEAM(); } }
            if (EN_ATT && PH(pb + 4)) {
_Pragma("unroll 1") for (int rep = 0; rep < REP_ATT; ++rep) { attn_phase(lds + RING_OFF); SEAM(); } }
        }
        if (EN_G2 && PH(pb + 5)) {
_Pragma("unroll 1") for (int rep = 0; rep < REP_G2; ++rep) {
            const Ctx C = make_ctx(); const Ptrs P = make_ptrs(); unsigned char* ws = P.ws; const int G = C.G, bx = C.bx; const float* modf = (const float*)(ws + WS_MODF); (void)modf;
            const bf16* Bt = kind == 0 ? (const bf16*)(ws + WS_COUT) + (size_t)jl * DM * DM : kind == 1 ? (const bf16*)(ws + WS_GOUT) : (const bf16*)(ws + WS_WO);
            pg8::Gemm g{(const bf16*)(ws + WS_A2), Bt, NTOK, DM, DM, KREP_G2}; pg8::StaticOrder S; S.init(NTOK, DM, G, bx);
            pg8::EpiRes E{(bf16*)(ws + WS_X), rep ? (const float*)(ws + WS_CTL) : modf + (size_t)L * 5 * MODROW + 2 * DM, DM, rep ? 0 : MODROW, 1.0f / KREP_G2};
            pg8::gemm_phase<pg8::EpiRes, pg8::StaticOrder, true, true>(lds + RING_OFF, g, S, E);
            SEAM(); } }
        if (EN_NORM && PH(pb + 6)) {
_Pragma("unroll 1") for (int rep = 0; rep < REP_NORM; ++rep) { norm_phase(L, 1, false); SEAM(); } }
        if (EN_W1 && PH(pb + 7)) {
_Pragma("unroll 1") for (int rep = 0; rep < REP_W1; ++rep) {
            const Ctx C = make_ctx(); const Ptrs P = make_ptrs(); unsigned char* ws = P.ws; const int G = C.G, bx = C.bx; const float* modf = (const float*)(ws + WS_MODF); (void)modf;
            pg8::Gemm g{(const bf16*)(ws + WS_H), (const bf16*)(ws + WS_W1) + (size_t)L * DFF * DM, NTOK, DFF, DM, KREP_W1}; pg8::StaticOrder S; S.init(NTOK, DFF, G, bx);
            pg8::EpiBf16 E{(bf16*)(ws + WS_BIG), DFF, 1, 1.0f / KREP_W1};
            pg8::gemm_phase<pg8::EpiBf16, pg8::StaticOrder, true, true>(lds + RING_OFF, g, S, E);
            SEAM(); } }
        if (EN_W2 && PH(pb + 8)) {
_Pragma("unroll 1") for (int rep = 0; rep < REP_W2; ++rep) {
            const Ctx C = make_ctx(); const Ptrs P = make_ptrs(); unsigned char* ws = P.ws; const int G = C.G, bx = C.bx; const float* modf = (const float*)(ws + WS_MODF); (void)modf;
            pg8::Gemm g{(const bf16*)(ws + WS_BIG), (const bf16*)(ws + WS_W2) + (size_t)L * DM * DFF, NTOK, DM, DFF, KREP_W2}; pg8::StaticOrder S; S.init(NTOK, DM, G, bx);
            pg8::EpiRes E{(bf16*)(ws + WS_X), rep ? (const float*)(ws + WS_CTL) : modf + (size_t)L * 5 * MODROW + 5 * DM, DM, rep ? 0 : MODROW, 1.0f / KREP_W2};
            pg8::gemm_phase<pg8::EpiRes, pg8::StaticOrder, true, true>(lds + RING_OFF, g, S, E);
            SEAM(); } }
    }
    if (EN_NORM && PH(N_PHASE_IDS - 1)) final_norm_phase();
#undef PH
#undef SEAM
}

extern "C" void kernel_launch(void* const* d_in, const int* in_sizes, int n_in, void* d_out, int out_size, void* d_ws, size_t ws_size, hipStream_t stream) {
    static int grid = 0;
    if (grid == 0) {
        if (n_in != 28 || in_sizes[0] != NPROMPT * DM || (size_t)out_size != OUT_END || ws_size < WS_END) {
            fprintf(stderr, "kernel_launch: built for 28 inputs, out of %zu floats, >= %zu bytes of workspace; got n_in %d, in0 %d, out %d, ws %zu; nothing launched\n", (size_t)OUT_END, (size_t)WS_END, n_in, n_in > 0 ? in_sizes[0] : -1, out_size, ws_size); grid = -1; return; }
        int dev = 0, cus = 0, per_cu = 0;
        if (hipGetDevice(&dev) != hipSuccess || hipDeviceGetAttribute(&cus, hipDeviceAttributeMultiprocessorCount, dev) != hipSuccess) { fprintf(stderr, "kernel_launch: device query failed\n"); grid = -1; return; }
        if (hipFuncSetAttribute((const void*)mk_fwd, hipFuncAttributeMaxDynamicSharedMemorySize, LDS_BYTES) != hipSuccess) { fprintf(stderr, "kernel_launch: hipFuncSetAttribute failed\n"); grid = -1; return; }
        if (hipOccupancyMaxActiveBlocksPerMultiprocessor(&per_cu, (const void*)mk_fwd, NWAVES * 64, LDS_BYTES) != hipSuccess || per_cu < 1)
            fprintf(stderr, "kernel_launch: note: the occupancy query reports %d workgroups per CU\n", per_cu);
        (void)hipGetLastError();
        grid = cus;
    }
    if (grid < 0) return;
    if (hipMemsetAsync((char*)d_ws + WS_CTL, 0, CTL_ZERO_BYTES, stream) != hipSuccess) { fprintf(stderr, "kernel_launch: hipMemsetAsync failed\n"); return; }
    Args a{};
    for (int i = 0; i < 28; ++i) a.in[i] = (const float*)d_in[i];
    a.out = (float*)d_out; a.ws = (unsigned char*)d_ws;
#if MK_MULTI
    for (int id = 0; id < N_PHASE_IDS; ++id) {
        if (id >= 2 && id < N_PHASE_IDS - 1) { const int L = (id - 2) / 9, slot = (id - 2) % 9; if ((slot == 3 || slot == 4) && (L % 3) != 2) continue; }
        a.ph_lo = id; a.ph_hi = id + 1;
        hipLaunchKernelGGL(mk_fwd, dim3(grid), dim3(NWAVES * 64), LDS_BYTES, stream, a);
    }
#else
    a.ph_lo = 0; a.ph_hi = N_PHASE_IDS;
    hipLaunchKernelGGL(mk_fwd, dim3(grid), dim3(NWAVES * 64), LDS_BYTES, stream, a);
#endif
    const hipError_t le = hipPeekAtLastError();
    if (le != hipSuccess) fprintf(stderr, "kernel_launch: launch failed: %s\n", hipGetErrorName(le));
}
```

```cpp
#include <hip/hip_runtime.h>
#include <cstdio>
#include <cstdint>
namespace pg8 {
#define PG8_LAS __attribute__((address_space(3)))
typedef unsigned short bf16_t;
typedef short bf16x8 __attribute__((ext_vector_type(8)));
typedef float f32x4 __attribute__((ext_vector_type(4)));
typedef unsigned u32x4 __attribute__((ext_vector_type(4)));
constexpr int BM = 256, BK = 64, HALF = 128, HTB = HALF * BK * 2  , STAGE_BYTES = 8 * HTB, NXCD = 8, WGM = 8;

__host__ __device__ __forceinline__ int lds_byte(int r, int c) { const int st = (r >> 4) * 2 + (c >> 5), rr = r & 15, cc = c & 31, ob = rr * 64 + cc * 2; return st * 1024 + (ob ^ (((ob >> 9) & 1) << 5)); }
__host__ __device__ __forceinline__ void stage_rc(int b, int& R, int& C) { const int st = b / 1024, sb = b % 1024, swz = sb ^ (((sb >> 9) & 1) << 5); R = (st >> 1) * 16 + swz / 64; C = (st & 1) * 32 + (swz % 64) / 2; }
__host__ __device__ __forceinline__ int perm32(int rho) { const int n = rho >> 4, i = rho & 15; return 8 * (i >> 2) + 4 * n + (i & 3); }

struct Unit { int pm, pn; };
struct Gemm { const bf16_t* A; const bf16_t* Bt; int M, N, K, krep; };

struct StaticOrder {
    int nM, nN, nwg, G, c;
    __host__ __device__ void init(int M, int N, int G_, int c_) { nM = M / BM; nN = N / BM; nwg = nM * nN; G = G_; c = c_; }
    __host__ __device__ bool next(int i, Unit& u) const {
        const long L = (long)i * G + c; if (L >= nwg) return false;
        int wgid = (int)L; { const int q = nwg / NXCD, r = nwg % NXCD, xcd = wgid % NXCD, off = wgid / NXCD; wgid = (xcd < r ? xcd * (q + 1) : r * (q + 1) + (xcd - r) * q) + off; }
        const int nig = WGM * nN, gid = wgid / nig, fm = gid * WGM, gsz = (nM - fm) < WGM ? (nM - fm) : WGM;
        u.pm = fm + ((wgid % nig) % gsz); u.pn = (wgid % nig) / gsz; return true;
    }
    __device__ __forceinline__ void a_ready(const Unit&) const {}
    __device__ __forceinline__ void done(const Unit&) const {}
};

struct GroupOrder {
    int nM, nN, nwg, G, c, wgm, split, base0, base1;
    __host__ __device__ void init(int nM_, int N, int G_, int c_, int wgm_, int split_, int base0_, int base1_) { nM = nM_; nN = N / BM; nwg = nM * nN; G = G_; c = c_; wgm = wgm_; split = split_; base0 = base0_; base1 = base1_; }
    __host__ __device__ bool next(int i, Unit& u) const {
        const long L = (long)i * G + c; if (L >= nwg) return false;
        int wgid = (int)L; { const int q = nwg / NXCD, r = nwg % NXCD, xcd = wgid % NXCD, off = wgid / NXCD; wgid = (xcd < r ? xcd * (q + 1) : r * (q + 1) + (xcd - r) * q) + off; }
        const int nig = wgm * nN, gid = wgid / nig, fm = gid * wgm, gsz = (nM - fm) < wgm ? (nM - fm) : wgm;
        const int pl = fm + ((wgid % nig) % gsz); u.pn = (wgid % nig) / gsz; u.pm = pl < split ? base0 + pl : base1 + (pl - split); return true;
    }
    __device__ __forceinline__ void a_ready(const Unit&) const {}
    __device__ __forceinline__ void done(const Unit&) const {}
};
#ifndef EPI_NT
#define EPI_NT 0
#endif
#ifndef EPI_REP
#define EPI_REP 1
#endif
__device__ __forceinline__ unsigned cvt_pk_bf16(float lo, float hi) { unsigned r; asm volatile("v_cvt_pk_bf16_f32 %0, %1, %2" : "=v"(r) : "v"(lo), "v"(hi)); return r; }
__device__ __forceinline__ int cond_of_tile(int pm) { return pm < 32 ? 0 : 1 + ((pm - 32) >> 3); }

struct EpiBf16 {
    static constexpr bool PERM = true, AFTER_DRAIN = false;
    bf16_t* O; int ldc; int act; float scale;
    __device__ __forceinline__ void operator()(const f32x4 (&acc)[2][2][4][2], const Unit& u, int wr, int wc, int fr, int fq) const {
        const int row0 = u.pm * BM + wr * 64 + fr, col0 = u.pn * BM + wc * 32 + 8 * fq;
        const f32x4 z4 = (f32x4){0.f, 0.f, 0.f, 0.f};
        for (int erep = 0; erep < (act ? EPI_REP : 1); ++erep) {
        asm volatile("" ::: "memory");
#pragma unroll
        for (int ai = 0; ai < 2; ++ai)
#pragma unroll
            for (int m = 0; m < 4; ++m) { bf16_t* rowp = O + (size_t)(row0 + ai * HALF + m * 16) * ldc + col0;
#pragma unroll
                for (int bj = 0; bj < 2; ++bj) { f32x4 v0 = acc[ai][bj][m][0] * scale, v1 = acc[ai][bj][m][1] * scale;
                    if (act) { v0 = __builtin_elementwise_max(v0, z4); v1 = __builtin_elementwise_max(v1, z4); v0 = v0 * v0; v1 = v1 * v1; }
                    u32x4 w; w.x = cvt_pk_bf16(v0[0], v0[1]); w.y = cvt_pk_bf16(v0[2], v0[3]); w.z = cvt_pk_bf16(v1[0], v1[1]); w.w = cvt_pk_bf16(v1[2], v1[3]);
                    if (EPI_NT) __builtin_nontemporal_store(w, (u32x4*)(rowp + bj * HALF)); else *(u32x4*)(rowp + bj * HALF) = w; } }
        }
    }
};
struct EpiRes {
    static constexpr bool PERM = true, AFTER_DRAIN = false;
    bf16_t* X; const float* gate; int ldx; int gstride; float scale; int pm0;
    __device__ __forceinline__ void operator()(const f32x4 (&acc)[2][2][4][2], const Unit& u, int wr, int wc, int fr, int fq) const {
        const float* g = gate + (size_t)cond_of_tile(u.pm + pm0) * gstride;
        const int row0 = u.pm * BM + wr * 64 + fr, col0 = u.pn * BM + wc * 32 + 8 * fq;
        f32x4 gv[2][2];
#pragma unroll
        for (int bj = 0; bj < 2; ++bj)
#pragma unroll
            for (int n = 0; n < 2; ++n) gv[bj][n] = *(const f32x4*)(g + col0 + bj * HALF + 4 * n) * scale;
#pragma unroll
        for (int ai = 0; ai < 2; ++ai) {
            u32x4 old[4][2];
#pragma unroll
            for (int m = 0; m < 4; ++m)
#pragma unroll
                for (int bj = 0; bj < 2; ++bj) old[m][bj] = *(const u32x4*)(X + (size_t)(row0 + ai * HALF + m * 16) * ldx + col0 + bj * HALF);
#pragma unroll
            for (int m = 0; m < 4; ++m) { bf16_t* rowp = X + (size_t)(row0 + ai * HALF + m * 16) * ldx + col0;
#pragma unroll
                for (int bj = 0; bj < 2; ++bj) { const u32x4 o = old[m][bj]; const f32x4 a0 = acc[ai][bj][m][0], a1 = acc[ai][bj][m][1]; const f32x4 g0 = gv[bj][0], g1 = gv[bj][1];
                    u32x4 w;
                    w.x = cvt_pk_bf16(__uint_as_float(o.x << 16) + g0[0] * a0[0], __uint_as_float(o.x & 0xffff0000u) + g0[1] * a0[1]);
                    w.y = cvt_pk_bf16(__uint_as_float(o.y << 16) + g0[2] * a0[2], __uint_as_float(o.y & 0xffff0000u) + g0[3] * a0[3]);
                    w.z = cvt_pk_bf16(__uint_as_float(o.z << 16) + g1[0] * a1[0], __uint_as_float(o.z & 0xffff0000u) + g1[1] * a1[1]);
                    w.w = cvt_pk_bf16(__uint_as_float(o.w << 16) + g1[2] * a1[2], __uint_as_float(o.w & 0xffff0000u) + g1[3] * a1[3]);
                    *(u32x4*)(rowp + bj * HALF) = w; } }
            asm volatile("" ::: "memory"); }
    }
};

template <class Epi, class Sched, bool ALIGN_EPI = false, bool SP2 = false>
__device__ __forceinline__ void gemm_phase(PG8_LAS unsigned char* lds, const Gemm g, const Sched& S, const Epi& E) {
    int tid_l = threadIdx.x; asm volatile("" : "+v"(tid_l));
    const int tid = tid_l, wid = __builtin_amdgcn_readfirstlane(tid >> 6), lane = tid & 63, wr = wid >> 2, wc = wid & 3, fr = lane & 15, fq = lane >> 4;
    const int K = g.K, nt = K / BK, ntt = nt * g.krep;
    unsigned voffA[2], voffB[2];
#pragma unroll
    for (int i = 0; i < 2; ++i) { int R, C; stage_rc(tid * 16 + i * 8192, R, C); const int Rb = Epi::PERM ? ((R & ~31) + perm32(R & 31)) : R;
        voffA[i] = (unsigned)(R * K + C) * 2u; voffB[i] = (unsigned)(Rb * K + C) * 2u; }
    const size_t kstep = (size_t)(BK * 2);
    const size_t hstep = (size_t)HALF * K * 2;
    const size_t tstep = 2 * hstep;
    const unsigned ldsw = (unsigned)wid * 1024u;
    const int aoff = lds_byte(wr * 64 + fr, fq * 8), boff = lds_byte(wc * 32 + fr, fq * 8);
#define PG8_SA(b, h) (((b) * 2 + (h)) * HTB)
#define PG8_SB(b, h) ((4 + (b) * 2 + (h)) * HTB)
#define PG8_STAGE(bufoff, gbase, voff) do { _Pragma("unroll") for (int _i = 0; _i < 2; ++_i) \
        __builtin_amdgcn_global_load_lds((const unsigned*)((const char*)(gbase) + (voff)[_i]), (PG8_LAS unsigned*)(lds + (bufoff) + ldsw + _i * 8192), 16, 0, 0); } while (0)
#define PG8_LDA(dst, b, h) do { _Pragma("unroll") for (int m = 0; m < 4; ++m) _Pragma("unroll") for (int k = 0; k < 2; ++k) dst[m][k] = *(const PG8_LAS bf16x8*)(lds + PG8_SA(b, h) + aoff + m * 2048 + k * 1024); } while (0)
#define PG8_LDB(dst, b, h) do { _Pragma("unroll") for (int n = 0; n < 2; ++n) _Pragma("unroll") for (int k = 0; k < 2; ++k) dst[n][k] = *(const PG8_LAS bf16x8*)(lds + PG8_SB(b, h) + boff + n * 2048 + k * 1024); } while (0)
#define PG8_MMA(ai, bj, At, Bt) do { __builtin_amdgcn_s_setprio(1); _Pragma("unroll") for (int m = 0; m < 4; ++m) _Pragma("unroll") for (int n = 0; n < 2; ++n) _Pragma("unroll") for (int k = 0; k < 2; ++k) \
        acc[ai][bj][m][n] = __builtin_amdgcn_mfma_f32_16x16x32_bf16(Bt[n][k], At[m][k], acc[ai][bj][m][n], 0, 0, 0); __builtin_amdgcn_s_setprio(0); } while (0)
#define PG8_WAIT_V(n) asm volatile("s_waitcnt vmcnt(" #n ")" ::: "memory")
#define PG8_WAIT_L(n) asm volatile("s_waitcnt lgkmcnt(" #n ")" ::: "memory")
#define PG8_BAR __builtin_amdgcn_s_barrier()
#define PG8_SCHED __builtin_amdgcn_sched_barrier(0)
    Unit cur, nxt; int ui = 0;
    if (!S.next(0, cur)) return;
    f32x4 acc[2][2][4][2];
#pragma unroll
    for (int a = 0; a < 2; ++a)
#pragma unroll
        for (int b = 0; b < 2; ++b)
#pragma unroll
            for (int m = 0; m < 4; ++m)
#pragma unroll
                for (int n = 0; n < 2; ++n) acc[a][b][m][n] = (f32x4){0.f, 0.f, 0.f, 0.f};
    bf16x8 At[4][2], B0[2][2], B1[2][2];
    const char* cA = (const char*)g.A + (size_t)cur.pm * tstep; const char* cB = (const char*)g.Bt + (size_t)cur.pn * tstep;
    S.a_ready(cur);
    if constexpr (SP2) {
        PG8_STAGE(PG8_SB(0, 0), cB, voffB); PG8_STAGE(PG8_SB(0, 1), cB + hstep, voffB); PG8_STAGE(PG8_SA(0, 0), cA, voffA); PG8_STAGE(PG8_SA(0, 1), cA + hstep, voffA);
        if (wr == 1) PG8_BAR;
        PG8_WAIT_V(2); PG8_BAR;
        PG8_STAGE(PG8_SB(1, 0), cB + kstep, voffB); PG8_STAGE(PG8_SA(1, 0), cA + kstep, voffA); PG8_STAGE(PG8_SB(1, 1), cB + hstep + kstep, voffB);
        PG8_WAIT_V(6); PG8_BAR;
    } else {
        PG8_STAGE(PG8_SB(0, 0), cB, voffB); PG8_STAGE(PG8_SA(0, 0), cA, voffA); PG8_STAGE(PG8_SB(0, 1), cB + hstep, voffB); PG8_STAGE(PG8_SA(0, 1), cA + hstep, voffA);
        if (wr == 1) PG8_BAR;
        PG8_WAIT_V(4); PG8_BAR;
        PG8_STAGE(PG8_SB(1, 0), cB + kstep, voffB); PG8_STAGE(PG8_SA(1, 0), cA + kstep, voffA); PG8_STAGE(PG8_SB(1, 1), cB + hstep + kstep, voffB);
        PG8_WAIT_V(6); PG8_BAR;
    }
    for (;;) {
        const bool has_next = S.next(ui + 1, nxt);
        const char* nA = has_next ? (const char*)g.A + (size_t)nxt.pm * tstep : cA; const char* nB = has_next ? (const char*)g.Bt + (size_t)nxt.pn * tstep : cB;
        for (int t = 0, tm = 0; t < ntt; t += 2, tm = (tm + 2 == nt ? 0 : tm + 2)) {
            const bool last = (t == ntt - 2); const int tm2 = (tm + 2 == nt) ? 0 : tm + 2;
            const char* a1 = cA + (size_t)(tm + 1) * kstep;
            const char* a2 = last ? nA : cA + (size_t)tm2 * kstep; const char* b2 = last ? nB : cB + (size_t)tm2 * kstep;
            const char* a3 = a2 + kstep; const char* b3 = b2 + kstep;
            if (last && has_next) S.a_ready(nxt);
            if constexpr (SP2) {
            PG8_LDB(B0, 0, 0); PG8_LDB(B1, 0, 1); PG8_SCHED; PG8_LDA(At, 0, 0); PG8_STAGE(PG8_SA(1, 1), a1 + hstep, voffA);
            PG8_WAIT_V(8); PG8_WAIT_L(0); PG8_BAR; PG8_MMA(0, 0, At, B0); PG8_MMA(0, 1, At, B1); PG8_BAR; PG8_SCHED;
            PG8_LDA(At, 0, 1); PG8_STAGE(PG8_SB(0, 0), b2, voffB); PG8_STAGE(PG8_SB(0, 1), b2 + hstep, voffB); PG8_STAGE(PG8_SA(0, 0), a2, voffA);
            PG8_WAIT_V(8); PG8_WAIT_L(0); PG8_BAR; PG8_MMA(1, 0, At, B0); PG8_MMA(1, 1, At, B1); PG8_BAR; PG8_SCHED;
            PG8_LDB(B0, 1, 0); PG8_LDB(B1, 1, 1); PG8_SCHED; PG8_LDA(At, 1, 0); PG8_STAGE(PG8_SA(0, 1), a2 + hstep, voffA);
            PG8_WAIT_V(8); PG8_WAIT_L(0); PG8_BAR; PG8_MMA(0, 0, At, B0); PG8_MMA(0, 1, At, B1); PG8_BAR; PG8_SCHED;
            PG8_LDA(At, 1, 1); PG8_STAGE(PG8_SB(1, 0), b3, voffB); PG8_STAGE(PG8_SB(1, 1), b3 + hstep, voffB); PG8_STAGE(PG8_SA(1, 0), a3, voffA);
            PG8_WAIT_V(8); PG8_WAIT_L(0); PG8_BAR; PG8_MMA(1, 0, At, B0); PG8_MMA(1, 1, At, B1); PG8_BAR; PG8_SCHED;
            } else {
            PG8_LDB(B0, 0, 0); PG8_SCHED; PG8_LDA(At, 0, 0); PG8_STAGE(PG8_SA(1, 1), a1 + hstep, voffA);
            PG8_WAIT_L(8); PG8_BAR; PG8_WAIT_L(0); PG8_MMA(0, 0, At, B0); PG8_BAR; PG8_SCHED;
            PG8_LDB(B1, 0, 1); PG8_STAGE(PG8_SB(0, 0), b2, voffB);
            PG8_BAR; PG8_WAIT_L(0); PG8_MMA(0, 1, At, B1); PG8_BAR;
            PG8_LDA(At, 0, 1); PG8_STAGE(PG8_SA(0, 0), a2, voffA);
            PG8_BAR; PG8_WAIT_L(0); PG8_MMA(1, 0, At, B0); PG8_BAR; PG8_SCHED;
            PG8_STAGE(PG8_SB(0, 1), b2 + hstep, voffB);
            PG8_WAIT_V(6); PG8_BAR; PG8_MMA(1, 1, At, B1); PG8_BAR;
            PG8_LDB(B0, 1, 0); PG8_SCHED; PG8_LDA(At, 1, 0); PG8_STAGE(PG8_SA(0, 1), a2 + hstep, voffA);
            PG8_WAIT_L(8); PG8_BAR; PG8_WAIT_L(0); PG8_MMA(0, 0, At, B0); PG8_BAR; PG8_SCHED;
            PG8_LDB(B1, 1, 1); PG8_STAGE(PG8_SB(1, 0), b3, voffB);
            PG8_BAR; PG8_WAIT_L(0); PG8_MMA(0, 1, At, B1); PG8_BAR;
            PG8_LDA(At, 1, 1); PG8_STAGE(PG8_SA(1, 0), a3, voffA);
            PG8_BAR; PG8_WAIT_L(0); PG8_MMA(1, 0, At, B0); PG8_BAR; PG8_SCHED;
            PG8_STAGE(PG8_SB(1, 1), b3 + hstep, voffB);
            PG8_WAIT_V(6); PG8_BAR; PG8_MMA(1, 1, At, B1); PG8_BAR;
            }
        }
        if constexpr (ALIGN_EPI) { if (wr == 0) PG8_BAR; }
        if constexpr (!Epi::AFTER_DRAIN) { E(acc, cur, wr, wc, fr, fq); S.done(cur); }
        if (!has_next) break;
#pragma unroll
        for (int a = 0; a < 2; ++a)
#pragma unroll
            for (int b = 0; b < 2; ++b)
#pragma unroll
                for (int m = 0; m < 4; ++m)
#pragma unroll
                    for (int n = 0; n < 2; ++n) acc[a][b][m][n] = (f32x4){0.f, 0.f, 0.f, 0.f};
        cur = nxt; cA = nA; cB = nB; ++ui;
        if constexpr (ALIGN_EPI) { if (wr == 1) PG8_BAR; }
    }
    PG8_WAIT_V(0);
    if constexpr (!ALIGN_EPI) { if (wr == 0) PG8_BAR; }
    PG8_BAR;
    if constexpr (Epi::AFTER_DRAIN) { E.fused(acc, cur, wr, wc, fr, fq, lds, wid, lane); S.done(cur); }
#undef PG8_SA
#undef PG8_SB
#undef PG8_STAGE
#undef PG8_LDA
#undef PG8_LDB
#undef PG8_MMA
#undef PG8_WAIT_V
#undef PG8_WAIT_L
#undef PG8_BAR
#undef PG8_SCHED
}
}
namespace att {
#define ATT_LAS __attribute__((address_space(3)))
typedef unsigned short bf16_t;
using bf16x8 = __attribute__((ext_vector_type(8))) short;
using s16x4  = __attribute__((ext_vector_type(4))) short;
using f32x16 = __attribute__((ext_vector_type(16))) float;
using f32x4  = __attribute__((ext_vector_type(4))) float;
using u32x4  = __attribute__((ext_vector_type(4))) unsigned;
constexpr int NW = 8, QBLK = 32, KVBLK = 64;
constexpr int LDQ = 3072, LDKV = 4096, LDO = 2048, LDKPE = 64;
constexpr float SCALE = 0.07216878364870322f;
constexpr float THR = 8.f;
constexpr int SHM_V = KVBLK * 128 * 2, SHM_KN = KVBLK * 128 * 2, SHM_KP = KVBLK * 64 * 2;
constexpr int NVB = 3, NKB = 2;
constexpr int OFF_V = 0, OFF_KN = NVB * SHM_V, OFF_KP = OFF_KN + NKB * SHM_KN, OFF_WS = OFF_KP + NKB * SHM_KP, LDS_BYTES = OFF_WS + NW * 64 * 4;
#define ATT_KNSWZ(row, colB) ((row) * 256 + ((colB) ^ (((row) & 7) << 4)))
#define ATT_KPSWZ(row, colB) ((row) * 128 + ((colB) ^ (((row) & 7) << 4)))
#define ATT_SBAR() __builtin_amdgcn_sched_barrier(0)
__device__ __forceinline__ int crow(int r, int hi) { return (r & 3) + 8 * (r >> 2) + 4 * hi; }
__device__ __forceinline__ unsigned cvtpk(float lo, float hi) { unsigned r; asm volatile("v_cvt_pk_bf16_f32 %0, %1, %2" : "=v"(r) : "v"(lo), "v"(hi)); return r; }
__device__ __forceinline__ float bf2f(short s) { return __uint_as_float(((unsigned)(unsigned short)s) << 16); }

__device__ __forceinline__ void partialSM(f32x16& p0, f32x16& p1, float& m_reg, float& mn, float& alpha) {
  constexpr float C = SCALE * 1.4426950408889634f;
  float pmax = p0[0];
#pragma unroll
  for (int r = 1; r < 16; ++r) pmax = fmaxf(pmax, p0[r]);
#pragma unroll
  for (int r = 0; r < 16; ++r) pmax = fmaxf(pmax, p1[r]);
  { auto rr = __builtin_amdgcn_permlane32_swap(__float_as_uint(pmax), __float_as_uint(pmax), false, false);
    pmax = fmaxf(__uint_as_float(rr[0]), __uint_as_float(rr[1])); }
  if (__builtin_expect(__all(pmax - m_reg <= THR / SCALE), 1)) { mn = m_reg; alpha = 1.f; }
  else { mn = fmaxf(m_reg, pmax); alpha = __builtin_amdgcn_exp2f((m_reg - mn) * C); m_reg = mn; }
  float mnC = -mn * C;
#pragma unroll
  for (int r = 0; r < 16; ++r) p0[r] = fmaf(p0[r], C, mnC);
#pragma unroll
  for (int r = 0; r < 16; ++r) p1[r] = fmaf(p1[r], C, mnC);
#pragma unroll
  for (int r = 0; r < 16; ++r) p0[r] = __builtin_amdgcn_exp2f(p0[r]);
}
__device__ __forceinline__ void finishSM(f32x16& p0, f32x16& p1, float alpha, float& l_reg, bf16x8& pa0, bf16x8& pa1, bf16x8& pa2, bf16x8& pa3) {
#pragma unroll
  for (int r = 0; r < 16; ++r) p1[r] = __builtin_amdgcn_exp2f(p1[r]);
  float ps = 0;
#pragma unroll
  for (int r = 0; r < 16; ++r) ps += p0[r];
#pragma unroll
  for (int r = 0; r < 16; ++r) ps += p1[r];
  { auto rr = __builtin_amdgcn_permlane32_swap(__float_as_uint(ps), __float_as_uint(ps), false, false);
    ps = __uint_as_float(rr[0]) + __uint_as_float(rr[1]); }
  l_reg = l_reg * alpha + ps;
#define ATT_PK4(P, BASE, OUT) do { unsigned a0 = cvtpk(P[BASE + 0], P[BASE + 1]), a1 = cvtpk(P[BASE + 2], P[BASE + 3]);   \
    unsigned b0 = cvtpk(P[BASE + 4], P[BASE + 5]), b1 = cvtpk(P[BASE + 6], P[BASE + 7]);                              \
    auto r0 = __builtin_amdgcn_permlane32_swap(a0, b0, false, false); auto r1 = __builtin_amdgcn_permlane32_swap(a1, b1, false, false); \
    u32x4 w = {r0[0], r1[0], r0[1], r1[1]}; OUT = __builtin_bit_cast(bf16x8, w); } while (0)
  ATT_PK4(p0, 0, pa0); ATT_PK4(p0, 8, pa1); ATT_PK4(p1, 0, pa2); ATT_PK4(p1, 8, pa3);
#undef ATT_PK4
}
__device__ __forceinline__ void qkt(f32x16& p0, f32x16& p1, const ATT_LAS char* Kn, const ATT_LAS char* Kp, const bf16x8 (&qr)[12], int r32, int hi) {
  p0 = f32x16{}; p1 = f32x16{};
#pragma unroll
  for (int d0 = 0; d0 < 8; ++d0) { const int cb = (d0 * 16 + hi * 8) * 2;
    const bf16x8 b0 = *reinterpret_cast<const ATT_LAS bf16x8*>(Kn + ATT_KNSWZ(r32, cb));
    const bf16x8 b1 = *reinterpret_cast<const ATT_LAS bf16x8*>(Kn + ATT_KNSWZ(32 + r32, cb));
    p0 = __builtin_amdgcn_mfma_f32_32x32x16_bf16(b0, qr[d0], p0, 0, 0, 0);
    p1 = __builtin_amdgcn_mfma_f32_32x32x16_bf16(b1, qr[d0], p1, 0, 0, 0);
    if ((d0 & 3) == 3) ATT_SBAR(); }
#pragma unroll
  for (int d0 = 8; d0 < 12; ++d0) { const int cb = ((d0 - 8) * 16 + hi * 8) * 2;
    const bf16x8 b0 = *reinterpret_cast<const ATT_LAS bf16x8*>(Kp + ATT_KPSWZ(r32, cb));
    const bf16x8 b1 = *reinterpret_cast<const ATT_LAS bf16x8*>(Kp + ATT_KPSWZ(32 + r32, cb));
    p0 = __builtin_amdgcn_mfma_f32_32x32x16_bf16(b0, qr[d0], p0, 0, 0, 0);
    p1 = __builtin_amdgcn_mfma_f32_32x32x16_bf16(b1, qr[d0], p1, 0, 0, 0); }
}
__device__ __forceinline__ int v_st(int k, int c) { const int kk = (k & ~0xC) | ((k & 4) << 1) | ((k & 8) >> 1); return ((kk >> 3) * 4 + (c >> 5)) * 512 + ((kk & 7) * 32 + (c & 31)) * 2; }
__device__ __forceinline__ int v_rd_base(int lane) { return ((lane & 3) << 3) | (((lane >> 2) & 3) << 6) | (((lane >> 4) & 1) << 5) | (((lane >> 5) & 1) << 8); }
constexpr int v_rd_off(int d0, int ks, int half) { return d0 * 512 + ks * 4096 + half * 2048; }
template <int OFF> __device__ __forceinline__ s16x4 tr_read(int vb) {
  s16x4 r; asm volatile("ds_read_b64_tr_b16 %0, %1 offset:%2" : "=&v"(r) : "v"(vb), "i"(OFF) : "memory"); return r;
}
template <int D0> __device__ __forceinline__ void pv_one(f32x16& od, int vb, bf16x8 pa0, bf16x8 pa1, bf16x8 pa2, bf16x8 pa3) {
  const s16x4 l0 = tr_read<v_rd_off(D0, 0, 0)>(vb), h0 = tr_read<v_rd_off(D0, 0, 1)>(vb), l1 = tr_read<v_rd_off(D0, 1, 0)>(vb), h1 = tr_read<v_rd_off(D0, 1, 1)>(vb);
  const s16x4 l2 = tr_read<v_rd_off(D0, 2, 0)>(vb), h2 = tr_read<v_rd_off(D0, 2, 1)>(vb), l3 = tr_read<v_rd_off(D0, 3, 0)>(vb), h3 = tr_read<v_rd_off(D0, 3, 1)>(vb);
  asm volatile("s_waitcnt lgkmcnt(0)" ::: "memory"); ATT_SBAR();
#define ATT_PK(L, H) (bf16x8){L[0], L[1], L[2], L[3], H[0], H[1], H[2], H[3]}
  od = __builtin_amdgcn_mfma_f32_32x32x16_bf16(pa0, ATT_PK(l0, h0), od, 0, 0, 0);
  od = __builtin_amdgcn_mfma_f32_32x32x16_bf16(pa1, ATT_PK(l1, h1), od, 0, 0, 0);
  od = __builtin_amdgcn_mfma_f32_32x32x16_bf16(pa2, ATT_PK(l2, h2), od, 0, 0, 0);
  od = __builtin_amdgcn_mfma_f32_32x32x16_bf16(pa3, ATT_PK(l3, h3), od, 0, 0, 0);
#undef ATT_PK
}

template <int S> __device__ __forceinline__ void qkt_h(f32x16& p, const ATT_LAS char* Kn, const ATT_LAS char* Kp, const bf16x8 (&qr)[12], int r32, int hi) {
  p = f32x16{};
#pragma unroll
  for (int d0 = 0; d0 < 8; ++d0) { const int cb = (d0 * 16 + hi * 8) * 2;
    const bf16x8 b = *reinterpret_cast<const ATT_LAS bf16x8*>(Kn + ATT_KNSWZ(32 * S + r32, cb));
    p = __builtin_amdgcn_mfma_f32_32x32x16_bf16(b, qr[d0], p, 0, 0, 0); }
#pragma unroll
  for (int d0 = 8; d0 < 12; ++d0) { const int cb = ((d0 - 8) * 16 + hi * 8) * 2;
    const bf16x8 b = *reinterpret_cast<const ATT_LAS bf16x8*>(Kp + ATT_KPSWZ(32 * S + r32, cb));
    p = __builtin_amdgcn_mfma_f32_32x32x16_bf16(b, qr[d0], p, 0, 0, 0); }
}
__device__ __forceinline__ void partialSM_h(f32x16& p, float& m_reg, float& alpha) {
  constexpr float C = SCALE * 1.4426950408889634f;
  float pmax = p[0];
#pragma unroll
  for (int r = 1; r < 16; ++r) pmax = fmaxf(pmax, p[r]);
  { auto rr = __builtin_amdgcn_permlane32_swap(__float_as_uint(pmax), __float_as_uint(pmax), false, false);
    pmax = fmaxf(__uint_as_float(rr[0]), __uint_as_float(rr[1])); }
  float mn;
  if (__builtin_expect(__all(pmax - m_reg <= THR / SCALE), 1)) { mn = m_reg; alpha = 1.f; }
  else { mn = fmaxf(m_reg, pmax); alpha = __builtin_amdgcn_exp2f((m_reg - mn) * C); m_reg = mn; }
  const float mnC = -mn * C;
#pragma unroll
  for (int r = 0; r < 16; ++r) p[r] = fmaf(p[r], C, mnC);
#pragma unroll
  for (int r = 0; r < 8; ++r) p[r] = __builtin_amdgcn_exp2f(p[r]);
}
__device__ __forceinline__ void finishSM_h(f32x16& p, float alpha, float& l_reg, bf16x8& pa0, bf16x8& pa1) {
#pragma unroll
  for (int r = 8; r < 16; ++r) p[r] = __builtin_amdgcn_exp2f(p[r]);
  float ps = 0;
#pragma unroll
  for (int r = 0; r < 16; ++r) ps += p[r];
  { auto rr = __builtin_amdgcn_permlane32_swap(__float_as_uint(ps), __float_as_uint(ps), false, false);
    ps = __uint_as_float(rr[0]) + __uint_as_float(rr[1]); }
  l_reg = l_reg * alpha + ps;
#define ATT_PK4(P, BASE, OUT) do { unsigned a0 = cvtpk(P[BASE + 0], P[BASE + 1]), a1 = cvtpk(P[BASE + 2], P[BASE + 3]);   \
    unsigned b0 = cvtpk(P[BASE + 4], P[BASE + 5]), b1 = cvtpk(P[BASE + 6], P[BASE + 7]);                              \
    auto r0 = __builtin_amdgcn_permlane32_swap(a0, b0, false, false); auto r1 = __builtin_amdgcn_permlane32_swap(a1, b1, false, false); \
    u32x4 w = {r0[0], r1[0], r0[1], r1[1]}; OUT = __builtin_bit_cast(bf16x8, w); } while (0)
  ATT_PK4(p, 0, pa0); ATT_PK4(p, 8, pa1);
#undef ATT_PK4
}
template <int S, int D0> __device__ __forceinline__ void pv_h_one(f32x16& od, int vb, bf16x8 pa0, bf16x8 pa1) {
  const s16x4 l0 = tr_read<v_rd_off(D0, 2 * S, 0)>(vb), h0 = tr_read<v_rd_off(D0, 2 * S, 1)>(vb), l1 = tr_read<v_rd_off(D0, 2 * S + 1, 0)>(vb), h1 = tr_read<v_rd_off(D0, 2 * S + 1, 1)>(vb);
  asm volatile("s_waitcnt lgkmcnt(0)" ::: "memory"); ATT_SBAR();
#define ATT_PK(L, H) (bf16x8){L[0], L[1], L[2], L[3], H[0], H[1], H[2], H[3]}
  od = __builtin_amdgcn_mfma_f32_32x32x16_bf16(pa0, ATT_PK(l0, h0), od, 0, 0, 0);
  od = __builtin_amdgcn_mfma_f32_32x32x16_bf16(pa1, ATT_PK(l1, h1), od, 0, 0, 0);
#undef ATT_PK
}
template <int S> __device__ __forceinline__ void pv_h(f32x16 (&o)[4], int vb, bf16x8 pa0, bf16x8 pa1) {
  pv_h_one<S, 0>(o[0], vb, pa0, pa1); pv_h_one<S, 1>(o[1], vb, pa0, pa1); pv_h_one<S, 2>(o[2], vb, pa0, pa1); pv_h_one<S, 3>(o[3], vb, pa0, pa1);
}

__device__ __forceinline__ void attn_unit(ATT_LAS unsigned char* lds, const bf16_t* __restrict__ Q, const bf16_t* __restrict__ KV, const bf16_t* __restrict__ KPE,
                                          bf16_t* __restrict__ O, int nkeys, int rope, int t0, const float* __restrict__ ROPE) {
  int tid_l = threadIdx.x; asm volatile("" : "+v"(tid_l));
  const int tid = tid_l, wid = tid >> 6, lane = tid & 63, r32 = lane & 31, hi = lane >> 5;
  ATT_LAS float* wsf = (ATT_LAS float*)((ATT_LAS char*)lds + OFF_WS) + wid * 64; ATT_LAS float* li_l = wsf; ATT_LAS float* al_l = wsf + 32;
  float m_reg = -1e30f, l_reg = 0.f; f32x16 o[4] = {}; bf16x8 qr[12];
  const bf16_t* Qw = Q + (size_t)(wid * QBLK + r32) * LDQ + hi * 8;
#pragma unroll
  for (int d0 = 0; d0 < 12; ++d0) qr[d0] = *reinterpret_cast<const bf16x8*>(Qw + d0 * 16);
  if (rope) {
    const int t = t0 + wid * QBLK + r32;
#pragma unroll
    for (int hf = 0; hf < 2; ++hf) {
      const int pos = hf ? (t & 63) : (t >> 6);
      const f32x4* tp = reinterpret_cast<const f32x4*>(ROPE + (size_t)(pos * 16 + hi * 8) * 2);
      const bf16x8 a = qr[8 + 2 * hf], b = qr[9 + 2 * hf]; u32x4 na, nb;
#pragma unroll
      for (int q = 0; q < 4; ++q) { const f32x4 cs = tp[q];
        const float x1a = bf2f(a[2 * q]), x2a = bf2f(b[2 * q]), x1b = bf2f(a[2 * q + 1]), x2b = bf2f(b[2 * q + 1]);
        na[q] = cvtpk(x1a * cs[0] - x2a * cs[1], x1b * cs[2] - x2b * cs[3]);
        nb[q] = cvtpk(x1a * cs[1] + x2a * cs[0], x1b * cs[3] + x2b * cs[2]); }
      qr[8 + 2 * hf] = __builtin_bit_cast(bf16x8, na); qr[9 + 2 * hf] = __builtin_bit_cast(bf16x8, nb);
    }
  }
  const int widu = __builtin_amdgcn_readfirstlane(wid);
  unsigned oKn[2], oV[2], oKp;
#pragma unroll
  for (int i = 0; i < 2; ++i) { const int pc = 2 * widu + i;
    { const int row = pc * 4 + (lane >> 4), col = ((lane & 15) ^ (row & 7)) * 8; oKn[i] = (unsigned)(row * LDKV + col) * 2u; }
    { const int st = pc * 2 + (lane >> 5), kk = ((st >> 2) << 3) | ((lane & 31) >> 2), k = (kk & ~0xC) | ((kk & 4) << 1) | ((kk & 8) >> 1), c = (st & 3) * 32 + (lane & 3) * 8; oV[i] = (unsigned)(k * LDKV + 128 + c) * 2u; } }
  { const int row = widu * 8 + (lane >> 3), col = ((lane & 7) ^ (row & 7)) * 8; oKp = (unsigned)(row * LDKPE + col) * 2u; }
  ATT_LAS char* V_lds = (ATT_LAS char*)lds + OFF_V; ATT_LAS char* Kn_lds = (ATT_LAS char*)lds + OFF_KN; ATT_LAS char* Kp_lds = (ATT_LAS char*)lds + OFF_KP;
  const int vb0 = (int)(unsigned)(size_t)V_lds + v_rd_base(lane);
#define ATT_DMA(t, kb, vbuf) do { const char* kvt = (const char*)KV + (size_t)(t) * (KVBLK * LDKV * 2); const char* kpt = (const char*)KPE + (size_t)(t) * (KVBLK * LDKPE * 2); \
    _Pragma("unroll") for (int _i = 0; _i < 2; ++_i) { \
      __builtin_amdgcn_global_load_lds((const unsigned*)(kvt + oKn[_i]), (ATT_LAS unsigned*)(Kn_lds + (kb) * SHM_KN + (2 * widu + _i) * 1024), 16, 0, 0); \
      __builtin_amdgcn_global_load_lds((const unsigned*)(kvt + oV[_i]), (ATT_LAS unsigned*)(V_lds + (vbuf) * SHM_V + (2 * widu + _i) * 1024), 16, 0, 0); } \
    __builtin_amdgcn_global_load_lds((const unsigned*)(kpt + oKp), (ATT_LAS unsigned*)(Kp_lds + (kb) * SHM_KP + widu * 1024), 16, 0, 0); } while (0)
#define ATT_LANDED() do { asm volatile("s_waitcnt vmcnt(0)" ::: "memory"); __builtin_amdgcn_s_barrier(); asm volatile("" ::: "memory"); } while (0)
#define ATT_RESC(a) do { if (__any((a) < 1.f)) { if (hi == 0) al_l[r32] = (a); asm volatile("s_waitcnt lgkmcnt(0)" ::: "memory"); \
    _Pragma("unroll") for (int r = 0; r < 16; ++r) { const float av = al_l[crow(r, hi)]; _Pragma("unroll") for (int d = 0; d < 4; ++d) o[d][r] *= av; } } } while (0)
#define ATT_PV(vsel) do { const int vb = vb0 + (vsel) * SHM_V; pv_one<0>(o[0], vb, pa0, pa1, pa2, pa3); pv_one<1>(o[1], vb, pa0, pa1, pa2, pa3); pv_one<2>(o[2], vb, pa0, pa1, pa2, pa3); pv_one<3>(o[3], vb, pa0, pa1, pa2, pa3); } while (0)
  const int NT = nkeys / KVBLK;
#ifndef ATT_DOUBLE
#define ATT_DOUBLE 0
#endif
#if ATT_DOUBLE
  f32x16 pA, pB; float alA, alB; bf16x8 pa0, pa1;
  ATT_DMA(0, 0, 0);
  ATT_LANDED(); if (NT > 1) ATT_DMA(1, 1, 1);
  qkt_h<0>(pA, Kn_lds, Kp_lds, qr, r32, hi); partialSM_h(pA, m_reg, alA); ATT_RESC(alA);
  int kj = 0, vj = 0;
  for (int j = 0; j < NT; ++j) {
    const int vb = vb0 + vj * SHM_V;
    ATT_SBAR(); qkt_h<1>(pB, Kn_lds + kj * SHM_KN, Kp_lds + kj * SHM_KP, qr, r32, hi);
    finishSM_h(pA, alA, l_reg, pa0, pa1); ATT_SBAR();
    pv_h<0>(o, vb, pa0, pa1); partialSM_h(pB, m_reg, alB); ATT_RESC(alB);
    if (j + 1 < NT) {
      const int vn = vj == 2 ? 0 : vj + 1, vnn = vn == 2 ? 0 : vn + 1;
      ATT_LANDED(); if (j + 2 < NT) ATT_DMA(j + 2, kj, vnn);
      ATT_SBAR(); qkt_h<0>(pA, Kn_lds + (kj ^ 1) * SHM_KN, Kp_lds + (kj ^ 1) * SHM_KP, qr, r32, hi);
      finishSM_h(pB, alB, l_reg, pa0, pa1); ATT_SBAR();
      pv_h<1>(o, vb, pa0, pa1); partialSM_h(pA, m_reg, alA); ATT_RESC(alA);
      kj ^= 1; vj = vn;
    } else {
      finishSM_h(pB, alB, l_reg, pa0, pa1); ATT_SBAR();
      pv_h<1>(o, vb, pa0, pa1);
    }
  }
#else
  ATT_DMA(0, 0, 0);
  for (int j = 0; j < NT; ++j) {
    const int b = j & 1;
    ATT_LANDED(); if (j + 1 < NT) ATT_DMA(j + 1, b ^ 1, b ^ 1);
    f32x16 p0, p1; float mn, alpha; bf16x8 pa0, pa1, pa2, pa3;
    qkt(p0, p1, Kn_lds + b * SHM_KN, Kp_lds + b * SHM_KP, qr, r32, hi);
    partialSM(p0, p1, m_reg, mn, alpha);
    ATT_RESC(alpha);
    finishSM(p0, p1, alpha, l_reg, pa0, pa1, pa2, pa3); ATT_SBAR();
    ATT_PV(b);
  }
#endif
  asm volatile("s_waitcnt lgkmcnt(0)" ::: "memory"); __builtin_amdgcn_s_barrier(); asm volatile("" ::: "memory");
  if (hi == 0) li_l[r32] = l_reg;
  asm volatile("s_waitcnt lgkmcnt(0)" ::: "memory");
  bf16_t* Ow = O + (size_t)(wid * QBLK) * LDO;
#pragma unroll
  for (int r = 0; r < 16; ++r) { const int orow = crow(r, hi); const float rl = __builtin_amdgcn_rcpf(li_l[orow]);
#pragma unroll
    for (int d0 = 0; d0 < 4; ++d0) { const float v = o[d0][r] * rl; unsigned u = __float_as_uint(v); u += 0x7fffu + ((u >> 16) & 1u);
      Ow[(size_t)orow * LDO + d0 * 32 + r32] = (bf16_t)(u >> 16); } }
  asm volatile("s_waitcnt lgkmcnt(0)" ::: "memory");
#undef ATT_DMA
#undef ATT_LANDED
#undef ATT_RESC
#undef ATT_PV
}
}

constexpr int NWAVES = 8;
constexpr int DM = 2048, NTOK = 16384, NPROMPT = 8192, DFF = 8192, NLAYER = 4;
constexpr int SEQ_S = 2048, PAST = 512, LKS = PAST + SEQ_S, NKVROWS = NPROMPT + 4 * LKS;
constexpr int MODROW = 6 * DM;
constexpr int KS_MOD = 16;
constexpr float EPS = 1e-6f;
#ifndef MK_MULTI
#define MK_MULTI 0
#endif

constexpr size_t MiB = 1u << 20;
constexpr size_t WS_CTL = 0, CTL_ZERO_BYTES = 32768;
constexpr size_t WS_MODF = 1 * MiB;
constexpr size_t WS_ROPE = WS_MODF + (size_t)NLAYER * 5 * MODROW * 4;
constexpr size_t WS_MODP = 2 * MiB;
constexpr size_t WS_WS = 17 * MiB;
constexpr size_t WS_MLA_A = 18 * MiB;
constexpr size_t WS_QB = 23 * MiB, WS_KVB = 26 * MiB, WS_WO = 30 * MiB;
constexpr size_t WS_GIN = 38 * MiB, WS_GOUT = 54 * MiB;
constexpr size_t WS_COUT = 62 * MiB, WS_CIN = 78 * MiB;
constexpr size_t WS_W1 = 126 * MiB, WS_W2 = 254 * MiB;
constexpr size_t WS_X = 382 * MiB;
constexpr size_t WS_H = 510 * MiB;
constexpr size_t WS_A2 = 574 * MiB;
constexpr size_t WS_BIG = 638 * MiB;
constexpr size_t WS_ABF = WS_BIG, WS_Q = WS_BIG + 40 * MiB, WS_QAN = WS_BIG + 136 * MiB, WS_CKV = WS_BIG + 152 * MiB, WS_KPE = WS_BIG + 170 * MiB;
constexpr size_t WS_KV = 894 * MiB;
constexpr size_t WS_END = 1038 * MiB;
static_assert(WS_ROPE + 64 * 16 * 2 * 4 <= WS_MODP && WS_MODP + (size_t)KS_MOD * NLAYER * 5 * MODROW * 4 <= WS_WS && WS_KPE + (size_t)NKVROWS * 64 * 2 <= WS_KV, "d_ws map");
constexpr int CW_BAR = 4096;
constexpr size_t OUT_Y = 0, OUT_CKV = (size_t)NTOK * DM, OUT_KPE = OUT_CKV + (size_t)NPROMPT * 512, OUT_END = OUT_KPE + (size_t)NPROMPT * 64;

constexpr int RING_OFF = 0, RING_BYTES = 131072;
constexpr int MISC_OFF = RING_BYTES;
constexpr int LDS_BYTES = 147456;
static_assert(att::LDS_BYTES <= RING_BYTES, "attention LDS");

#define GAS __attribute__((address_space(1)))
#define LAS __attribute__((address_space(3)))
typedef unsigned short bf16;
typedef unsigned v4u __attribute__((ext_vector_type(4)));
typedef unsigned v2u __attribute__((ext_vector_type(2)));
typedef float f32x4 __attribute__((ext_vector_type(4)));
typedef short bf16x8 __attribute__((ext_vector_type(8)));
#define LDS_WAIT() asm volatile("s_waitcnt lgkmcnt(0)" ::: "memory")
#define VM_WAIT() asm volatile("s_waitcnt vmcnt(0)" ::: "memory")
__device__ __forceinline__ unsigned f2bf(float f) { unsigned u = __builtin_bit_cast(unsigned, f); return (u + 0x7fffu + ((u >> 16) & 1u)) >> 16; }
__device__ __forceinline__ unsigned pk2(float lo, float hi) { return f2bf(lo) | (f2bf(hi) << 16); }
__device__ __forceinline__ float bf2f(short s) { return __uint_as_float(((unsigned)(unsigned short)s) << 16); }
__device__ __forceinline__ float wave_sum(float v) {
#pragma unroll
    for (int o = 1; o < 64; o <<= 1) v += __shfl_xor(v, o);
    return v;
}
__device__ __forceinline__ int cond_of_row(int row) { return row < NPROMPT ? 0 : 1 + ((row - NPROMPT) >> 11); }

#define XB_TMO      128
#define XB_XCNT(j)  (256  + 64 * (j))
#define XB_XSUB(j)  (1280 + 64 * (j))
#define XB_XGEN(j)  (2304 + 64 * (j))
#define XB_TOP      3328
#define XB_TOPGEN   3392
#define XCD_BAR_WORDS 3456
#define XB_SPIN_CAP (1u << 18)

__device__ __forceinline__ unsigned xb_ld(unsigned* p)              { return __hip_atomic_load(p, __ATOMIC_RELAXED, __HIP_MEMORY_SCOPE_AGENT); }
__device__ __forceinline__ unsigned xb_add(unsigned* p, unsigned v) { return __hip_atomic_fetch_add(p, v, __ATOMIC_RELAXED, __HIP_MEMORY_SCOPE_AGENT); }
__device__ __forceinline__ unsigned xb_xcc_id() { return (unsigned)__builtin_amdgcn_s_getreg((3 << 11) | 20) & 0xFu; }
#define XB_SPIN(cond, bar) do { unsigned _sp = 0; while (cond) { __builtin_amdgcn_s_sleep(1); \
    if ((++_sp & 255u) == 0u) { if (xb_ld(&(bar)[XB_TMO])) break; if (_sp > XB_SPIN_CAP) { atomicAdd(&(bar)[XB_TMO], 1u); break; } } } } while (0)

struct XcdBarrier {
    unsigned* bar; unsigned x; unsigned gsize;
    volatile LAS unsigned* st;
};

__device__ __forceinline__ XcdBarrier xcd_barrier_post(unsigned* bar, volatile LAS unsigned* st, unsigned gsize) {
    XcdBarrier b; b.bar = bar; b.x = xb_xcc_id(); b.st = st; b.gsize = gsize;
    if (threadIdx.x == 0) (void)xb_add(&bar[XB_XCNT(b.x)], 1u);
    return b;
}
__device__ __forceinline__ void xcd_barrier_complete(unsigned* bar, unsigned x, unsigned& nloc, unsigned& nx, const unsigned G) {
    unsigned sum, cnt, mine, sp = 0u;
    for (;;) {
        sum = 0u; cnt = 0u; mine = 0u;
#pragma unroll
        for (unsigned j = 0; j < 16; ++j) { const unsigned c = xb_ld(&bar[XB_XCNT(j)]); sum += c; cnt += (c > 0u) ? 1u : 0u; mine = (j == x) ? c : mine; }
        if (sum == G) break;
        __builtin_amdgcn_s_sleep(1);
        if ((++sp & 255u) == 0u) { if (xb_ld(&bar[XB_TMO])) break; if (sp > XB_SPIN_CAP) { atomicAdd(&bar[XB_TMO], 1u); break; } }
    }
    nloc = mine > 0u ? mine : 1u; nx = cnt > 0u ? cnt : 1u;
}

__device__ __forceinline__ void xcd_barrier(const XcdBarrier& b) {
    asm volatile("s_waitcnt vmcnt(0)" ::: "memory");
    __syncthreads();
    if (threadIdx.x == 0) {
        unsigned* bar = b.bar;
        __builtin_amdgcn_s_waitcnt(0);
        unsigned nloc = b.st[0], nx = b.st[1];
        if (nloc == 0u) { xcd_barrier_complete(bar, b.x, nloc, nx, b.gsize); b.st[0] = nloc; b.st[1] = nx; }
        const unsigned old = xb_add(&bar[XB_XSUB(b.x)], 1u);
        const unsigned gen = old / nloc;
        if (old + 1u == (gen + 1u) * nloc) {
            __builtin_amdgcn_fence(__ATOMIC_RELEASE, "agent");
            asm volatile("s_waitcnt vmcnt(0)" ::: "memory");
            const unsigned og = xb_add(&bar[XB_TOP], 1u);
            const unsigned tg = og / nx;
            if (og + 1u == (tg + 1u) * nx) xb_add(&bar[XB_TOPGEN], 1u);
            else XB_SPIN(xb_ld(&bar[XB_TOPGEN]) == tg, bar);
            __builtin_amdgcn_fence(__ATOMIC_ACQUIRE, "agent");
            xb_add(&bar[XB_XGEN(b.x)], 1u);
            asm volatile("s_waitcnt vmcnt(0)" ::: "memory");
        } else {
            XB_SPIN(xb_ld(&bar[XB_XGEN(b.x)]) == gen, bar);
            __builtin_amdgcn_fence(__ATOMIC_ACQUIRE, "agent");
            asm volatile("s_waitcnt vmcnt(0)" ::: "memory");
        }
    }
    __syncthreads();
}
constexpr int N_MOD = NLAYER * (MODROW / 256) * KS_MOD;
constexpr int I_CIN = (DM / 64) * (6144 / 32), I_SQ = (DM / 64) * (DM / 32), I_GIN = (DM / 64) * (4096 / 32), I_QA = (DM / 64) * (512 / 32), I_KVA = (DM / 64) * (576 / 32),
              I_QB = (512 / 64) * (3072 / 32), I_KVB = (512 / 64) * (4096 / 32), I_W1 = (DM / 64) * (DFF / 32), I_W2 = (DFF / 64) * (DM / 32);
constexpr int N_TR = 2 * I_CIN + 2 * I_SQ + I_GIN + I_SQ + I_QA + I_KVA + I_QB + I_KVB + I_SQ + 4 * I_W1 + 4 * I_W2;
constexpr int N_WSI = 512, N_ZI = 768, N_P0 = N_MOD + N_TR + N_WSI + N_ZI;

struct Ptrs {
    const float *xp, *xs, *cache_ckv, *cache_kpe, *c, *c_ctx, *ada_w, *ada_b, *norm1, *norm2, *conv_w_in, *conv_w, *conv_w_out, *gmlp_w_in, *gmlp_g_v, *gmlp_w_s, *gmlp_b_s, *gmlp_w_out,
                *mla_w_q_a, *mla_g_q, *mla_w_q_b, *mla_w_kv_a, *mla_g_kv, *mla_w_kv_b, *mla_w_o, *mlp_w1, *mlp_w2, *final_norm;
    float* out; unsigned char* ws;
};

struct Args { const float* in[28]; float* out; unsigned char* ws; int ph_lo, ph_hi; };
__device__ __forceinline__ Ptrs make_ptrs() {
    const __attribute__((address_space(4))) Args* ap = (const __attribute__((address_space(4))) Args*)__builtin_amdgcn_kernarg_segment_ptr();
    asm volatile("" : "+s"(ap));
    Ptrs P;
    P.xp = ap->in[0]; P.xs = ap->in[1]; P.cache_ckv = ap->in[2]; P.cache_kpe = ap->in[3]; P.c = ap->in[4]; P.c_ctx = ap->in[5]; P.ada_w = ap->in[6]; P.ada_b = ap->in[7];
    P.norm1 = ap->in[8]; P.norm2 = ap->in[9]; P.conv_w_in = ap->in[10]; P.conv_w = ap->in[11]; P.conv_w_out = ap->in[12]; P.gmlp_w_in = ap->in[13]; P.gmlp_g_v = ap->in[14];
    P.gmlp_w_s = ap->in[15]; P.gmlp_b_s = ap->in[16]; P.gmlp_w_out = ap->in[17]; P.mla_w_q_a = ap->in[18]; P.mla_g_q = ap->in[19]; P.mla_w_q_b = ap->in[20]; P.mla_w_kv_a = ap->in[21];
    P.mla_g_kv = ap->in[22]; P.mla_w_kv_b = ap->in[23]; P.mla_w_o = ap->in[24]; P.mlp_w1 = ap->in[25]; P.mlp_w2 = ap->in[26]; P.final_norm = ap->in[27];
    P.out = ap->out; P.ws = ap->ws;
    return P;
}
struct Ctx { int tid, lane, wave, G, bx, gw, NGW; };
__device__ __forceinline__ Ctx make_ctx() {
    int t = threadIdx.x; asm volatile("" : "+v"(t));
    int b = blockIdx.x; asm volatile("" : "+s"(b));
    Ctx C; C.tid = t; C.lane = t & 63; C.wave = __builtin_amdgcn_readfirstlane(t >> 6); C.G = gridDim.x; C.bx = b;
    const int vcu = (C.G % 8 == 0) ? (b % 8) * (C.G / 8) + b / 8 : b;
    C.gw = vcu * NWAVES + C.wave; C.NGW = C.G * NWAVES;
    return C;
}

__device__ __forceinline__ void p0_transpose_item(const float* W, int K, int N, bf16* WT, int row_off, LAS float* scr, int item, int lane) {
    const int nblk = N / 32, kb = item / nblk, nb = item - kb * nblk, k0 = 64 * kb, n0 = 32 * nb;
    const int lk = lane >> 3, ln = (lane & 7) * 4;
    f32x4 v[8];
#pragma unroll
    for (int i = 0; i < 8; ++i) v[i] = *(const f32x4*)(W + (size_t)(k0 + 8 * i + lk) * N + n0 + ln);
#pragma unroll
    for (int i = 0; i < 8; ++i) { LAS float* d = scr + (8 * i + lk) * 33 + ln; d[0] = v[i][0]; d[1] = v[i][1]; d[2] = v[i][2]; d[3] = v[i][3]; }
    LDS_WAIT(); asm volatile("" ::: "memory");
    const int c = lane & 7;
#pragma unroll
    for (int j = 0; j < 4; ++j) { const int n = (lane >> 3) + 8 * j; const LAS float* s = scr + (8 * c) * 33 + n;
        v4u o; o.x = pk2(s[0 * 33], s[1 * 33]); o.y = pk2(s[2 * 33], s[3 * 33]); o.z = pk2(s[4 * 33], s[5 * 33]); o.w = pk2(s[6 * 33], s[7 * 33]);
        *(v4u*)(WT + (size_t)(row_off + n0 + n) * K + k0 + 8 * c) = o; }
    LDS_WAIT(); asm volatile("" ::: "memory");
}


__device__ __forceinline__ void p0a_phase(LAS unsigned char* lds) {
    const Ctx C = make_ctx(); const Ptrs P = make_ptrs(); const int gw = C.gw, NGW = C.NGW, tid = C.tid, wave = C.wave, lane = C.lane;
    LAS float* silu = (LAS float*)lds;
    for (int i = tid; i < 5 * DM; i += NWAVES * 64) { const int cd = i >> 11, k = i & (DM - 1); const float x = cd == 0 ? P.c_ctx[k] : P.c[(cd - 1) * DM + k]; silu[i] = x / (1.f + expf(-x)); }
    __syncthreads();
    LAS float* scr = (LAS float*)(lds + 40960 + wave * 8448);
    float* modp = (float*)(P.ws + WS_MODP);
    for (int it = gw; it < N_P0; it += NGW) {
        if (it < N_MOD) {
            const int L = it / (N_MOD / NLAYER), rem = it - L * (N_MOD / NLAYER), jb = rem / KS_MOD, ks = rem - jb * KS_MOD;
            const float* W = P.ada_w + ((size_t)L * DM + (size_t)ks * 128) * MODROW + jb * 256 + lane * 4;
            f32x4 acc[5];
#pragma unroll
            for (int cd = 0; cd < 5; ++cd) acc[cd] = (f32x4){0.f, 0.f, 0.f, 0.f};
            for (int k = 0; k < 128; k += 16) { f32x4 w[16];
#pragma unroll
                for (int i = 0; i < 16; ++i) w[i] = *(const f32x4*)(W + (size_t)(k + i) * MODROW);
#pragma unroll
                for (int i = 0; i < 16; ++i)
#pragma unroll
                    for (int cd = 0; cd < 5; ++cd) acc[cd] += w[i] * silu[cd * DM + ks * 128 + k + i]; }
#pragma unroll
            for (int cd = 0; cd < 5; ++cd) *(f32x4*)(modp + ((size_t)(ks * NLAYER + L) * 5 + cd) * MODROW + jb * 256 + lane * 4) = acc[cd];
            continue; }
        int r = it - N_MOD;
        if (r < N_TR) {
            const float* W; int K, N, ro = 0; size_t dst;
            if (r < 2 * I_CIN) { const int l = r / I_CIN; r -= l * I_CIN; W = P.conv_w_in + (size_t)l * DM * 6144; K = DM; N = 6144; dst = WS_CIN + (size_t)l * 6144 * DM * 2; }
            else if ((r -= 2 * I_CIN) < 2 * I_SQ) { const int l = r / I_SQ; r -= l * I_SQ; W = P.conv_w_out + (size_t)l * DM * DM; K = DM; N = DM; dst = WS_COUT + (size_t)l * DM * DM * 2; }
            else if ((r -= 2 * I_SQ) < I_GIN) { W = P.gmlp_w_in; K = DM; N = 4096; dst = WS_GIN; }
            else if ((r -= I_GIN) < I_SQ) { W = P.gmlp_w_out; K = DM; N = DM; dst = WS_GOUT; }
            else if ((r -= I_SQ) < I_QA) { W = P.mla_w_q_a; K = DM; N = 512; dst = WS_MLA_A; }
            else if ((r -= I_QA) < I_KVA) { W = P.mla_w_kv_a; K = DM; N = 576; dst = WS_MLA_A; ro = 512; }
            else if ((r -= I_KVA) < I_QB) { W = P.mla_w_q_b; K = 512; N = 3072; dst = WS_QB; }
            else if ((r -= I_QB) < I_KVB) { W = P.mla_w_kv_b; K = 512; N = 4096; dst = WS_KVB; }
            else if ((r -= I_KVB) < I_SQ) { W = P.mla_w_o; K = DM; N = DM; dst = WS_WO; }
            else if ((r -= I_SQ) < 4 * I_W1) { const int l = r / I_W1; r -= l * I_W1; W = P.mlp_w1 + (size_t)l * DM * DFF; K = DM; N = DFF; dst = WS_W1 + (size_t)l * DFF * DM * 2; }
            else { r -= 4 * I_W1; const int l = r / I_W2; r -= l * I_W2; W = P.mlp_w2 + (size_t)l * DFF * DM; K = DFF; N = DM; dst = WS_W2 + (size_t)l * DM * DFF * 2; }
            p0_transpose_item(W, K, N, (bf16*)(P.ws + dst), ro, scr, r, lane);
            continue; }
        r -= N_TR;
        if (r < N_WSI) { const float* s = P.gmlp_w_s + (size_t)r * 512 + lane * 8; const f32x4 a = *(const f32x4*)s, b = *(const f32x4*)(s + 4);
            v4u o; o.x = pk2(a[0], a[1]); o.y = pk2(a[2], a[3]); o.z = pk2(b[0], b[1]); o.w = pk2(b[2], b[3]); *(v4u*)((bf16*)(P.ws + WS_WS) + (size_t)r * 512 + lane * 8) = o; continue; }
        r -= N_WSI;
        { v4u z; z.x = 0u; z.y = 0u; z.z = 0u; z.w = 0u; *(v4u*)((bf16*)(P.ws + WS_MLA_A) + (size_t)1088 * DM + (size_t)r * 512 + lane * 8) = z; }
    }
    __syncthreads();
}

__device__ __forceinline__ void sincos_d(double a, double& sn, double& cs) {
    const double k = rint(a * 0.63661977236758134308); double r = fma(-k, 1.57079632679489655800, a); r = fma(-k, 6.12323399573676603587e-17, r);
    const double r2 = r * r;
    const double s = r * (1.0 + r2 * (-1.0 / 6 + r2 * (1.0 / 120 + r2 * (-1.0 / 5040 + r2 * (1.0 / 362880 + r2 * (-1.0 / 39916800 + r2 * (1.0 / 6227020800.0 + r2 * (-1.0 / 1307674368000.0))))))));
    const double c = 1.0 + r2 * (-0.5 + r2 * (1.0 / 24 + r2 * (-1.0 / 720 + r2 * (1.0 / 40320 + r2 * (-1.0 / 3628800 + r2 * (1.0 / 479001600 + r2 * (-1.0 / 87178291200.0 + r2 * (1.0 / 20922789888000.0))))))));
    const int q = ((int)k) & 3;
    sn = q == 0 ? s : q == 1 ? c : q == 2 ? -s : -c;
    cs = q == 0 ? c : q == 1 ? -s : q == 2 ? -c : s;
}
__device__ __forceinline__ void p0b_phase() {
    const Ctx C = make_ctx(); const Ptrs P = make_ptrs(); const int gtid = C.bx * (NWAVES * 64) + C.tid, NT = C.G * NWAVES * 64;
    const float* modp = (const float*)(P.ws + WS_MODP); float* modf = (float*)(P.ws + WS_MODF);
    for (int i = gtid; i < NLAYER * 5 * MODROW; i += NT) {
        const int cidx = i & (DM - 1), lcs = i >> 11, slot = lcs % 6, lc = lcs / 6, L = lc / 5, cd = lc - 5 * L, j = slot * DM + cidx;
        float v = P.ada_b[L * MODROW + j];
#pragma unroll
        for (int ks = 0; ks < KS_MOD; ++ks) v += modp[((size_t)(ks * NLAYER + L) * 5 + cd) * MODROW + j];
        if (slot == 1) v = P.norm1[L * DM + cidx] * (1.f + v);
        if (slot == 4) v = P.norm2[L * DM + cidx] * (1.f + v);
        modf[i] = v; }
    float* rope = (float*)(P.ws + WS_ROPE);
    for (int i = gtid; i < 64 * 16; i += NT) { const int pos = i >> 4, j = i & 15;
        double inv = 1.0; for (int q = 0; q < j; ++q) inv *= 0.56234132519034908039;
        const float ang = (float)pos * (float)inv; double sn, cs; sincos_d((double)ang, sn, cs);
        rope[2 * i] = (float)cs; rope[2 * i + 1] = (float)sn; }
}

__device__ __forceinline__ void norm_phase(int L, int which, bool first) {
    const Ctx C = make_ctx(); const Ptrs P = make_ptrs(); const int gw = C.gw, NGW = C.NGW, lane = C.lane;
    const float* modf = (const float*)(P.ws + WS_MODF); bf16* X = (bf16*)(P.ws + WS_X); bf16* H = (bf16*)(P.ws + WS_H);
    for (int r0 = gw * 8; r0 < NTOK; r0 += NGW * 8) {
        const int cd = cond_of_row(r0);
        const float* wp = modf + ((size_t)(L * 5 + cd) * 6 + (which ? 4 : 1)) * DM + lane * 8;
        const float* sp = modf + ((size_t)(L * 5 + cd) * 6 + (which ? 3 : 0)) * DM + lane * 8;
        f32x4 wv[4][2], sv[4][2];
#pragma unroll
        for (int j = 0; j < 4; ++j) { wv[j][0] = *(const f32x4*)(wp + 512 * j); wv[j][1] = *(const f32x4*)(wp + 512 * j + 4); sv[j][0] = *(const f32x4*)(sp + 512 * j); sv[j][1] = *(const f32x4*)(sp + 512 * j + 4); }
        for (int rr = 0; rr < 8; rr += 2) {
            f32x4 v[2][4][2];
            if (first) {
#pragma unroll
                for (int q = 0; q < 2; ++q) { const int row = r0 + rr + q; const float* src = (row < NPROMPT ? P.xp + (size_t)row * DM : P.xs + (size_t)(row - NPROMPT) * DM) + lane * 8;
#pragma unroll
                    for (int j = 0; j < 4; ++j) { v[q][j][0] = *(const f32x4*)(src + 512 * j); v[q][j][1] = *(const f32x4*)(src + 512 * j + 4); } }
#pragma unroll
                for (int q = 0; q < 2; ++q) { const int row = r0 + rr + q;
#pragma unroll
                    for (int j = 0; j < 4; ++j) { v4u o; o.x = pk2(v[q][j][0][0], v[q][j][0][1]); o.y = pk2(v[q][j][0][2], v[q][j][0][3]); o.z = pk2(v[q][j][1][0], v[q][j][1][1]); o.w = pk2(v[q][j][1][2], v[q][j][1][3]);
                        *(v4u*)(X + (size_t)row * DM + lane * 8 + 512 * j) = o;
                        v[q][j][0] = (f32x4){__uint_as_float(o.x << 16), __uint_as_float(o.x & 0xffff0000u), __uint_as_float(o.y << 16), __uint_as_float(o.y & 0xffff0000u)};
                        v[q][j][1] = (f32x4){__uint_as_float(o.z << 16), __uint_as_float(o.z & 0xffff0000u), __uint_as_float(o.w << 16), __uint_as_float(o.w & 0xffff0000u)}; } }
            } else { v4u o[2][4];
#pragma unroll
                for (int q = 0; q < 2; ++q) { const bf16* src = X + (size_t)(r0 + rr + q) * DM + lane * 8;
#pragma unroll
                    for (int j = 0; j < 4; ++j) o[q][j] = *(const v4u*)(src + 512 * j); }
#pragma unroll
                for (int q = 0; q < 2; ++q)
#pragma unroll
                    for (int j = 0; j < 4; ++j) {
                        v[q][j][0] = (f32x4){__uint_as_float(o[q][j].x << 16), __uint_as_float(o[q][j].x & 0xffff0000u), __uint_as_float(o[q][j].y << 16), __uint_as_float(o[q][j].y & 0xffff0000u)};
                        v[q][j][1] = (f32x4){__uint_as_float(o[q][j].z << 16), __uint_as_float(o[q][j].z & 0xffff0000u), __uint_as_float(o[q][j].w << 16), __uint_as_float(o[q][j].w & 0xffff0000u)}; } }
#pragma unroll
            for (int q = 0; q < 2; ++q) { const int row = r0 + rr + q; float ss = 0.f;
#pragma unroll
                for (int j = 0; j < 4; ++j)
#pragma unroll
                    for (int h = 0; h < 2; ++h) ss += (v[q][j][h][0] * v[q][j][h][0] + v[q][j][h][1] * v[q][j][h][1]) + (v[q][j][h][2] * v[q][j][h][2] + v[q][j][h][3] * v[q][j][h][3]);
                const float rstd = 1.0f / sqrtf(wave_sum(ss) * (1.f / DM) + EPS);
#pragma unroll
                for (int j = 0; j < 4; ++j) { const f32x4 h0 = v[q][j][0] * rstd * wv[j][0] + sv[j][0], h1 = v[q][j][1] * rstd * wv[j][1] + sv[j][1];
                    v4u o; o.x = pk2(h0[0], h0[1]); o.y = pk2(h0[2], h0[3]); o.z = pk2(h1[0], h1[1]); o.w = pk2(h1[2], h1[3]);
                    *(v4u*)(H + (size_t)row * DM + lane * 8 + 512 * j) = o; } }
        }
    }
}
__device__ __forceinline__ void final_norm_phase() {
    const Ctx C = make_ctx(); const Ptrs P = make_ptrs(); const int gw = C.gw, NGW = C.NGW, lane = C.lane;
    const bf16* X = (const bf16*)(P.ws + WS_X);
    f32x4 wv[4][2];
#pragma unroll
    for (int j = 0; j < 4; ++j) { wv[j][0] = *(const f32x4*)(P.final_norm + lane * 8 + 512 * j); wv[j][1] = *(const f32x4*)(P.final_norm + lane * 8 + 512 * j + 4); }
    for (int row = gw; row < NTOK; row += NGW) {
        const bf16* src = X + (size_t)row * DM + lane * 8;
        v4u o[4]; f32x4 v[4][2]; float ss = 0.f;
#pragma unroll
        for (int j = 0; j < 4; ++j) o[j] = *(const v4u*)(src + 512 * j);
#pragma unroll
        for (int j = 0; j < 4; ++j) {
            v[j][0] = (f32x4){__uint_as_float(o[j].x << 16), __uint_as_float(o[j].x & 0xffff0000u), __uint_as_float(o[j].y << 16), __uint_as_float(o[j].y & 0xffff0000u)};
            v[j][1] = (f32x4){__uint_as_float(o[j].z << 16), __uint_as_float(o[j].z & 0xffff0000u), __uint_as_float(o[j].w << 16), __uint_as_float(o[j].w & 0xffff0000u)};
#pragma unroll
            for (int h = 0; h < 2; ++h) ss += (v[j][h][0] * v[j][h][0] + v[j][h][1] * v[j][h][1]) + (v[j][h][2] * v[j][h][2] + v[j][h][3] * v[j][h][3]); }
        const float rstd = 1.0f / sqrtf(wave_sum(ss) * (1.f / DM) + EPS);
        float* yo = P.out + OUT_Y + (size_t)row * DM + lane * 8;
#pragma unroll
        for (int j = 0; j < 4; ++j) { *(f32x4*)(yo + 512 * j) = v[j][0] * rstd * wv[j][0]; *(f32x4*)(yo + 512 * j + 4) = v[j][1] * rstd * wv[j][1]; }
    }
}

__device__ __forceinline__ void conv_elem_phase(int jl) {
    const Ctx C = make_ctx(); const Ptrs P = make_ptrs(); const int gw = C.gw, NGW = C.NGW, lane = C.lane;
    const bf16* U = (const bf16*)(P.ws + WS_BIG); bf16* A2 = (bf16*)(P.ws + WS_A2); const float* cw = P.conv_w + (size_t)jl * 3 * DM;
    for (int item = gw; item < (NTOK / 16) * 4; item += NGW) {
        const int s = item >> 2, cb = item & 3, r0 = s * 16, c = cb * 512 + lane * 8;
        const int seqlen = r0 < NPROMPT ? 256 : SEQ_S, t0 = r0 & (seqlen - 1);
        float w0[8], w1[8], w2[8], zp[8], zc[8], zn[8];
#pragma unroll
        for (int e = 0; e < 8; ++e) { w0[e] = cw[c + e]; w1[e] = cw[DM + c + e]; w2[e] = cw[2 * DM + c + e]; }
#define CONV_Z(dst, row) do { const bf16* up = U + (size_t)(row) * 6144 + c; const bf16x8 cg = *(const bf16x8*)(up + DM), hv = *(const bf16x8*)(up + 2 * DM); \
        _Pragma("unroll") for (int e = 0; e < 8; ++e) dst[e] = bf2f(cg[e]) * bf2f(hv[e]); } while (0)
        if (t0 == 0) {
#pragma unroll
            for (int e = 0; e < 8; ++e) zp[e] = 0.f; }
        else CONV_Z(zp, r0 - 1);
        CONV_Z(zc, r0);
#pragma unroll 4
        for (int rr = 0; rr < 16; ++rr) { const int r = r0 + rr;
            if (t0 + rr == seqlen - 1) {
#pragma unroll
                for (int e = 0; e < 8; ++e) zn[e] = 0.f; }
            else CONV_Z(zn, r + 1);
            const bf16x8 bg = *(const bf16x8*)(U + (size_t)r * 6144 + c);
            float a[8];
#pragma unroll
            for (int e = 0; e < 8; ++e) { a[e] = bf2f(bg[e]) * (w0[e] * zp[e] + w1[e] * zc[e] + w2[e] * zn[e]); zp[e] = zc[e]; zc[e] = zn[e]; }
            v4u o; o.x = pk2(a[0], a[1]); o.y = pk2(a[2], a[3]); o.z = pk2(a[4], a[5]); o.w = pk2(a[6], a[7]);
            *(v4u*)(A2 + (size_t)r * DM + c) = o; }
#undef CONV_Z
    }
}

__device__ __forceinline__ void gmlp_spatial_phase(LAS unsigned char* lds) {
    const Ctx C = make_ctx(); const Ptrs P = make_ptrs(); const int G = C.G, c = C.bx;
    const int tid = C.tid, wid = tid >> 6, lane = tid & 63, r32 = lane & 31, hi = lane >> 5;
    const bf16* UV = (const bf16*)(P.ws + WS_BIG); bf16* A2 = (bf16*)(P.ws + WS_A2); const bf16* WSb = (const bf16*)(P.ws + WS_WS);
    LAS float* rs = (LAS float*)(lds + 65536);
    for (int u = c; u < 256; u += G) {
        const int n = u >> 1, hh = u & 1, R0 = n * 128;
        for (int qq = 0; qq < 16; ++qq) { const int q = wid * 16 + qq; const bf16* vr = UV + (size_t)(R0 + q) * 4096 + DM + lane * 8; float ss = 0.f;
#pragma unroll
            for (int j = 0; j < 4; ++j) { const bf16x8 x = *(const bf16x8*)(vr + 512 * j);
#pragma unroll
                for (int e = 0; e < 8; ++e) { const float f = bf2f(x[e]); ss += f * f; } }
            ss = wave_sum(ss); if (lane == 0) rs[q] = 1.0f / sqrtf(ss * (1.f / DM) + EPS); }
        __syncthreads();
        const int sr = tid >> 4, sc = (tid & 15) * 8, mi = wid & 3, dh = wid >> 2;
        for (int gi = 0; gi < 8; ++gi) { const int g = hh * 8 + gi, c0 = g * 128; LAS unsigned char* Vb = lds + (gi & 1) * 32768;
            const f32x4 ga = *(const f32x4*)(P.gmlp_g_v + c0 + sc), gb = *(const f32x4*)(P.gmlp_g_v + c0 + sc + 4);
#pragma unroll
            for (int i = 0; i < 4; ++i) { const int q = sr + 32 * i; const bf16x8 x = *(const bf16x8*)(UV + (size_t)(R0 + q) * 4096 + DM + c0 + sc); const float r = rs[q];
                v4u o; o.x = pk2(bf2f(x[0]) * r * ga[0], bf2f(x[1]) * r * ga[1]); o.y = pk2(bf2f(x[2]) * r * ga[2], bf2f(x[3]) * r * ga[3]);
                o.z = pk2(bf2f(x[4]) * r * gb[0], bf2f(x[5]) * r * gb[1]); o.w = pk2(bf2f(x[6]) * r * gb[2], bf2f(x[7]) * r * gb[3]);
                *(LAS v4u*)(Vb + (q >> 6) * 16384 + att::v_st(q & 63, sc)) = o; }
            __syncthreads();
            bf16x8 pa[2][4];
#pragma unroll
            for (int t = 0; t < 2; ++t)
#pragma unroll
                for (int s = 0; s < 4; ++s) pa[t][s] = *(const bf16x8*)(WSb + ((size_t)g * 128 + 32 * mi + r32) * 128 + 64 * t + 16 * s + 8 * hi);
            att::f32x16 od0 = {}, od1 = {};
#pragma unroll
            for (int t = 0; t < 2; ++t) { const int vb = (int)(unsigned)(size_t)Vb + t * 16384 + dh * 1024 + att::v_rd_base(lane);
                att::pv_one<0>(od0, vb, pa[t][0], pa[t][1], pa[t][2], pa[t][3]); att::pv_one<1>(od1, vb, pa[t][0], pa[t][1], pa[t][2], pa[t][3]); }
#pragma unroll
            for (int r = 0; r < 16; ++r) { const int p = 32 * mi + att::crow(r, hi); const float bias = P.gmlp_b_s[g * 128 + p]; const size_t row = (size_t)(R0 + p);
#pragma unroll
                for (int e = 0; e < 2; ++e) { const int col = c0 + 32 * (2 * dh + e) + r32; const float val = (e ? od1[r] : od0[r]) + bias;
                    const float uval = bf2f((short)UV[row * 4096 + col]); A2[row * DM + col] = (bf16)f2bf(uval * val); } }
        }
        __syncthreads();
    }
}

__device__ __forceinline__ void mla_thin_phase() {
    const Ctx C = make_ctx(); const Ptrs P = make_ptrs(); const int gw = C.gw, NGW = C.NGW, lane = C.lane;
    const bf16* ABF = (const bf16*)(P.ws + WS_ABF); bf16* QAN = (bf16*)(P.ws + WS_QAN); bf16* CKV = (bf16*)(P.ws + WS_CKV); bf16* KPE = (bf16*)(P.ws + WS_KPE); const float* rope = (const float*)(P.ws + WS_ROPE);
    const f32x4 gq0 = *(const f32x4*)(P.mla_g_q + lane * 8), gq1 = *(const f32x4*)(P.mla_g_q + lane * 8 + 4), gk0 = *(const f32x4*)(P.mla_g_kv + lane * 8), gk1 = *(const f32x4*)(P.mla_g_kv + lane * 8 + 4);
    for (int item = gw; item < NKVROWS; item += NGW) {
        if (item < NTOK) { const int row = item; const bf16* base = ABF + (size_t)row * 1280;
            const int dst = row < NPROMPT ? row : NPROMPT + ((row - NPROMPT) >> 11) * LKS + PAST + ((row - NPROMPT) & (SEQ_S - 1));
            { const bf16x8 x = *(const bf16x8*)(base + lane * 8); float f[8], ss = 0.f;
#pragma unroll
              for (int e = 0; e < 8; ++e) { f[e] = bf2f(x[e]); ss += f[e] * f[e]; }
              const float r = 1.0f / sqrtf(wave_sum(ss) * (1.f / 512) + EPS);
              v4u o; o.x = pk2(f[0] * r * gq0[0], f[1] * r * gq0[1]); o.y = pk2(f[2] * r * gq0[2], f[3] * r * gq0[3]); o.z = pk2(f[4] * r * gq1[0], f[5] * r * gq1[1]); o.w = pk2(f[6] * r * gq1[2], f[7] * r * gq1[3]);
              *(v4u*)(QAN + (size_t)row * 512 + lane * 8) = o; }
            { const bf16x8 x = *(const bf16x8*)(base + 512 + lane * 8); float f[8], ss = 0.f;
#pragma unroll
              for (int e = 0; e < 8; ++e) { f[e] = bf2f(x[e]); ss += f[e] * f[e]; }
              const float r = 1.0f / sqrtf(wave_sum(ss) * (1.f / 512) + EPS);
              f32x4 y0, y1;
#pragma unroll
              for (int e = 0; e < 4; ++e) { y0[e] = f[e] * r * gk0[e]; y1[e] = f[4 + e] * r * gk1[e]; }
              v4u o; o.x = pk2(y0[0], y0[1]); o.y = pk2(y0[2], y0[3]); o.z = pk2(y1[0], y1[1]); o.w = pk2(y1[2], y1[3]);
              *(v4u*)(CKV + (size_t)dst * 512 + lane * 8) = o;
              if (row < NPROMPT) { float* oc = P.out + OUT_CKV + (size_t)row * 512 + lane * 8; *(f32x4*)oc = y0; *(f32x4*)(oc + 4) = y1; } }
            { const float x = bf2f((short)base[1024 + lane]);
              if (row < NPROMPT) { P.out[OUT_KPE + (size_t)row * 64 + lane] = x; KPE[(size_t)dst * 64 + lane] = (bf16)f2bf(x); }
              else { const int t = (row - NPROMPT) & (SEQ_S - 1), w = lane & 31, j = w & 15, pos = (lane >> 5) ? (t & 63) : (t >> 6);
                  const float cs = rope[2 * (pos * 16 + j)], sn = rope[2 * (pos * 16 + j) + 1]; const float xo = __shfl_xor(x, 16);
                  const float y = (w >> 4) ? (xo * sn + x * cs) : (x * cs - xo * sn);
                  KPE[(size_t)dst * 64 + lane] = (bf16)f2bf(y); } }
        } else { const int cr = item - NTOK, b = cr >> 9, p = cr & (PAST - 1), dst = NPROMPT + b * LKS + p;
            const float* s = P.cache_ckv + (size_t)cr * 512 + lane * 8; const f32x4 a = *(const f32x4*)s, bb = *(const f32x4*)(s + 4);
            v4u o; o.x = pk2(a[0], a[1]); o.y = pk2(a[2], a[3]); o.z = pk2(bb[0], bb[1]); o.w = pk2(bb[2], bb[3]);
            *(v4u*)(CKV + (size_t)dst * 512 + lane * 8) = o;
            KPE[(size_t)dst * 64 + lane] = (bf16)f2bf(P.cache_kpe[(size_t)cr * 64 + lane]); }
    }
}

__device__ __forceinline__ void attn_phase(LAS unsigned char* lds) {
    const Ctx C = make_ctx(); const Ptrs P = make_ptrs(); const int G = C.G, c = C.bx;
    const bf16* Q = (const bf16*)(P.ws + WS_Q); const bf16* KV = (const bf16*)(P.ws + WS_KV); const bf16* KPE = (const bf16*)(P.ws + WS_KPE); bf16* O = (bf16*)(P.ws + WS_A2); const float* rope = (const float*)(P.ws + WS_ROPE);
    for (int id = c; id < 1024; id += G) {
        int h, qrow0, kvrow0, nkeys, rp, t0;
        if (id < 512) { const int x = id & 7, y = id >> 3, qb = y & 7, bh = x + 8 * (y >> 3), b = bh >> 4; h = bh & 15;
            qrow0 = NPROMPT + b * SEQ_S + qb * 256; kvrow0 = NPROMPT + b * LKS; nkeys = LKS; rp = 1; t0 = qb * 256; }
        else { const int i2 = id - 512, b = i2 >> 4; h = i2 & 15; qrow0 = b * 256; kvrow0 = b * 256; nkeys = 256; rp = 0; t0 = 0; }
        att::attn_unit(lds, Q + (size_t)qrow0 * att::LDQ + h * 192, KV + (size_t)kvrow0 * att::LDKV + h * 256, KPE + (size_t)kvrow0 * 64,
                       O + (size_t)qrow0 * att::LDO + h * 128, nkeys, rp, t0, rope);
    }
}

#ifndef MLP_SPLIT
#define MLP_SPLIT 1
#endif
#ifndef GEMM_ALIGN
#define GEMM_ALIGN 1
#endif
#ifndef GEMM_SP2
#define GEMM_SP2 1
#endif
#ifndef KREP_G1
#define KREP_G1 1
#endif
#ifndef KREP_G2
#define KREP_G2 1
#endif
#ifndef KREP_W1
#define KREP_W1 1
#endif
#ifndef KREP_W2
#define KREP_W2 1
#endif
#ifndef REP_P0
#define REP_P0 1
#endif
#ifndef REP_NORM
#define REP_NORM 1
#endif
#ifndef REP_G1
#define REP_G1 1
#endif
#ifndef REP_THIN
#define REP_THIN 1
#endif
#ifndef REP_QKV
#define REP_QKV 1
#endif
#ifndef REP_ATT
#define REP_ATT 1
#endif
#ifndef REP_G2
#define REP_G2 1
#endif
#ifndef REP_W1
#define REP_W1 1
#endif
#ifndef REP_W2
#define REP_W2 1
#endif
#ifndef EN_P0
#define EN_P0 1
#endif
#ifndef EN_NORM
#define EN_NORM 1
#endif
#ifndef EN_G1
#define EN_G1 1
#endif
#ifndef EN_THIN
#define EN_THIN 1
#endif
#ifndef EN_QKV
#define EN_QKV 1
#endif
#ifndef EN_ATT
#define EN_ATT 1
#endif
#ifndef EN_G2
#define EN_G2 1
#endif
#ifndef EN_W1
#define EN_W1 1
#endif
#ifndef EN_W2
#define EN_W2 1
#endif
constexpr int N_PHASE_IDS = 2 + 9 * NLAYER + 1;
__global__ void __launch_bounds__(NWAVES * 64, 2) mk_fwd(Args args) {
    extern __shared__ __attribute__((aligned(16))) unsigned char lds_raw[];
    LAS unsigned char* lds = (LAS unsigned char*)lds_raw;
    const int tid = threadIdx.x;
    unsigned char* ws0 = args.ws;
    if (tid < 4) ((LAS unsigned*)(lds + MISC_OFF))[tid] = 0u;
    __syncthreads();
    XcdBarrier bar = xcd_barrier_post((unsigned*)(ws0 + WS_CTL) + CW_BAR, (volatile LAS unsigned*)(lds + MISC_OFF), gridDim.x);
    const int lo = args.ph_lo, hi = args.ph_hi; const bool fused = (hi - lo) > 1;
#define PH(id) (lo <= (id) && (id) < hi)
#define SEAM() do { if (fused) xcd_barrier(bar); } while (0)

    if (EN_P0 && PH(0)) {
_Pragma("unroll 1") for (int rep = 0; rep < REP_P0; ++rep) { p0a_phase(lds); SEAM(); } }
    if (EN_P0 && PH(1)) {
_Pragma("unroll 1") for (int rep = 0; rep < REP_P0; ++rep) { p0b_phase(); SEAM(); } }

    for (int L = 0; L < NLAYER; ++L) {
        const int kind = L % 3, jl = L / 3, pb = 2 + 9 * L;
        if (EN_NORM && PH(pb + 0)) {
_Pragma("unroll 1") for (int rep = 0; rep < REP_NORM; ++rep) { norm_phase(L, 0, L == 0); SEAM(); } }
        if (EN_G1 && PH(pb + 1)) {
_Pragma("unroll 1") for (int rep = 0; rep < REP_G1; ++rep) {
            const Ctx C = make_ctx(); const Ptrs P = make_ptrs(); unsigned char* ws = P.ws; const int G = C.G, bx = C.bx; const float* modf = (const float*)(ws + WS_MODF); (void)modf;
            const bf16* Bt = kind == 0 ? (const bf16*)(ws + WS_CIN) + (size_t)jl * 6144 * DM : kind == 1 ? (const bf16*)(ws + WS_GIN) : (const bf16*)(ws + WS_MLA_A);
            const int N = kind == 0 ? 6144 : kind == 1 ? 4096 : 1280;
            pg8::Gemm g{(const bf16*)(ws + WS_H), Bt, NTOK, N, DM, KREP_G1}; pg8::StaticOrder S; S.init(NTOK, N, G, bx);
            pg8::EpiBf16 E{(bf16*)(ws + WS_BIG), N, 0, 1.0f / KREP_G1};
            pg8::gemm_phase<pg8::EpiBf16, pg8::StaticOrder, GEMM_ALIGN, GEMM_SP2>(lds + RING_OFF, g, S, E);
            SEAM(); } }
        if (EN_THIN && PH(pb + 2)) {
_Pragma("unroll 1") for (int rep = 0; rep < REP_THIN; ++rep) {
            if (kind == 0) conv_elem_phase(jl);
            else if (kind == 1) gmlp_spatial_phase(lds + RING_OFF);
            else mla_thin_phase();
            SEAM(); } }
        if (kind == 2) {
            if (EN_QKV && PH(pb + 3)) {
_Pragma("unroll 1") for (int rep = 0; rep < REP_QKV; ++rep) {
                const Ctx C = make_ctx(); const Ptrs P = make_ptrs(); unsigned char* ws = P.ws; const int G = C.G, bx = C.bx; const float* modf = (const float*)(ws + WS_MODF); (void)modf;
                { pg8::Gemm g{(const bf16*)(ws + WS_QAN), (const bf16*)(ws + WS_QB), NTOK, 3072, 512, 1}; pg8::StaticOrder S; S.init(NTOK, 3072, G, bx);
                  pg8::EpiBf16 E{(bf16*)(ws + WS_Q), 3072, 0, 1.0f};
                  pg8::gemm_phase<pg8::EpiBf16, pg8::StaticOrder, GEMM_ALIGN, GEMM_SP2>(lds + RING_OFF, g, S, E); }
                { pg8::Gemm g{(const bf16*)(ws + WS_CKV), (const bf16*)(ws + WS_KVB), NKVROWS, 4096, 512, 1}; pg8::StaticOrder S; S.init(NKVROWS, 4096, G, bx);
                  pg8::EpiBf16 E{(bf16*)(ws + WS_KV), 4096, 0, 1.0f};
                  pg8::gemm_phase<pg8::EpiBf16, pg8::StaticOrder, GEMM_ALIGN, GEMM_SP2>(lds + RING_OFF, g, S, E); }
                SEAM(); } }
            if (EN_ATT && PH(pb + 4)) {
_Pragma("unroll 1") for (int rep = 0; rep < REP_ATT; ++rep) { attn_phase(lds + RING_OFF); SEAM(); } }
        }
        if (EN_G2 && PH(pb + 5)) {
_Pragma("unroll 1") for (int rep = 0; rep < REP_G2; ++rep) {
            const Ctx C = make_ctx(); const Ptrs P = make_ptrs(); unsigned char* ws = P.ws; const int G = C.G, bx = C.bx; const float* modf = (const float*)(ws + WS_MODF); (void)modf;
            const bf16* Bt = kind == 0 ? (const bf16*)(ws + WS_COUT) + (size_t)jl * DM * DM : kind == 1 ? (const bf16*)(ws + WS_GOUT) : (const bf16*)(ws + WS_WO);
            pg8::Gemm g{(const bf16*)(ws + WS_A2), Bt, NTOK, DM, DM, KREP_G2}; pg8::StaticOrder S; S.init(NTOK, DM, G, bx);
            pg8::EpiRes E{(bf16*)(ws + WS_X), rep ? (const float*)(ws + WS_CTL) : modf + (size_t)L * 5 * MODROW + 2 * DM, DM, rep ? 0 : MODROW, 1.0f / KREP_G2, 0};
            pg8::gemm_phase<pg8::EpiRes, pg8::StaticOrder, GEMM_ALIGN, GEMM_SP2>(lds + RING_OFF, g, S, E);
            SEAM(); } }
        if (EN_NORM && PH(pb + 6)) {
_Pragma("unroll 1") for (int rep = 0; rep < REP_NORM; ++rep) { norm_phase(L, 1, false); SEAM(); } }
        for (int hb = 0; hb < MLP_SPLIT; ++hb) {
        if (EN_W1 && PH(pb + 7)) {
_Pragma("unroll 1") for (int rep = 0; rep < REP_W1; ++rep) {
            const Ctx C = make_ctx(); const Ptrs P = make_ptrs(); unsigned char* ws = P.ws; const int G = C.G, bx = C.bx;
            constexpr int MS = NTOK / MLP_SPLIT;
            pg8::Gemm g{(const bf16*)(ws + WS_H) + (size_t)hb * MS * DM, (const bf16*)(ws + WS_W1) + (size_t)L * DFF * DM, MS, DFF, DM, KREP_W1}; pg8::StaticOrder S; S.init(MS, DFF, G, bx);
            pg8::EpiBf16 E{(bf16*)(ws + WS_BIG), DFF, 1, 1.0f / KREP_W1};
            pg8::gemm_phase<pg8::EpiBf16, pg8::StaticOrder, GEMM_ALIGN, GEMM_SP2>(lds + RING_OFF, g, S, E);
            SEAM(); } }
        if (EN_W2 && PH(pb + 8)) {
_Pragma("unroll 1") for (int rep = 0; rep < REP_W2; ++rep) {
            const Ctx C = make_ctx(); const Ptrs P = make_ptrs(); unsigned char* ws = P.ws; const int G = C.G, bx = C.bx; const float* modf = (const float*)(ws + WS_MODF);
            constexpr int MS = NTOK / MLP_SPLIT;
            pg8::Gemm g{(const bf16*)(ws + WS_BIG), (const bf16*)(ws + WS_W2) + (size_t)L * DM * DFF, MS, DM, DFF, KREP_W2}; pg8::StaticOrder S; S.init(MS, DM, G, bx);
            pg8::EpiRes E{(bf16*)(ws + WS_X) + (size_t)hb * MS * DM, rep ? (const float*)(ws + WS_CTL) : modf + (size_t)L * 5 * MODROW + 5 * DM, DM, rep ? 0 : MODROW, 1.0f / KREP_W2, hb * (MS / 256)};
            pg8::gemm_phase<pg8::EpiRes, pg8::StaticOrder, GEMM_ALIGN, GEMM_SP2>(lds + RING_OFF, g, S, E);
            SEAM(); } }
        }
    }
    if (EN_NORM && PH(N_PHASE_IDS - 1)) final_norm_phase();
#undef PH
#undef SEAM
}

extern "C" void kernel_launch(void* const* d_in, const int* in_sizes, int n_in, void* d_out, int out_size, void* d_ws, size_t ws_size, hipStream_t stream) {
    static int grid = 0;
    if (grid == 0) {
        if (n_in != 28 || in_sizes[0] != NPROMPT * DM || (size_t)out_size != OUT_END || ws_size < WS_END) {
            fprintf(stderr, "kernel_launch: built for 28 inputs, out of %zu floats, >= %zu bytes of workspace; got n_in %d, in0 %d, out %d, ws %zu; nothing launched\n", (size_t)OUT_END, (size_t)WS_END, n_in, n_in > 0 ? in_sizes[0] : -1, out_size, ws_size); grid = -1; return; }
        int dev = 0, cus = 0, per_cu = 0;
        if (hipGetDevice(&dev) != hipSuccess || hipDeviceGetAttribute(&cus, hipDeviceAttributeMultiprocessorCount, dev) != hipSuccess) { fprintf(stderr, "kernel_launch: device query failed\n"); grid = -1; return; }
        if (hipFuncSetAttribute((const void*)mk_fwd, hipFuncAttributeMaxDynamicSharedMemorySize, LDS_BYTES) != hipSuccess) { fprintf(stderr, "kernel_launch: hipFuncSetAttribute failed\n"); grid = -1; return; }
        if (hipOccupancyMaxActiveBlocksPerMultiprocessor(&per_cu, (const void*)mk_fwd, NWAVES * 64, LDS_BYTES) != hipSuccess || per_cu < 1)
            fprintf(stderr, "kernel_launch: note: the occupancy query reports %d workgroups per CU\n", per_cu);
        (void)hipGetLastError();
        grid = cus;
    }
    if (grid < 0) return;
    if (hipMemsetAsync((char*)d_ws + WS_CTL, 0, CTL_ZERO_BYTES, stream) != hipSuccess) { fprintf(stderr, "kernel_launch: hipMemsetAsync failed\n"); return; }
    Args a{};
    for (int i = 0; i < 28; ++i) a.in[i] = (const float*)d_in[i];
    a.out = (float*)d_out; a.ws = (unsigned char*)d_ws;
#if MK_MULTI
    for (int id = 0; id < N_PHASE_IDS; ++id) {
        if (id >= 2 && id < N_PHASE_IDS - 1) { const int L = (id - 2) / 9, slot = (id - 2) % 9; if ((slot == 3 || slot == 4) && (L % 3) != 2) continue; }
        a.ph_lo = id; a.ph_hi = id + 1;
        hipLaunchKernelGGL(mk_fwd, dim3(grid), dim3(NWAVES * 64), LDS_BYTES, stream, a);
    }
#else
    a.ph_lo = 0; a.ph_hi = N_PHASE_IDS;
    hipLaunchKernelGGL(mk_fwd, dim3(grid), dim3(NWAVES * 64), LDS_BYTES, stream, a);
#endif
    const hipError_t le = hipPeekAtLastError();
    if (le != hipSuccess) fprintf(stderr, "kernel_launch: launch failed: %s\n", hipGetErrorName(le));
}
```

```cpp
#include <hip/hip_runtime.h>
#include <cstdio>
#include <cstdint>
namespace pg8 {
#define PG8_LAS __attribute__((address_space(3)))
typedef unsigned short bf16_t;
typedef short bf16x8 __attribute__((ext_vector_type(8)));
typedef float f32x4 __attribute__((ext_vector_type(4)));
typedef unsigned u32x4 __attribute__((ext_vector_type(4)));
constexpr int BM = 256, BK = 64, HALF = 128, HTB = HALF * BK * 2  , STAGE_BYTES = 8 * HTB, NXCD = 8, WGM = 8;

__host__ __device__ __forceinline__ int lds_byte(int r, int c) { const int st = (r >> 4) * 2 + (c >> 5), rr = r & 15, cc = c & 31, ob = rr * 64 + cc * 2; return st * 1024 + (ob ^ (((ob >> 9) & 1) << 5)); }
__host__ __device__ __forceinline__ void stage_rc(int b, int& R, int& C) { const int st = b / 1024, sb = b % 1024, swz = sb ^ (((sb >> 9) & 1) << 5); R = (st >> 1) * 16 + swz / 64; C = (st & 1) * 32 + (swz % 64) / 2; }
__host__ __device__ __forceinline__ int perm32(int rho) { const int n = rho >> 4, i = rho & 15; return 8 * (i >> 2) + 4 * n + (i & 3); }

struct Unit { int pm, pn; };
struct Gemm { const bf16_t* A; const bf16_t* Bt; int M, N, K, krep; };

struct StaticOrder {
    int nM, nN, nwg, G, c;
    __host__ __device__ void init(int M, int N, int G_, int c_) { nM = M / BM; nN = N / BM; nwg = nM * nN; G = G_; c = c_; }
    __host__ __device__ bool next(int i, Unit& u) const {
        const long L = (long)i * G + c; if (L >= nwg) return false;
        int wgid = (int)L; { const int q = nwg / NXCD, r = nwg % NXCD, xcd = wgid % NXCD, off = wgid / NXCD; wgid = (xcd < r ? xcd * (q + 1) : r * (q + 1) + (xcd - r) * q) + off; }
        const int nig = WGM * nN, gid = wgid / nig, fm = gid * WGM, gsz = (nM - fm) < WGM ? (nM - fm) : WGM;
        u.pm = fm + ((wgid % nig) % gsz); u.pn = (wgid % nig) / gsz; return true;
    }
    __device__ __forceinline__ void a_ready(const Unit&) const {}
    __device__ __forceinline__ void done(const Unit&) const {}
};

struct GroupOrder {
    int nM, nN, nwg, G, c, wgm, split, base0, base1;
    __host__ __device__ void init(int nM_, int N, int G_, int c_, int wgm_, int split_, int base0_, int base1_) { nM = nM_; nN = N / BM; nwg = nM * nN; G = G_; c = c_; wgm = wgm_; split = split_; base0 = base0_; base1 = base1_; }
    __host__ __device__ bool next(int i, Unit& u) const {
        const long L = (long)i * G + c; if (L >= nwg) return false;
        int wgid = (int)L; { const int q = nwg / NXCD, r = nwg % NXCD, xcd = wgid % NXCD, off = wgid / NXCD; wgid = (xcd < r ? xcd * (q + 1) : r * (q + 1) + (xcd - r) * q) + off; }
        const int nig = wgm * nN, gid = wgid / nig, fm = gid * wgm, gsz = (nM - fm) < wgm ? (nM - fm) : wgm;
        const int pl = fm + ((wgid % nig) % gsz); u.pn = (wgid % nig) / gsz; u.pm = pl < split ? base0 + pl : base1 + (pl - split); return true;
    }
    __device__ __forceinline__ void a_ready(const Unit&) const {}
    __device__ __forceinline__ void done(const Unit&) const {}
};
#ifndef EPI_NT
#define EPI_NT 0
#endif
#ifndef EPI_REP
#define EPI_REP 1
#endif
__device__ __forceinline__ unsigned cvt_pk_bf16(float lo, float hi) { unsigned r; asm volatile("v_cvt_pk_bf16_f32 %0, %1, %2" : "=v"(r) : "v"(lo), "v"(hi)); return r; }
__device__ __forceinline__ int cond_of_tile(int pm) { return pm < 32 ? 0 : 1 + ((pm - 32) >> 3); }

struct EpiBf16 {
    static constexpr bool PERM = true, AFTER_DRAIN = false;
    bf16_t* O; int ldc; int act; float scale; int zf;
    __device__ __forceinline__ void operator()(const f32x4 (&acc)[2][2][4][2], const Unit& u, int wr, int wc, int fr, int fq) const {
        const int row0 = u.pm * BM + wr * 64 + fr, col0 = u.pn * BM + wc * 32 + 8 * fq;
        const f32x4 z4 = (f32x4){0.f, 0.f, 0.f, 0.f};
        if (zf && u.pn >= 8) {
            const int zc0 = 2048 + (u.pn - 8) * HALF + wc * 32 + 8 * fq;
#pragma unroll
            for (int ai = 0; ai < 2; ++ai)
#pragma unroll
                for (int m = 0; m < 4; ++m) { const f32x4 v0 = acc[ai][0][m][0] * acc[ai][1][m][0], v1 = acc[ai][0][m][1] * acc[ai][1][m][1];
                    u32x4 w; w.x = cvt_pk_bf16(v0[0], v0[1]); w.y = cvt_pk_bf16(v0[2], v0[3]); w.z = cvt_pk_bf16(v1[0], v1[1]); w.w = cvt_pk_bf16(v1[2], v1[3]);
                    *(u32x4*)(O + (size_t)(row0 + ai * HALF + m * 16) * ldc + zc0) = w; }
            return; }
        for (int erep = 0; erep < (act ? EPI_REP : 1); ++erep) {
        asm volatile("" ::: "memory");
#pragma unroll
        for (int ai = 0; ai < 2; ++ai)
#pragma unroll
            for (int m = 0; m < 4; ++m) { bf16_t* rowp = O + (size_t)(row0 + ai * HALF + m * 16) * ldc + col0;
#pragma unroll
                for (int bj = 0; bj < 2; ++bj) { f32x4 v0 = acc[ai][bj][m][0] * scale, v1 = acc[ai][bj][m][1] * scale;
                    if (act) { v0 = __builtin_elementwise_max(v0, z4); v1 = __builtin_elementwise_max(v1, z4); v0 = v0 * v0; v1 = v1 * v1; }
                    u32x4 w; w.x = cvt_pk_bf16(v0[0], v0[1]); w.y = cvt_pk_bf16(v0[2], v0[3]); w.z = cvt_pk_bf16(v1[0], v1[1]); w.w = cvt_pk_bf16(v1[2], v1[3]);
                    if (EPI_NT) __builtin_nontemporal_store(w, (u32x4*)(rowp + bj * HALF)); else *(u32x4*)(rowp + bj * HALF) = w; } }
        }
    }
};
struct EpiRes {
    static constexpr bool PERM = true, AFTER_DRAIN = false;
    bf16_t* X; const float* gate; int ldx; int gstride; float scale; int pm0;
    __device__ __forceinline__ void operator()(const f32x4 (&acc)[2][2][4][2], const Unit& u, int wr, int wc, int fr, int fq) const {
        const float* g = gate + (size_t)cond_of_tile(u.pm + pm0) * gstride;
        const int row0 = u.pm * BM + wr * 64 + fr, col0 = u.pn * BM + wc * 32 + 8 * fq;
        f32x4 gv[2][2];
#pragma unroll
        for (int bj = 0; bj < 2; ++bj)
#pragma unroll
            for (int n = 0; n < 2; ++n) gv[bj][n] = *(const f32x4*)(g + col0 + bj * HALF + 4 * n) * scale;
#pragma unroll
        for (int ai = 0; ai < 2; ++ai) {
            u32x4 old[4][2];
#pragma unroll
            for (int m = 0; m < 4; ++m)
#pragma unroll
                for (int bj = 0; bj < 2; ++bj) old[m][bj] = *(const u32x4*)(X + (size_t)(row0 + ai * HALF + m * 16) * ldx + col0 + bj * HALF);
#pragma unroll
            for (int m = 0; m < 4; ++m) { bf16_t* rowp = X + (size_t)(row0 + ai * HALF + m * 16) * ldx + col0;
#pragma unroll
                for (int bj = 0; bj < 2; ++bj) { const u32x4 o = old[m][bj]; const f32x4 a0 = acc[ai][bj][m][0], a1 = acc[ai][bj][m][1]; const f32x4 g0 = gv[bj][0], g1 = gv[bj][1];
                    u32x4 w;
                    w.x = cvt_pk_bf16(__uint_as_float(o.x << 16) + g0[0] * a0[0], __uint_as_float(o.x & 0xffff0000u) + g0[1] * a0[1]);
                    w.y = cvt_pk_bf16(__uint_as_float(o.y << 16) + g0[2] * a0[2], __uint_as_float(o.y & 0xffff0000u) + g0[3] * a0[3]);
                    w.z = cvt_pk_bf16(__uint_as_float(o.z << 16) + g1[0] * a1[0], __uint_as_float(o.z & 0xffff0000u) + g1[1] * a1[1]);
                    w.w = cvt_pk_bf16(__uint_as_float(o.w << 16) + g1[2] * a1[2], __uint_as_float(o.w & 0xffff0000u) + g1[3] * a1[3]);
                    *(u32x4*)(rowp + bj * HALF) = w; } }
            asm volatile("" ::: "memory"); }
    }
};

template <class Epi, class Sched, bool ALIGN_EPI = false, bool SP2 = false>
__device__ __forceinline__ void gemm_phase(PG8_LAS unsigned char* lds, const Gemm g, const Sched& S, const Epi& E) {
    int tid_l = threadIdx.x; asm volatile("" : "+v"(tid_l));
    const int tid = tid_l, wid = __builtin_amdgcn_readfirstlane(tid >> 6), lane = tid & 63, wr = wid >> 2, wc = wid & 3, fr = lane & 15, fq = lane >> 4;
    const int K = g.K, nt = K / BK, ntt = nt * g.krep;
    unsigned voffA[2], voffB[2];
#pragma unroll
    for (int i = 0; i < 2; ++i) { int R, C; stage_rc(tid * 16 + i * 8192, R, C); const int Rb = Epi::PERM ? ((R & ~31) + perm32(R & 31)) : R;
        voffA[i] = (unsigned)(R * K + C) * 2u; voffB[i] = (unsigned)(Rb * K + C) * 2u; }
    const size_t kstep = (size_t)(BK * 2);
    const size_t hstep = (size_t)HALF * K * 2;
    const size_t tstep = 2 * hstep;
    const unsigned ldsw = (unsigned)wid * 1024u;
    const int aoff = lds_byte(wr * 64 + fr, fq * 8), boff = lds_byte(wc * 32 + fr, fq * 8);
#define PG8_SA(b, h) (((b) * 2 + (h)) * HTB)
#define PG8_SB(b, h) ((4 + (b) * 2 + (h)) * HTB)
#define PG8_STAGE(bufoff, gbase, voff) do { _Pragma("unroll") for (int _i = 0; _i < 2; ++_i) \
        __builtin_amdgcn_global_load_lds((const unsigned*)((const char*)(gbase) + (voff)[_i]), (PG8_LAS unsigned*)(lds + (bufoff) + ldsw + _i * 8192), 16, 0, 0); } while (0)
#define PG8_LDA(dst, b, h) do { _Pragma("unroll") for (int m = 0; m < 4; ++m) _Pragma("unroll") for (int k = 0; k < 2; ++k) dst[m][k] = *(const PG8_LAS bf16x8*)(lds + PG8_SA(b, h) + aoff + m * 2048 + k * 1024); } while (0)
#define PG8_LDB(dst, b, h) do { _Pragma("unroll") for (int n = 0; n < 2; ++n) _Pragma("unroll") for (int k = 0; k < 2; ++k) dst[n][k] = *(const PG8_LAS bf16x8*)(lds + PG8_SB(b, h) + boff + n * 2048 + k * 1024); } while (0)
#define PG8_MMA(ai, bj, At, Bt) do { __builtin_amdgcn_s_setprio(1); _Pragma("unroll") for (int m = 0; m < 4; ++m) _Pragma("unroll") for (int n = 0; n < 2; ++n) _Pragma("unroll") for (int k = 0; k < 2; ++k) \
        acc[ai][bj][m][n] = __builtin_amdgcn_mfma_f32_16x16x32_bf16(Bt[n][k], At[m][k], acc[ai][bj][m][n], 0, 0, 0); __builtin_amdgcn_s_setprio(0); } while (0)
#define PG8_WAIT_V(n) asm volatile("s_waitcnt vmcnt(" #n ")" ::: "memory")
#define PG8_WAIT_L(n) asm volatile("s_waitcnt lgkmcnt(" #n ")" ::: "memory")
#define PG8_BAR __builtin_amdgcn_s_barrier()
#define PG8_SCHED __builtin_amdgcn_sched_barrier(0)
    Unit cur, nxt; int ui = 0;
    if (!S.next(0, cur)) return;
    f32x4 acc[2][2][4][2];
#pragma unroll
    for (int a = 0; a < 2; ++a)
#pragma unroll
        for (int b = 0; b < 2; ++b)
#pragma unroll
            for (int m = 0; m < 4; ++m)
#pragma unroll
                for (int n = 0; n < 2; ++n) acc[a][b][m][n] = (f32x4){0.f, 0.f, 0.f, 0.f};
    bf16x8 At[4][2], B0[2][2], B1[2][2];
    const char* cA = (const char*)g.A + (size_t)cur.pm * tstep; const char* cB = (const char*)g.Bt + (size_t)cur.pn * tstep;
    S.a_ready(cur);
    if constexpr (SP2) {
        PG8_STAGE(PG8_SB(0, 0), cB, voffB); PG8_STAGE(PG8_SB(0, 1), cB + hstep, voffB); PG8_STAGE(PG8_SA(0, 0), cA, voffA); PG8_STAGE(PG8_SA(0, 1), cA + hstep, voffA);
        if (wr == 1) PG8_BAR;
        PG8_WAIT_V(2); PG8_BAR;
        PG8_STAGE(PG8_SB(1, 0), cB + kstep, voffB); PG8_STAGE(PG8_SA(1, 0), cA + kstep, voffA); PG8_STAGE(PG8_SB(1, 1), cB + hstep + kstep, voffB);
        PG8_WAIT_V(6); PG8_BAR;
    } else {
        PG8_STAGE(PG8_SB(0, 0), cB, voffB); PG8_STAGE(PG8_SA(0, 0), cA, voffA); PG8_STAGE(PG8_SB(0, 1), cB + hstep, voffB); PG8_STAGE(PG8_SA(0, 1), cA + hstep, voffA);
        if (wr == 1) PG8_BAR;
        PG8_WAIT_V(4); PG8_BAR;
        PG8_STAGE(PG8_SB(1, 0), cB + kstep, voffB); PG8_STAGE(PG8_SA(1, 0), cA + kstep, voffA); PG8_STAGE(PG8_SB(1, 1), cB + hstep + kstep, voffB);
        PG8_WAIT_V(6); PG8_BAR;
    }
    for (;;) {
        const bool has_next = S.next(ui + 1, nxt);
        const char* nA = has_next ? (const char*)g.A + (size_t)nxt.pm * tstep : cA; const char* nB = has_next ? (const char*)g.Bt + (size_t)nxt.pn * tstep : cB;
        for (int t = 0, tm = 0; t < ntt; t += 2, tm = (tm + 2 == nt ? 0 : tm + 2)) {
            const bool last = (t == ntt - 2); const int tm2 = (tm + 2 == nt) ? 0 : tm + 2;
            const char* a1 = cA + (size_t)(tm + 1) * kstep;
            const char* a2 = last ? nA : cA + (size_t)tm2 * kstep; const char* b2 = last ? nB : cB + (size_t)tm2 * kstep;
            const char* a3 = a2 + kstep; const char* b3 = b2 + kstep;
            if (last && has_next) S.a_ready(nxt);
            if constexpr (SP2) {
            PG8_LDB(B0, 0, 0); PG8_LDB(B1, 0, 1); PG8_SCHED; PG8_LDA(At, 0, 0); PG8_STAGE(PG8_SA(1, 1), a1 + hstep, voffA);
            PG8_WAIT_V(8); PG8_WAIT_L(0); PG8_BAR; PG8_MMA(0, 0, At, B0); PG8_MMA(0, 1, At, B1); PG8_BAR; PG8_SCHED;
            PG8_LDA(At, 0, 1); PG8_STAGE(PG8_SB(0, 0), b2, voffB); PG8_STAGE(PG8_SB(0, 1), b2 + hstep, voffB); PG8_STAGE(PG8_SA(0, 0), a2, voffA);
            PG8_WAIT_V(8); PG8_WAIT_L(0); PG8_BAR; PG8_MMA(1, 0, At, B0); PG8_MMA(1, 1, At, B1); PG8_BAR; PG8_SCHED;
            PG8_LDB(B0, 1, 0); PG8_LDB(B1, 1, 1); PG8_SCHED; PG8_LDA(At, 1, 0); PG8_STAGE(PG8_SA(0, 1), a2 + hstep, voffA);
            PG8_WAIT_V(8); PG8_WAIT_L(0); PG8_BAR; PG8_MMA(0, 0, At, B0); PG8_MMA(0, 1, At, B1); PG8_BAR; PG8_SCHED;
            PG8_LDA(At, 1, 1); PG8_STAGE(PG8_SB(1, 0), b3, voffB); PG8_STAGE(PG8_SB(1, 1), b3 + hstep, voffB); PG8_STAGE(PG8_SA(1, 0), a3, voffA);
            PG8_WAIT_V(8); PG8_WAIT_L(0); PG8_BAR; PG8_MMA(1, 0, At, B0); PG8_MMA(1, 1, At, B1); PG8_BAR; PG8_SCHED;
            } else {
            PG8_LDB(B0, 0, 0); PG8_SCHED; PG8_LDA(At, 0, 0); PG8_STAGE(PG8_SA(1, 1), a1 + hstep, voffA);
            PG8_WAIT_L(8); PG8_BAR; PG8_WAIT_L(0); PG8_MMA(0, 0, At, B0); PG8_BAR; PG8_SCHED;
            PG8_LDB(B1, 0, 1); PG8_STAGE(PG8_SB(0, 0), b2, voffB);
            PG8_BAR; PG8_WAIT_L(0); PG8_MMA(0, 1, At, B1); PG8_BAR;
            PG8_LDA(At, 0, 1); PG8_STAGE(PG8_SA(0, 0), a2, voffA);
            PG8_BAR; PG8_WAIT_L(0); PG8_MMA(1, 0, At, B0); PG8_BAR; PG8_SCHED;
            PG8_STAGE(PG8_SB(0, 1), b2 + hstep, voffB);
            PG8_WAIT_V(6); PG8_BAR; PG8_MMA(1, 1, At, B1); PG8_BAR;
            PG8_LDB(B0, 1, 0); PG8_SCHED; PG8_LDA(At, 1, 0); PG8_STAGE(PG8_SA(0, 1), a2 + hstep, voffA);
            PG8_WAIT_L(8); PG8_BAR; PG8_WAIT_L(0); PG8_MMA(0, 0, At, B0); PG8_BAR; PG8_SCHED;
            PG8_LDB(B1, 1, 1); PG8_STAGE(PG8_SB(1, 0), b3, voffB);
            PG8_BAR; PG8_WAIT_L(0); PG8_MMA(0, 1, At, B1); PG8_BAR;
            PG8_LDA(At, 1, 1); PG8_STAGE(PG8_SA(1, 0), a3, voffA);
            PG8_BAR; PG8_WAIT_L(0); PG8_MMA(1, 0, At, B0); PG8_BAR; PG8_SCHED;
            PG8_STAGE(PG8_SB(1, 1), b3 + hstep, voffB);
            PG8_WAIT_V(6); PG8_BAR; PG8_MMA(1, 1, At, B1); PG8_BAR;
            }
        }
        if constexpr (ALIGN_EPI) { if (wr == 0) PG8_BAR; }
        if constexpr (!Epi::AFTER_DRAIN) { E(acc, cur, wr, wc, fr, fq); S.done(cur); }
        if (!has_next) break;
#pragma unroll
        for (int a = 0; a < 2; ++a)
#pragma unroll
            for (int b = 0; b < 2; ++b)
#pragma unroll
                for (int m = 0; m < 4; ++m)
#pragma unroll
                    for (int n = 0; n < 2; ++n) acc[a][b][m][n] = (f32x4){0.f, 0.f, 0.f, 0.f};
        cur = nxt; cA = nA; cB = nB; ++ui;
        if constexpr (ALIGN_EPI) { if (wr == 1) PG8_BAR; }
    }
    PG8_WAIT_V(0);
    if constexpr (!ALIGN_EPI) { if (wr == 0) PG8_BAR; }
    PG8_BAR;
    if constexpr (Epi::AFTER_DRAIN) { E.fused(acc, cur, wr, wc, fr, fq, lds, wid, lane); S.done(cur); }
#undef PG8_SA
#undef PG8_SB
#undef PG8_STAGE
#undef PG8_LDA
#undef PG8_LDB
#undef PG8_MMA
#undef PG8_WAIT_V
#undef PG8_WAIT_L
#undef PG8_BAR
#undef PG8_SCHED
}
}
namespace att {
#define ATT_LAS __attribute__((address_space(3)))
typedef unsigned short bf16_t;
using bf16x8 = __attribute__((ext_vector_type(8))) short;
using s16x4  = __attribute__((ext_vector_type(4))) short;
using f32x16 = __attribute__((ext_vector_type(16))) float;
using f32x4  = __attribute__((ext_vector_type(4))) float;
using u32x4  = __attribute__((ext_vector_type(4))) unsigned;
constexpr int NW = 8, QBLK = 32, KVBLK = 64;
constexpr int LDQ = 3072, LDKV = 4096, LDO = 2048, LDKPE = 64;
constexpr float SCALE = 0.07216878364870322f;
constexpr float THR = 8.f;
constexpr int SHM_V = KVBLK * 128 * 2, SHM_KN = KVBLK * 128 * 2, SHM_KP = KVBLK * 64 * 2;
constexpr int NVB = 3, NKB = 2;
constexpr int OFF_V = 0, OFF_KN = NVB * SHM_V, OFF_KP = OFF_KN + NKB * SHM_KN, OFF_WS = OFF_KP + NKB * SHM_KP, LDS_BYTES = OFF_WS + NW * 64 * 4;
#define ATT_KNSWZ(row, colB) ((row) * 256 + ((colB) ^ (((row) & 7) << 4)))
#define ATT_KPSWZ(row, colB) ((row) * 128 + ((colB) ^ (((row) & 7) << 4)))
#define ATT_SBAR() __builtin_amdgcn_sched_barrier(0)
__device__ __forceinline__ int crow(int r, int hi) { return (r & 3) + 8 * (r >> 2) + 4 * hi; }
__device__ __forceinline__ unsigned cvtpk(float lo, float hi) { unsigned r; asm volatile("v_cvt_pk_bf16_f32 %0, %1, %2" : "=v"(r) : "v"(lo), "v"(hi)); return r; }
__device__ __forceinline__ float bf2f(short s) { return __uint_as_float(((unsigned)(unsigned short)s) << 16); }

__device__ __forceinline__ void partialSM(f32x16& p0, f32x16& p1, float& m_reg, float& mn, float& alpha) {
  constexpr float C = SCALE * 1.4426950408889634f;
  float pmax = p0[0];
#pragma unroll
  for (int r = 1; r < 16; ++r) pmax = fmaxf(pmax, p0[r]);
#pragma unroll
  for (int r = 0; r < 16; ++r) pmax = fmaxf(pmax, p1[r]);
  { auto rr = __builtin_amdgcn_permlane32_swap(__float_as_uint(pmax), __float_as_uint(pmax), false, false);
    pmax = fmaxf(__uint_as_float(rr[0]), __uint_as_float(rr[1])); }
  if (__builtin_expect(__all(pmax - m_reg <= THR / SCALE), 1)) { mn = m_reg; alpha = 1.f; }
  else { mn = fmaxf(m_reg, pmax); alpha = __builtin_amdgcn_exp2f((m_reg - mn) * C); m_reg = mn; }
  float mnC = -mn * C;
#pragma unroll
  for (int r = 0; r < 16; ++r) p0[r] = fmaf(p0[r], C, mnC);
#pragma unroll
  for (int r = 0; r < 16; ++r) p1[r] = fmaf(p1[r], C, mnC);
#pragma unroll
  for (int r = 0; r < 16; ++r) p0[r] = __builtin_amdgcn_exp2f(p0[r]);
}
__device__ __forceinline__ void finishSM(f32x16& p0, f32x16& p1, float alpha, float& l_reg, bf16x8& pa0, bf16x8& pa1, bf16x8& pa2, bf16x8& pa3) {
#pragma unroll
  for (int r = 0; r < 16; ++r) p1[r] = __builtin_amdgcn_exp2f(p1[r]);
  float ps = 0;
#pragma unroll
  for (int r = 0; r < 16; ++r) ps += p0[r];
#pragma unroll
  for (int r = 0; r < 16; ++r) ps += p1[r];
  { auto rr = __builtin_amdgcn_permlane32_swap(__float_as_uint(ps), __float_as_uint(ps), false, false);
    ps = __uint_as_float(rr[0]) + __uint_as_float(rr[1]); }
  l_reg = l_reg * alpha + ps;
#define ATT_PK4(P, BASE, OUT) do { unsigned a0 = cvtpk(P[BASE + 0], P[BASE + 1]), a1 = cvtpk(P[BASE + 2], P[BASE + 3]);   \
    unsigned b0 = cvtpk(P[BASE + 4], P[BASE + 5]), b1 = cvtpk(P[BASE + 6], P[BASE + 7]);                              \
    auto r0 = __builtin_amdgcn_permlane32_swap(a0, b0, false, false); auto r1 = __builtin_amdgcn_permlane32_swap(a1, b1, false, false); \
    u32x4 w = {r0[0], r1[0], r0[1], r1[1]}; OUT = __builtin_bit_cast(bf16x8, w); } while (0)
  ATT_PK4(p0, 0, pa0); ATT_PK4(p0, 8, pa1); ATT_PK4(p1, 0, pa2); ATT_PK4(p1, 8, pa3);
#undef ATT_PK4
}
__device__ __forceinline__ void qkt(f32x16& p0, f32x16& p1, const ATT_LAS char* Kn, const ATT_LAS char* Kp, const bf16x8 (&qr)[12], int r32, int hi) {
  p0 = f32x16{}; p1 = f32x16{};
#pragma unroll
  for (int d0 = 0; d0 < 8; ++d0) { const int cb = (d0 * 16 + hi * 8) * 2;
    const bf16x8 b0 = *reinterpret_cast<const ATT_LAS bf16x8*>(Kn + ATT_KNSWZ(r32, cb));
    const bf16x8 b1 = *reinterpret_cast<const ATT_LAS bf16x8*>(Kn + ATT_KNSWZ(32 + r32, cb));
    p0 = __builtin_amdgcn_mfma_f32_32x32x16_bf16(b0, qr[d0], p0, 0, 0, 0);
    p1 = __builtin_amdgcn_mfma_f32_32x32x16_bf16(b1, qr[d0], p1, 0, 0, 0);
    if ((d0 & 3) == 3) ATT_SBAR(); }
#pragma unroll
  for (int d0 = 8; d0 < 12; ++d0) { const int cb = ((d0 - 8) * 16 + hi * 8) * 2;
    const bf16x8 b0 = *reinterpret_cast<const ATT_LAS bf16x8*>(Kp + ATT_KPSWZ(r32, cb));
    const bf16x8 b1 = *reinterpret_cast<const ATT_LAS bf16x8*>(Kp + ATT_KPSWZ(32 + r32, cb));
    p0 = __builtin_amdgcn_mfma_f32_32x32x16_bf16(b0, qr[d0], p0, 0, 0, 0);
    p1 = __builtin_amdgcn_mfma_f32_32x32x16_bf16(b1, qr[d0], p1, 0, 0, 0); }
}
__device__ __forceinline__ int v_st(int k, int c) { const int kk = (k & ~0xC) | ((k & 4) << 1) | ((k & 8) >> 1); return ((kk >> 3) * 4 + (c >> 5)) * 512 + ((kk & 7) * 32 + (c & 31)) * 2; }
__device__ __forceinline__ int v_rd_base(int lane) { return ((lane & 3) << 3) | (((lane >> 2) & 3) << 6) | (((lane >> 4) & 1) << 5) | (((lane >> 5) & 1) << 8); }
constexpr int v_rd_off(int d0, int ks, int half) { return d0 * 512 + ks * 4096 + half * 2048; }
template <int OFF> __device__ __forceinline__ s16x4 tr_read(int vb) {
  s16x4 r; asm volatile("ds_read_b64_tr_b16 %0, %1 offset:%2" : "=&v"(r) : "v"(vb), "i"(OFF) : "memory"); return r;
}
template <int D0> __device__ __forceinline__ void pv_one(f32x16& od, int vb, bf16x8 pa0, bf16x8 pa1, bf16x8 pa2, bf16x8 pa3) {
  const s16x4 l0 = tr_read<v_rd_off(D0, 0, 0)>(vb), h0 = tr_read<v_rd_off(D0, 0, 1)>(vb), l1 = tr_read<v_rd_off(D0, 1, 0)>(vb), h1 = tr_read<v_rd_off(D0, 1, 1)>(vb);
  const s16x4 l2 = tr_read<v_rd_off(D0, 2, 0)>(vb), h2 = tr_read<v_rd_off(D0, 2, 1)>(vb), l3 = tr_read<v_rd_off(D0, 3, 0)>(vb), h3 = tr_read<v_rd_off(D0, 3, 1)>(vb);
  asm volatile("s_waitcnt lgkmcnt(0)" ::: "memory"); ATT_SBAR();
#define ATT_PK(L, H) (bf16x8){L[0], L[1], L[2], L[3], H[0], H[1], H[2], H[3]}
  od = __builtin_amdgcn_mfma_f32_32x32x16_bf16(pa0, ATT_PK(l0, h0), od, 0, 0, 0);
  od = __builtin_amdgcn_mfma_f32_32x32x16_bf16(pa1, ATT_PK(l1, h1), od, 0, 0, 0);
  od = __builtin_amdgcn_mfma_f32_32x32x16_bf16(pa2, ATT_PK(l2, h2), od, 0, 0, 0);
  od = __builtin_amdgcn_mfma_f32_32x32x16_bf16(pa3, ATT_PK(l3, h3), od, 0, 0, 0);
#undef ATT_PK
}

template <int S> __device__ __forceinline__ void qkt_h(f32x16& p, const ATT_LAS char* Kn, const ATT_LAS char* Kp, const bf16x8 (&qr)[12], int r32, int hi) {
  p = f32x16{};
#pragma unroll
  for (int d0 = 0; d0 < 8; ++d0) { const int cb = (d0 * 16 + hi * 8) * 2;
    const bf16x8 b = *reinterpret_cast<const ATT_LAS bf16x8*>(Kn + ATT_KNSWZ(32 * S + r32, cb));
    p = __builtin_amdgcn_mfma_f32_32x32x16_bf16(b, qr[d0], p, 0, 0, 0); }
#pragma unroll
  for (int d0 = 8; d0 < 12; ++d0) { const int cb = ((d0 - 8) * 16 + hi * 8) * 2;
    const bf16x8 b = *reinterpret_cast<const ATT_LAS bf16x8*>(Kp + ATT_KPSWZ(32 * S + r32, cb));
    p = __builtin_amdgcn_mfma_f32_32x32x16_bf16(b, qr[d0], p, 0, 0, 0); }
}
__device__ __forceinline__ void partialSM_h(f32x16& p, float& m_reg, float& alpha) {
  constexpr float C = SCALE * 1.4426950408889634f;
  float pmax = p[0];
#pragma unroll
  for (int r = 1; r < 16; ++r) pmax = fmaxf(pmax, p[r]);
  { auto rr = __builtin_amdgcn_permlane32_swap(__float_as_uint(pmax), __float_as_uint(pmax), false, false);
    pmax = fmaxf(__uint_as_float(rr[0]), __uint_as_float(rr[1])); }
  float mn;
  if (__builtin_expect(__all(pmax - m_reg <= THR / SCALE), 1)) { mn = m_reg; alpha = 1.f; }
  else { mn = fmaxf(m_reg, pmax); alpha = __builtin_amdgcn_exp2f((m_reg - mn) * C); m_reg = mn; }
  const float mnC = -mn * C;
#pragma unroll
  for (int r = 0; r < 16; ++r) p[r] = fmaf(p[r], C, mnC);
#pragma unroll
  for (int r = 0; r < 8; ++r) p[r] = __builtin_amdgcn_exp2f(p[r]);
}
__device__ __forceinline__ void finishSM_h(f32x16& p, float alpha, float& l_reg, bf16x8& pa0, bf16x8& pa1) {
#pragma unroll
  for (int r = 8; r < 16; ++r) p[r] = __builtin_amdgcn_exp2f(p[r]);
  float ps = 0;
#pragma unroll
  for (int r = 0; r < 16; ++r) ps += p[r];
  { auto rr = __builtin_amdgcn_permlane32_swap(__float_as_uint(ps), __float_as_uint(ps), false, false);
    ps = __uint_as_float(rr[0]) + __uint_as_float(rr[1]); }
  l_reg = l_reg * alpha + ps;
#define ATT_PK4(P, BASE, OUT) do { unsigned a0 = cvtpk(P[BASE + 0], P[BASE + 1]), a1 = cvtpk(P[BASE + 2], P[BASE + 3]);   \
    unsigned b0 = cvtpk(P[BASE + 4], P[BASE + 5]), b1 = cvtpk(P[BASE + 6], P[BASE + 7]);                              \
    auto r0 = __builtin_amdgcn_permlane32_swap(a0, b0, false, false); auto r1 = __builtin_amdgcn_permlane32_swap(a1, b1, false, false); \
    u32x4 w = {r0[0], r1[0], r0[1], r1[1]}; OUT = __builtin_bit_cast(bf16x8, w); } while (0)
  ATT_PK4(p, 0, pa0); ATT_PK4(p, 8, pa1);
#undef ATT_PK4
}
template <int S, int D0> __device__ __forceinline__ void pv_h_one(f32x16& od, int vb, bf16x8 pa0, bf16x8 pa1) {
  const s16x4 l0 = tr_read<v_rd_off(D0, 2 * S, 0)>(vb), h0 = tr_read<v_rd_off(D0, 2 * S, 1)>(vb), l1 = tr_read<v_rd_off(D0, 2 * S + 1, 0)>(vb), h1 = tr_read<v_rd_off(D0, 2 * S + 1, 1)>(vb);
  asm volatile("s_waitcnt lgkmcnt(0)" ::: "memory"); ATT_SBAR();
#define ATT_PK(L, H) (bf16x8){L[0], L[1], L[2], L[3], H[0], H[1], H[2], H[3]}
  od = __builtin_amdgcn_mfma_f32_32x32x16_bf16(pa0, ATT_PK(l0, h0), od, 0, 0, 0);
  od = __builtin_amdgcn_mfma_f32_32x32x16_bf16(pa1, ATT_PK(l1, h1), od, 0, 0, 0);
#undef ATT_PK
}
template <int S> __device__ __forceinline__ void pv_h(f32x16 (&o)[4], int vb, bf16x8 pa0, bf16x8 pa1) {
  pv_h_one<S, 0>(o[0], vb, pa0, pa1); pv_h_one<S, 1>(o[1], vb, pa0, pa1); pv_h_one<S, 2>(o[2], vb, pa0, pa1); pv_h_one<S, 3>(o[3], vb, pa0, pa1);
}

__device__ __forceinline__ void attn_unit(ATT_LAS unsigned char* lds, const bf16_t* __restrict__ Q, const bf16_t* __restrict__ KV, const bf16_t* __restrict__ KPE,
                                          bf16_t* __restrict__ O, int nkeys, int rope, int t0, const float* __restrict__ ROPE) {
  int tid_l = threadIdx.x; asm volatile("" : "+v"(tid_l));
  const int tid = tid_l, wid = tid >> 6, lane = tid & 63, r32 = lane & 31, hi = lane >> 5;
  ATT_LAS float* wsf = (ATT_LAS float*)((ATT_LAS char*)lds + OFF_WS) + wid * 64; ATT_LAS float* li_l = wsf; ATT_LAS float* al_l = wsf + 32;
  float m_reg = -1e30f, l_reg = 0.f; f32x16 o[4] = {}; bf16x8 qr[12];
  const bf16_t* Qw = Q + (size_t)(wid * QBLK + r32) * LDQ + hi * 8;
#pragma unroll
  for (int d0 = 0; d0 < 12; ++d0) qr[d0] = *reinterpret_cast<const bf16x8*>(Qw + d0 * 16);
  if (rope) {
    const int t = t0 + wid * QBLK + r32;
#pragma unroll
    for (int hf = 0; hf < 2; ++hf) {
      const int pos = hf ? (t & 63) : (t >> 6);
      const f32x4* tp = reinterpret_cast<const f32x4*>(ROPE + (size_t)(pos * 16 + hi * 8) * 2);
      const bf16x8 a = qr[8 + 2 * hf], b = qr[9 + 2 * hf]; u32x4 na, nb;
#pragma unroll
      for (int q = 0; q < 4; ++q) { const f32x4 cs = tp[q];
        const float x1a = bf2f(a[2 * q]), x2a = bf2f(b[2 * q]), x1b = bf2f(a[2 * q + 1]), x2b = bf2f(b[2 * q + 1]);
        na[q] = cvtpk(x1a * cs[0] - x2a * cs[1], x1b * cs[2] - x2b * cs[3]);
        nb[q] = cvtpk(x1a * cs[1] + x2a * cs[0], x1b * cs[3] + x2b * cs[2]); }
      qr[8 + 2 * hf] = __builtin_bit_cast(bf16x8, na); qr[9 + 2 * hf] = __builtin_bit_cast(bf16x8, nb);
    }
  }
  const int widu = __builtin_amdgcn_readfirstlane(wid);
  unsigned oKn[2], oV[2], oKp;
#pragma unroll
  for (int i = 0; i < 2; ++i) { const int pc = 2 * widu + i;
    { const int row = pc * 4 + (lane >> 4), col = ((lane & 15) ^ (row & 7)) * 8; oKn[i] = (unsigned)(row * LDKV + col) * 2u; }
    { const int st = pc * 2 + (lane >> 5), kk = ((st >> 2) << 3) | ((lane & 31) >> 2), k = (kk & ~0xC) | ((kk & 4) << 1) | ((kk & 8) >> 1), c = (st & 3) * 32 + (lane & 3) * 8; oV[i] = (unsigned)(k * LDKV + 128 + c) * 2u; } }
  { const int row = widu * 8 + (lane >> 3), col = ((lane & 7) ^ (row & 7)) * 8; oKp = (unsigned)(row * LDKPE + col) * 2u; }
  ATT_LAS char* V_lds = (ATT_LAS char*)lds + OFF_V; ATT_LAS char* Kn_lds = (ATT_LAS char*)lds + OFF_KN; ATT_LAS char* Kp_lds = (ATT_LAS char*)lds + OFF_KP;
  const int vb0 = (int)(unsigned)(size_t)V_lds + v_rd_base(lane);
#define ATT_DMA(t, kb, vbuf) do { const char* kvt = (const char*)KV + (size_t)(t) * (KVBLK * LDKV * 2); const char* kpt = (const char*)KPE + (size_t)(t) * (KVBLK * LDKPE * 2); \
    _Pragma("unroll") for (int _i = 0; _i < 2; ++_i) { \
      __builtin_amdgcn_global_load_lds((const unsigned*)(kvt + oKn[_i]), (ATT_LAS unsigned*)(Kn_lds + (kb) * SHM_KN + (2 * widu + _i) * 1024), 16, 0, 0); \
      __builtin_amdgcn_global_load_lds((const unsigned*)(kvt + oV[_i]), (ATT_LAS unsigned*)(V_lds + (vbuf) * SHM_V + (2 * widu + _i) * 1024), 16, 0, 0); } \
    __builtin_amdgcn_global_load_lds((const unsigned*)(kpt + oKp), (ATT_LAS unsigned*)(Kp_lds + (kb) * SHM_KP + widu * 1024), 16, 0, 0); } while (0)
#define ATT_LANDED() do { asm volatile("s_waitcnt vmcnt(0)" ::: "memory"); __builtin_amdgcn_s_barrier(); asm volatile("" ::: "memory"); } while (0)
#define ATT_RESC(a) do { if (__any((a) < 1.f)) { if (hi == 0) al_l[r32] = (a); asm volatile("s_waitcnt lgkmcnt(0)" ::: "memory"); \
    _Pragma("unroll") for (int r = 0; r < 16; ++r) { const float av = al_l[crow(r, hi)]; _Pragma("unroll") for (int d = 0; d < 4; ++d) o[d][r] *= av; } } } while (0)
#define ATT_PV(vsel) do { const int vb = vb0 + (vsel) * SHM_V; pv_one<0>(o[0], vb, pa0, pa1, pa2, pa3); pv_one<1>(o[1], vb, pa0, pa1, pa2, pa3); pv_one<2>(o[2], vb, pa0, pa1, pa2, pa3); pv_one<3>(o[3], vb, pa0, pa1, pa2, pa3); } while (0)
  const int NT = nkeys / KVBLK;
#ifndef ATT_DOUBLE
#define ATT_DOUBLE 0
#endif
#if ATT_DOUBLE
  f32x16 pA, pB; float alA, alB; bf16x8 pa0, pa1;
  ATT_DMA(0, 0, 0);
  ATT_LANDED(); if (NT > 1) ATT_DMA(1, 1, 1);
  qkt_h<0>(pA, Kn_lds, Kp_lds, qr, r32, hi); partialSM_h(pA, m_reg, alA); ATT_RESC(alA);
  int kj = 0, vj = 0;
  for (int j = 0; j < NT; ++j) {
    const int vb = vb0 + vj * SHM_V;
    ATT_SBAR(); qkt_h<1>(pB, Kn_lds + kj * SHM_KN, Kp_lds + kj * SHM_KP, qr, r32, hi);
    finishSM_h(pA, alA, l_reg, pa0, pa1); ATT_SBAR();
    pv_h<0>(o, vb, pa0, pa1); partialSM_h(pB, m_reg, alB); ATT_RESC(alB);
    if (j + 1 < NT) {
      const int vn = vj == 2 ? 0 : vj + 1, vnn = vn == 2 ? 0 : vn + 1;
      ATT_LANDED(); if (j + 2 < NT) ATT_DMA(j + 2, kj, vnn);
      ATT_SBAR(); qkt_h<0>(pA, Kn_lds + (kj ^ 1) * SHM_KN, Kp_lds + (kj ^ 1) * SHM_KP, qr, r32, hi);
      finishSM_h(pB, alB, l_reg, pa0, pa1); ATT_SBAR();
      pv_h<1>(o, vb, pa0, pa1); partialSM_h(pA, m_reg, alA); ATT_RESC(alA);
      kj ^= 1; vj = vn;
    } else {
      finishSM_h(pB, alB, l_reg, pa0, pa1); ATT_SBAR();
      pv_h<1>(o, vb, pa0, pa1);
    }
  }
#else
  ATT_DMA(0, 0, 0);
  for (int j = 0; j < NT; ++j) {
    const int b = j & 1;
    ATT_LANDED(); if (j + 1 < NT) ATT_DMA(j + 1, b ^ 1, b ^ 1);
    f32x16 p0, p1; float mn, alpha; bf16x8 pa0, pa1, pa2, pa3;
    qkt(p0, p1, Kn_lds + b * SHM_KN, Kp_lds + b * SHM_KP, qr, r32, hi);
    partialSM(p0, p1, m_reg, mn, alpha);
    ATT_RESC(alpha);
    finishSM(p0, p1, alpha, l_reg, pa0, pa1, pa2, pa3); ATT_SBAR();
    ATT_PV(b);
  }
#endif
  asm volatile("s_waitcnt lgkmcnt(0)" ::: "memory"); __builtin_amdgcn_s_barrier(); asm volatile("" ::: "memory");
  if (hi == 0) li_l[r32] = l_reg;
  asm volatile("s_waitcnt lgkmcnt(0)" ::: "memory");
  bf16_t* Ow = O + (size_t)(wid * QBLK) * LDO;
#pragma unroll
  for (int r = 0; r < 16; ++r) { const int orow = crow(r, hi); const float rl = __builtin_amdgcn_rcpf(li_l[orow]);
#pragma unroll
    for (int d0 = 0; d0 < 4; ++d0) { const float v = o[d0][r] * rl; unsigned u = __float_as_uint(v); u += 0x7fffu + ((u >> 16) & 1u);
      Ow[(size_t)orow * LDO + d0 * 32 + r32] = (bf16_t)(u >> 16); } }
  asm volatile("s_waitcnt lgkmcnt(0)" ::: "memory");
#undef ATT_DMA
#undef ATT_LANDED
#undef ATT_RESC
#undef ATT_PV
}
}

constexpr int NWAVES = 8;
constexpr int DM = 2048, NTOK = 16384, NPROMPT = 8192, DFF = 8192, NLAYER = 4;
constexpr int SEQ_S = 2048, PAST = 512, LKS = PAST + SEQ_S, NKVROWS = NPROMPT + 4 * LKS;
constexpr int MODROW = 6 * DM;
constexpr int KS_MOD = 16;
constexpr float EPS = 1e-6f;
#ifndef MK_MULTI
#define MK_MULTI 0
#endif

constexpr size_t MiB = 1u << 20;
constexpr size_t WS_CTL = 0, CTL_ZERO_BYTES = 32768;
constexpr size_t WS_MODF = 1 * MiB;
constexpr size_t WS_ROPE = WS_MODF + (size_t)NLAYER * 5 * MODROW * 4;
constexpr size_t WS_MODP = 2 * MiB;
constexpr size_t WS_WS = 17 * MiB;
constexpr size_t WS_MLA_A = 18 * MiB;
constexpr size_t WS_QB = 23 * MiB, WS_KVB = 26 * MiB, WS_WO = 30 * MiB;
constexpr size_t WS_GIN = 38 * MiB, WS_GOUT = 54 * MiB;
constexpr size_t WS_COUT = 62 * MiB, WS_CIN = 78 * MiB;
constexpr size_t WS_W1 = 126 * MiB, WS_W2 = 254 * MiB;
constexpr size_t WS_X = 382 * MiB;
constexpr size_t WS_H = 510 * MiB;
constexpr size_t WS_A2 = 574 * MiB;
constexpr size_t WS_BIG = 638 * MiB;
constexpr size_t WS_ABF = WS_BIG, WS_Q = WS_BIG + 40 * MiB, WS_QAN = WS_BIG + 136 * MiB, WS_CKV = WS_BIG + 152 * MiB, WS_KPE = WS_BIG + 170 * MiB;
constexpr size_t WS_KV = 894 * MiB;
constexpr size_t WS_END = 1038 * MiB;
static_assert(WS_ROPE + 64 * 16 * 2 * 4 <= WS_MODP && WS_MODP + (size_t)KS_MOD * NLAYER * 5 * MODROW * 4 <= WS_WS && WS_KPE + (size_t)NKVROWS * 64 * 2 <= WS_KV, "d_ws map");
constexpr int CW_BAR = 4096;
constexpr size_t OUT_Y = 0, OUT_CKV = (size_t)NTOK * DM, OUT_KPE = OUT_CKV + (size_t)NPROMPT * 512, OUT_END = OUT_KPE + (size_t)NPROMPT * 64;

constexpr int RING_OFF = 0, RING_BYTES = 131072;
constexpr int MISC_OFF = RING_BYTES;
constexpr int LDS_BYTES = 147456;
static_assert(att::LDS_BYTES <= RING_BYTES, "attention LDS");

#define GAS __attribute__((address_space(1)))
#define LAS __attribute__((address_space(3)))
typedef unsigned short bf16;
typedef unsigned v4u __attribute__((ext_vector_type(4)));
typedef unsigned v2u __attribute__((ext_vector_type(2)));
typedef float f32x4 __attribute__((ext_vector_type(4)));
typedef short bf16x8 __attribute__((ext_vector_type(8)));
#define LDS_WAIT() asm volatile("s_waitcnt lgkmcnt(0)" ::: "memory")
#define VM_WAIT() asm volatile("s_waitcnt vmcnt(0)" ::: "memory")
__device__ __forceinline__ unsigned f2bf(float f) { unsigned u = __builtin_bit_cast(unsigned, f); return (u + 0x7fffu + ((u >> 16) & 1u)) >> 16; }
__device__ __forceinline__ unsigned pk2(float lo, float hi) { return f2bf(lo) | (f2bf(hi) << 16); }
__device__ __forceinline__ float bf2f(short s) { return __uint_as_float(((unsigned)(unsigned short)s) << 16); }
__device__ __forceinline__ float wave_sum(float v) {
#pragma unroll
    for (int o = 1; o < 64; o <<= 1) v += __shfl_xor(v, o);
    return v;
}
__device__ __forceinline__ int cond_of_row(int row) { return row < NPROMPT ? 0 : 1 + ((row - NPROMPT) >> 11); }

#define XB_TMO      128
#define XB_XCNT(j)  (256  + 64 * (j))
#define XB_XSUB(j)  (1280 + 64 * (j))
#define XB_XGEN(j)  (2304 + 64 * (j))
#define XB_TOP      3328
#define XB_TOPGEN   3392
#define XCD_BAR_WORDS 3456
#define XB_SPIN_CAP (1u << 18)

__device__ __forceinline__ unsigned xb_ld(unsigned* p)              { return __hip_atomic_load(p, __ATOMIC_RELAXED, __HIP_MEMORY_SCOPE_AGENT); }
__device__ __forceinline__ unsigned xb_add(unsigned* p, unsigned v) { return __hip_atomic_fetch_add(p, v, __ATOMIC_RELAXED, __HIP_MEMORY_SCOPE_AGENT); }
__device__ __forceinline__ unsigned xb_xcc_id() { return (unsigned)__builtin_amdgcn_s_getreg((3 << 11) | 20) & 0xFu; }
#define XB_SPIN(cond, bar) do { unsigned _sp = 0; while (cond) { __builtin_amdgcn_s_sleep(1); \
    if ((++_sp & 255u) == 0u) { if (xb_ld(&(bar)[XB_TMO])) break; if (_sp > XB_SPIN_CAP) { atomicAdd(&(bar)[XB_TMO], 1u); break; } } } } while (0)

struct XcdBarrier {
    unsigned* bar; unsigned x; unsigned gsize;
    volatile LAS unsigned* st;
};

__device__ __forceinline__ XcdBarrier xcd_barrier_post(unsigned* bar, volatile LAS unsigned* st, unsigned gsize) {
    XcdBarrier b; b.bar = bar; b.x = xb_xcc_id(); b.st = st; b.gsize = gsize;
    if (threadIdx.x == 0) (void)xb_add(&bar[XB_XCNT(b.x)], 1u);
    return b;
}
__device__ __forceinline__ void xcd_barrier_complete(unsigned* bar, unsigned x, unsigned& nloc, unsigned& nx, const unsigned G) {
    unsigned sum, cnt, mine, sp = 0u;
    for (;;) {
        sum = 0u; cnt = 0u; mine = 0u;
#pragma unroll
        for (unsigned j = 0; j < 16; ++j) { const unsigned c = xb_ld(&bar[XB_XCNT(j)]); sum += c; cnt += (c > 0u) ? 1u : 0u; mine = (j == x) ? c : mine; }
        if (sum == G) break;
        __builtin_amdgcn_s_sleep(1);
        if ((++sp & 255u) == 0u) { if (xb_ld(&bar[XB_TMO])) break; if (sp > XB_SPIN_CAP) { atomicAdd(&bar[XB_TMO], 1u); break; } }
    }
    nloc = mine > 0u ? mine : 1u; nx = cnt > 0u ? cnt : 1u;
}

__device__ __forceinline__ void xcd_barrier(const XcdBarrier& b) {
    asm volatile("s_waitcnt vmcnt(0)" ::: "memory");
    __syncthreads();
    if (threadIdx.x == 0) {
        unsigned* bar = b.bar;
        __builtin_amdgcn_s_waitcnt(0);
        unsigned nloc = b.st[0], nx = b.st[1];
        if (nloc == 0u) { xcd_barrier_complete(bar, b.x, nloc, nx, b.gsize); b.st[0] = nloc; b.st[1] = nx; }
        const unsigned old = xb_add(&bar[XB_XSUB(b.x)], 1u);
        const unsigned gen = old / nloc;
        if (old + 1u == (gen + 1u) * nloc) {
            __builtin_amdgcn_fence(__ATOMIC_RELEASE, "agent");
            asm volatile("s_waitcnt vmcnt(0)" ::: "memory");
            const unsigned og = xb_add(&bar[XB_TOP], 1u);
            const unsigned tg = og / nx;
            if (og + 1u == (tg + 1u) * nx) xb_add(&bar[XB_TOPGEN], 1u);
            else XB_SPIN(xb_ld(&bar[XB_TOPGEN]) == tg, bar);
            __builtin_amdgcn_fence(__ATOMIC_ACQUIRE, "agent");
            xb_add(&bar[XB_XGEN(b.x)], 1u);
            asm volatile("s_waitcnt vmcnt(0)" ::: "memory");
        } else {
            XB_SPIN(xb_ld(&bar[XB_XGEN(b.x)]) == gen, bar);
            __builtin_amdgcn_fence(__ATOMIC_ACQUIRE, "agent");
            asm volatile("s_waitcnt vmcnt(0)" ::: "memory");
        }
    }
    __syncthreads();
}
constexpr int N_MOD = NLAYER * (MODROW / 256) * KS_MOD;
constexpr int I_CIN = (DM / 64) * (6144 / 32), I_SQ = (DM / 64) * (DM / 32), I_GIN = (DM / 64) * (4096 / 32), I_QA = (DM / 64) * (512 / 32), I_KVA = (DM / 64) * (576 / 32),
              I_QB = (512 / 64) * (3072 / 32), I_KVB = (512 / 64) * (4096 / 32), I_W1 = (DM / 64) * (DFF / 32), I_W2 = (DFF / 64) * (DM / 32);
constexpr int N_TR = 2 * I_CIN + 2 * I_SQ + I_GIN + I_SQ + I_QA + I_KVA + I_QB + I_KVB + I_SQ + 4 * I_W1 + 4 * I_W2;
constexpr int N_WSI = 512, N_ZI = 768, N_P0 = N_MOD + N_TR + N_WSI + N_ZI;

struct Ptrs {
    const float *xp, *xs, *cache_ckv, *cache_kpe, *c, *c_ctx, *ada_w, *ada_b, *norm1, *norm2, *conv_w_in, *conv_w, *conv_w_out, *gmlp_w_in, *gmlp_g_v, *gmlp_w_s, *gmlp_b_s, *gmlp_w_out,
                *mla_w_q_a, *mla_g_q, *mla_w_q_b, *mla_w_kv_a, *mla_g_kv, *mla_w_kv_b, *mla_w_o, *mlp_w1, *mlp_w2, *final_norm;
    float* out; unsigned char* ws;
};

struct Args { const float* in[28]; float* out; unsigned char* ws; int ph_lo, ph_hi; };
__device__ __forceinline__ Ptrs make_ptrs() {
    const __attribute__((address_space(4))) Args* ap = (const __attribute__((address_space(4))) Args*)__builtin_amdgcn_kernarg_segment_ptr();
    asm volatile("" : "+s"(ap));
    Ptrs P;
    P.xp = ap->in[0]; P.xs = ap->in[1]; P.cache_ckv = ap->in[2]; P.cache_kpe = ap->in[3]; P.c = ap->in[4]; P.c_ctx = ap->in[5]; P.ada_w = ap->in[6]; P.ada_b = ap->in[7];
    P.norm1 = ap->in[8]; P.norm2 = ap->in[9]; P.conv_w_in = ap->in[10]; P.conv_w = ap->in[11]; P.conv_w_out = ap->in[12]; P.gmlp_w_in = ap->in[13]; P.gmlp_g_v = ap->in[14];
    P.gmlp_w_s = ap->in[15]; P.gmlp_b_s = ap->in[16]; P.gmlp_w_out = ap->in[17]; P.mla_w_q_a = ap->in[18]; P.mla_g_q = ap->in[19]; P.mla_w_q_b = ap->in[20]; P.mla_w_kv_a = ap->in[21];
    P.mla_g_kv = ap->in[22]; P.mla_w_kv_b = ap->in[23]; P.mla_w_o = ap->in[24]; P.mlp_w1 = ap->in[25]; P.mlp_w2 = ap->in[26]; P.final_norm = ap->in[27];
    P.out = ap->out; P.ws = ap->ws;
    return P;
}
struct Ctx { int tid, lane, wave, G, bx, gw, NGW; };
__device__ __forceinline__ Ctx make_ctx() {
    int t = threadIdx.x; asm volatile("" : "+v"(t));
    int b = blockIdx.x; asm volatile("" : "+s"(b));
    Ctx C; C.tid = t; C.lane = t & 63; C.wave = __builtin_amdgcn_readfirstlane(t >> 6); int g_ = gridDim.x; asm volatile("" : "+s"(g_)); C.G = g_; C.bx = b;
    const int vcu = (C.G % 8 == 0) ? (b % 8) * (C.G / 8) + b / 8 : b;
    C.gw = vcu * NWAVES + C.wave; C.NGW = C.G * NWAVES;
    return C;
}

__device__ __forceinline__ void p0_transpose_item(const float* W, int K, int N, bf16* WT, int row_off, LAS float* scr, int item, int lane, bool zmap = false) {
    const int nblk = N / 32, kb = item / nblk, nb = item - kb * nblk, k0 = 64 * kb, n0 = 32 * nb;
    const int nd0 = (zmap && n0 >= 2048) ? 2048 + (((n0 - 2048) & 2047) >> 7) * 256 + ((n0 - 2048) >> 11) * 128 + (n0 & 127) : n0;
    const int lk = lane >> 3, ln = (lane & 7) * 4;
    f32x4 v[8];
#pragma unroll
    for (int i = 0; i < 8; ++i) v[i] = *(const f32x4*)(W + (size_t)(k0 + 8 * i + lk) * N + n0 + ln);
#pragma unroll
    for (int i = 0; i < 8; ++i) { LAS float* d = scr + (8 * i + lk) * 33 + ln; d[0] = v[i][0]; d[1] = v[i][1]; d[2] = v[i][2]; d[3] = v[i][3]; }
    LDS_WAIT(); asm volatile("" ::: "memory");
    const int c = lane & 7;
#pragma unroll
    for (int j = 0; j < 4; ++j) { const int n = (lane >> 3) + 8 * j; const LAS float* s = scr + (8 * c) * 33 + n;
        v4u o; o.x = pk2(s[0 * 33], s[1 * 33]); o.y = pk2(s[2 * 33], s[3 * 33]); o.z = pk2(s[4 * 33], s[5 * 33]); o.w = pk2(s[6 * 33], s[7 * 33]);
        *(v4u*)(WT + (size_t)(row_off + nd0 + n) * K + k0 + 8 * c) = o; }
    LDS_WAIT(); asm volatile("" ::: "memory");
}


__device__ __forceinline__ void p0a_phase(LAS unsigned char* lds) {
    const Ctx C = make_ctx(); const Ptrs P = make_ptrs(); const int gw = C.gw, NGW = C.NGW, tid = C.tid, wave = C.wave, lane = C.lane;
    LAS float* silu = (LAS float*)lds;
    for (int i = tid; i < 5 * DM; i += NWAVES * 64) { const int cd = i >> 11, k = i & (DM - 1); const float x = cd == 0 ? P.c_ctx[k] : P.c[(cd - 1) * DM + k]; silu[i] = x / (1.f + expf(-x)); }
    __syncthreads();
    LAS float* scr = (LAS float*)(lds + 40960 + wave * 8448);
    float* modp = (float*)(P.ws + WS_MODP);
    for (int it = gw; it < N_P0; it += NGW) {
        if (it < N_MOD) {
            const int L = it / (N_MOD / NLAYER), rem = it - L * (N_MOD / NLAYER), jb = rem / KS_MOD, ks = rem - jb * KS_MOD;
            const float* W = P.ada_w + ((size_t)L * DM + (size_t)ks * 128) * MODROW + jb * 256 + lane * 4;
            f32x4 acc[5];
#pragma unroll
            for (int cd = 0; cd < 5; ++cd) acc[cd] = (f32x4){0.f, 0.f, 0.f, 0.f};
            for (int k = 0; k < 128; k += 16) { f32x4 w[16];
#pragma unroll
                for (int i = 0; i < 16; ++i) w[i] = *(const f32x4*)(W + (size_t)(k + i) * MODROW);
#pragma unroll
                for (int i = 0; i < 16; ++i)
#pragma unroll
                    for (int cd = 0; cd < 5; ++cd) acc[cd] += w[i] * silu[cd * DM + ks * 128 + k + i]; }
#pragma unroll
            for (int cd = 0; cd < 5; ++cd) *(f32x4*)(modp + ((size_t)(ks * NLAYER + L) * 5 + cd) * MODROW + jb * 256 + lane * 4) = acc[cd];
            continue; }
        int r = it - N_MOD;
        if (r < N_TR) {
            const float* W; int K, N, ro = 0; size_t dst;
            if (r < 2 * I_CIN) { const int l = r / I_CIN; r -= l * I_CIN; W = P.conv_w_in + (size_t)l * DM * 6144; K = DM; N = 6144; dst = WS_CIN + (size_t)l * 6144 * DM * 2; }
            else if ((r -= 2 * I_CIN) < 2 * I_SQ) { const int l = r / I_SQ; r -= l * I_SQ; W = P.conv_w_out + (size_t)l * DM * DM; K = DM; N = DM; dst = WS_COUT + (size_t)l * DM * DM * 2; }
            else if ((r -= 2 * I_SQ) < I_GIN) { W = P.gmlp_w_in; K = DM; N = 4096; dst = WS_GIN; }
            else if ((r -= I_GIN) < I_SQ) { W = P.gmlp_w_out; K = DM; N = DM; dst = WS_GOUT; }
            else if ((r -= I_SQ) < I_QA) { W = P.mla_w_q_a; K = DM; N = 512; dst = WS_MLA_A; }
            else if ((r -= I_QA) < I_KVA) { W = P.mla_w_kv_a; K = DM; N = 576; dst = WS_MLA_A; ro = 512; }
            else if ((r -= I_KVA) < I_QB) { W = P.mla_w_q_b; K = 512; N = 3072; dst = WS_QB; }
            else if ((r -= I_QB) < I_KVB) { W = P.mla_w_kv_b; K = 512; N = 4096; dst = WS_KVB; }
            else if ((r -= I_KVB) < I_SQ) { W = P.mla_w_o; K = DM; N = DM; dst = WS_WO; }
            else if ((r -= I_SQ) < 4 * I_W1) { const int l = r / I_W1; r -= l * I_W1; W = P.mlp_w1 + (size_t)l * DM * DFF; K = DM; N = DFF; dst = WS_W1 + (size_t)l * DFF * DM * 2; }
            else { r -= 4 * I_W1; const int l = r / I_W2; r -= l * I_W2; W = P.mlp_w2 + (size_t)l * DFF * DM; K = DFF; N = DM; dst = WS_W2 + (size_t)l * DM * DFF * 2; }
            p0_transpose_item(W, K, N, (bf16*)(P.ws + dst), ro, scr, r, lane, N == 6144);
            continue; }
        r -= N_TR;
        if (r < N_WSI) { const float* s = P.gmlp_w_s + (size_t)r * 512 + lane * 8; const f32x4 a = *(const f32x4*)s, b = *(const f32x4*)(s + 4);
            v4u o; o.x = pk2(a[0], a[1]); o.y = pk2(a[2], a[3]); o.z = pk2(b[0], b[1]); o.w = pk2(b[2], b[3]); *(v4u*)((bf16*)(P.ws + WS_WS) + (size_t)r * 512 + lane * 8) = o; continue; }
        r -= N_WSI;
        { v4u z; z.x = 0u; z.y = 0u; z.z = 0u; z.w = 0u; *(v4u*)((bf16*)(P.ws + WS_MLA_A) + (size_t)1088 * DM + (size_t)r * 512 + lane * 8) = z; }
    }
    __syncthreads();
}

__device__ __forceinline__ void sincos_d(double a, double& sn, double& cs) {
    const double k = rint(a * 0.63661977236758134308); double r = fma(-k, 1.57079632679489655800, a); r = fma(-k, 6.12323399573676603587e-17, r);
    const double r2 = r * r;
    const double s = r * (1.0 + r2 * (-1.0 / 6 + r2 * (1.0 / 120 + r2 * (-1.0 / 5040 + r2 * (1.0 / 362880 + r2 * (-1.0 / 39916800 + r2 * (1.0 / 6227020800.0 + r2 * (-1.0 / 1307674368000.0))))))));
    const double c = 1.0 + r2 * (-0.5 + r2 * (1.0 / 24 + r2 * (-1.0 / 720 + r2 * (1.0 / 40320 + r2 * (-1.0 / 3628800 + r2 * (1.0 / 479001600 + r2 * (-1.0 / 87178291200.0 + r2 * (1.0 / 20922789888000.0))))))));
    const int q = ((int)k) & 3;
    sn = q == 0 ? s : q == 1 ? c : q == 2 ? -s : -c;
    cs = q == 0 ? c : q == 1 ? -s : q == 2 ? -c : s;
}
__device__ __forceinline__ void p0b_phase() {
    const Ctx C = make_ctx(); const Ptrs P = make_ptrs(); const int gtid = C.bx * (NWAVES * 64) + C.tid, NT = C.G * NWAVES * 64;
    const float* modp = (const float*)(P.ws + WS_MODP); float* modf = (float*)(P.ws + WS_MODF);
    for (int i = gtid; i < NLAYER * 5 * MODROW; i += NT) {
        const int cidx = i & (DM - 1), lcs = i >> 11, slot = lcs % 6, lc = lcs / 6, L = lc / 5, cd = lc - 5 * L, j = slot * DM + cidx;
        float v = P.ada_b[L * MODROW + j];
#pragma unroll
        for (int ks = 0; ks < KS_MOD; ++ks) v += modp[((size_t)(ks * NLAYER + L) * 5 + cd) * MODROW + j];
        if (slot == 1) v = P.norm1[L * DM + cidx] * (1.f + v);
        if (slot == 4) v = P.norm2[L * DM + cidx] * (1.f + v);
        modf[i] = v; }
    float* rope = (float*)(P.ws + WS_ROPE);
    for (int i = gtid; i < 64 * 16; i += NT) { const int pos = i >> 4, j = i & 15;
        double inv = 1.0; for (int q = 0; q < j; ++q) inv *= 0.56234132519034908039;
        const float ang = (float)pos * (float)inv; double sn, cs; sincos_d((double)ang, sn, cs);
        rope[2 * i] = (float)cs; rope[2 * i + 1] = (float)sn; }
}

__device__ __forceinline__ void norm_phase(int L, int which, bool first) {
    const Ctx C = make_ctx(); const Ptrs P = make_ptrs(); const int gw = C.gw, NGW = C.NGW, lane = C.lane;
    const float* modf = (const float*)(P.ws + WS_MODF); bf16* X = (bf16*)(P.ws + WS_X); bf16* H = (bf16*)(P.ws + WS_H);
    for (int r0 = gw * 8; r0 < NTOK; r0 += NGW * 8) {
        const int cd = cond_of_row(r0);
        const float* wp = modf + ((size_t)(L * 5 + cd) * 6 + (which ? 4 : 1)) * DM + lane * 8;
        const float* sp = modf + ((size_t)(L * 5 + cd) * 6 + (which ? 3 : 0)) * DM + lane * 8;
        f32x4 wv[4][2], sv[4][2];
#pragma unroll
        for (int j = 0; j < 4; ++j) { wv[j][0] = *(const f32x4*)(wp + 512 * j); wv[j][1] = *(const f32x4*)(wp + 512 * j + 4); sv[j][0] = *(const f32x4*)(sp + 512 * j); sv[j][1] = *(const f32x4*)(sp + 512 * j + 4); }
        for (int rr = 0; rr < 8; rr += 2) {
            f32x4 v[2][4][2];
            if (first) {
#pragma unroll
                for (int q = 0; q < 2; ++q) { const int row = r0 + rr + q; const float* src = (row < NPROMPT ? P.xp + (size_t)row * DM : P.xs + (size_t)(row - NPROMPT) * DM) + lane * 8;
#pragma unroll
                    for (int j = 0; j < 4; ++j) { v[q][j][0] = *(const f32x4*)(src + 512 * j); v[q][j][1] = *(const f32x4*)(src + 512 * j + 4); } }
#pragma unroll
                for (int q = 0; q < 2; ++q) { const int row = r0 + rr + q;
#pragma unroll
                    for (int j = 0; j < 4; ++j) { v4u o; o.x = pk2(v[q][j][0][0], v[q][j][0][1]); o.y = pk2(v[q][j][0][2], v[q][j][0][3]); o.z = pk2(v[q][j][1][0], v[q][j][1][1]); o.w = pk2(v[q][j][1][2], v[q][j][1][3]);
                        *(v4u*)(X + (size_t)row * DM + lane * 8 + 512 * j) = o;
                        v[q][j][0] = (f32x4){__uint_as_float(o.x << 16), __uint_as_float(o.x & 0xffff0000u), __uint_as_float(o.y << 16), __uint_as_float(o.y & 0xffff0000u)};
                        v[q][j][1] = (f32x4){__uint_as_float(o.z << 16), __uint_as_float(o.z & 0xffff0000u), __uint_as_float(o.w << 16), __uint_as_float(o.w & 0xffff0000u)}; } }
            } else { v4u o[2][4];
#pragma unroll
                for (int q = 0; q < 2; ++q) { const bf16* src = X + (size_t)(r0 + rr + q) * DM + lane * 8;
#pragma unroll
                    for (int j = 0; j < 4; ++j) o[q][j] = *(const v4u*)(src + 512 * j); }
#pragma unroll
                for (int q = 0; q < 2; ++q)
#pragma unroll
                    for (int j = 0; j < 4; ++j) {
                        v[q][j][0] = (f32x4){__uint_as_float(o[q][j].x << 16), __uint_as_float(o[q][j].x & 0xffff0000u), __uint_as_float(o[q][j].y << 16), __uint_as_float(o[q][j].y & 0xffff0000u)};
                        v[q][j][1] = (f32x4){__uint_as_float(o[q][j].z << 16), __uint_as_float(o[q][j].z & 0xffff0000u), __uint_as_float(o[q][j].w << 16), __uint_as_float(o[q][j].w & 0xffff0000u)}; } }
#pragma unroll
            for (int q = 0; q < 2; ++q) { const int row = r0 + rr + q; float ss = 0.f;
#pragma unroll
                for (int j = 0; j < 4; ++j)
#pragma unroll
                    for (int h = 0; h < 2; ++h) ss += (v[q][j][h][0] * v[q][j][h][0] + v[q][j][h][1] * v[q][j][h][1]) + (v[q][j][h][2] * v[q][j][h][2] + v[q][j][h][3] * v[q][j][h][3]);
                const float rstd = 1.0f / sqrtf(wave_sum(ss) * (1.f / DM) + EPS);
#pragma unroll
                for (int j = 0; j < 4; ++j) { const f32x4 h0 = v[q][j][0] * rstd * wv[j][0] + sv[j][0], h1 = v[q][j][1] * rstd * wv[j][1] + sv[j][1];
                    v4u o; o.x = pk2(h0[0], h0[1]); o.y = pk2(h0[2], h0[3]); o.z = pk2(h1[0], h1[1]); o.w = pk2(h1[2], h1[3]);
                    *(v4u*)(H + (size_t)row * DM + lane * 8 + 512 * j) = o; } }
        }
    }
}
__device__ __forceinline__ void final_norm_phase() {
    const Ctx C = make_ctx(); const Ptrs P = make_ptrs(); const int gw = C.gw, NGW = C.NGW, lane = C.lane;
    const bf16* X = (const bf16*)(P.ws + WS_X);
    f32x4 wv[4][2];
#pragma unroll
    for (int j = 0; j < 4; ++j) { wv[j][0] = *(const f32x4*)(P.final_norm + lane * 8 + 512 * j); wv[j][1] = *(const f32x4*)(P.final_norm + lane * 8 + 512 * j + 4); }
    for (int row = gw; row < NTOK; row += NGW) {
        const bf16* src = X + (size_t)row * DM + lane * 8;
        v4u o[4]; f32x4 v[4][2]; float ss = 0.f;
#pragma unroll
        for (int j = 0; j < 4; ++j) o[j] = *(const v4u*)(src + 512 * j);
#pragma unroll
        for (int j = 0; j < 4; ++j) {
            v[j][0] = (f32x4){__uint_as_float(o[j].x << 16), __uint_as_float(o[j].x & 0xffff0000u), __uint_as_float(o[j].y << 16), __uint_as_float(o[j].y & 0xffff0000u)};
            v[j][1] = (f32x4){__uint_as_float(o[j].z << 16), __uint_as_float(o[j].z & 0xffff0000u), __uint_as_float(o[j].w << 16), __uint_as_float(o[j].w & 0xffff0000u)};
#pragma unroll
            for (int h = 0; h < 2; ++h) ss += (v[j][h][0] * v[j][h][0] + v[j][h][1] * v[j][h][1]) + (v[j][h][2] * v[j][h][2] + v[j][h][3] * v[j][h][3]); }
        const float rstd = 1.0f / sqrtf(wave_sum(ss) * (1.f / DM) + EPS);
        float* yo = P.out + OUT_Y + (size_t)row * DM + lane * 8;
#pragma unroll
        for (int j = 0; j < 4; ++j) { *(f32x4*)(yo + 512 * j) = v[j][0] * rstd * wv[j][0]; *(f32x4*)(yo + 512 * j + 4) = v[j][1] * rstd * wv[j][1]; }
    }
}

__device__ __forceinline__ void conv_elem_phase(int jl) {
    const Ctx C = make_ctx(); const Ptrs P = make_ptrs(); const int gw = C.gw, NGW = C.NGW, lane = C.lane;
    const bf16* U = (const bf16*)(P.ws + WS_BIG); bf16* A2 = (bf16*)(P.ws + WS_A2); const float* cw = P.conv_w + (size_t)jl * 3 * DM;
    for (int item = gw; item < (NTOK / 8) * 4; item += NGW) {
        const int s = item >> 2, cb = item & 3, r0 = s * 8, c = cb * 512 + lane * 8;
        const int seqlen = r0 < NPROMPT ? 256 : SEQ_S, t0 = r0 & (seqlen - 1);
        float w0[8], w1[8], w2[8];
#pragma unroll
        for (int e = 0; e < 8; ++e) { w0[e] = cw[c + e]; w1[e] = cw[DM + c + e]; w2[e] = cw[2 * DM + c + e]; }
        bf16x8 zr[10], bg[8];
        const bf16x8 zero8 = {0, 0, 0, 0, 0, 0, 0, 0};
        zr[0] = (t0 == 0) ? zero8 : *(const bf16x8*)(U + (size_t)(r0 - 1) * 4096 + DM + c);
#pragma unroll
        for (int rr = 0; rr < 8; ++rr) { zr[1 + rr] = *(const bf16x8*)(U + (size_t)(r0 + rr) * 4096 + DM + c); bg[rr] = *(const bf16x8*)(U + (size_t)(r0 + rr) * 4096 + c); }
        zr[9] = (t0 + 8 == seqlen) ? zero8 : *(const bf16x8*)(U + (size_t)(r0 + 8) * 4096 + DM + c);
#pragma unroll
        for (int rr = 0; rr < 8; ++rr) { float a[8];
#pragma unroll
            for (int e = 0; e < 8; ++e) a[e] = bf2f(bg[rr][e]) * (w0[e] * bf2f(zr[rr][e]) + w1[e] * bf2f(zr[rr + 1][e]) + w2[e] * bf2f(zr[rr + 2][e]));
            v4u o; o.x = pk2(a[0], a[1]); o.y = pk2(a[2], a[3]); o.z = pk2(a[4], a[5]); o.w = pk2(a[6], a[7]);
            *(v4u*)(A2 + (size_t)(r0 + rr) * DM + c) = o; }
    }
}

__device__ __forceinline__ void gmlp_spatial_phase(LAS unsigned char* lds) {
    const Ctx C = make_ctx(); const Ptrs P = make_ptrs(); const int G = C.G, c = C.bx;
    const int tid = C.tid, wid = tid >> 6, lane = tid & 63, r32 = lane & 31, hi = lane >> 5;
    const bf16* UV = (const bf16*)(P.ws + WS_BIG); bf16* A2 = (bf16*)(P.ws + WS_A2); const bf16* WSb = (const bf16*)(P.ws + WS_WS);
    LAS float* rs = (LAS float*)(lds + 65536); LAS unsigned char* Sb = lds + 66048; constexpr int SP = 272;
    for (int u = c; u < 256; u += G) {
        const int n = u >> 1, hh = u & 1, R0 = n * 128;
        for (int qq = 0; qq < 16; qq += 4) {
            v4u x[4][4];
#pragma unroll
            for (int k = 0; k < 4; ++k) { const bf16* vr = UV + (size_t)(R0 + wid * 16 + qq + k) * 4096 + DM + lane * 8;
#pragma unroll
                for (int j = 0; j < 4; ++j) x[k][j] = *(const v4u*)(vr + 512 * j); }
#pragma unroll
            for (int k = 0; k < 4; ++k) { float ss = 0.f;
#pragma unroll
                for (int j = 0; j < 4; ++j)
#pragma unroll
                    for (int e = 0; e < 4; ++e) { const float lo = __uint_as_float(x[k][j][e] << 16), hv = __uint_as_float(x[k][j][e] & 0xffff0000u); ss += lo * lo + hv * hv; }
                ss = wave_sum(ss); if (lane == 0) rs[wid * 16 + qq + k] = 1.0f / sqrtf(ss * (1.f / DM) + EPS); } }
        __syncthreads();
        const int sr = tid >> 4, sc = (tid & 15) * 8, mi = wid & 3, dh = wid >> 2;
        for (int gi = 0; gi < 8; ++gi) { const int g = hh * 8 + gi, c0 = g * 128; LAS unsigned char* Vb = lds + (gi & 1) * 32768;
            const f32x4 ga = *(const f32x4*)(P.gmlp_g_v + c0 + sc), gb = *(const f32x4*)(P.gmlp_g_v + c0 + sc + 4);
            bf16x8 xs[4];
#pragma unroll
            for (int i = 0; i < 4; ++i) xs[i] = *(const bf16x8*)(UV + (size_t)(R0 + sr + 32 * i) * 4096 + DM + c0 + sc);
#pragma unroll
            for (int i = 0; i < 4; ++i) { const int q = sr + 32 * i; const bf16x8 x = xs[i]; const float r = rs[q];
                v4u o; o.x = pk2(bf2f(x[0]) * r * ga[0], bf2f(x[1]) * r * ga[1]); o.y = pk2(bf2f(x[2]) * r * ga[2], bf2f(x[3]) * r * ga[3]);
                o.z = pk2(bf2f(x[4]) * r * gb[0], bf2f(x[5]) * r * gb[1]); o.w = pk2(bf2f(x[6]) * r * gb[2], bf2f(x[7]) * r * gb[3]);
                *(LAS v4u*)(Vb + (q >> 6) * 16384 + att::v_st(q & 63, sc)) = o; }
            bf16x8 us[4];
#pragma unroll
            for (int i = 0; i < 4; ++i) us[i] = *(const bf16x8*)(UV + (size_t)(R0 + sr + 32 * i) * 4096 + c0 + sc);
            __syncthreads();
            bf16x8 pa[2][4];
#pragma unroll
            for (int t = 0; t < 2; ++t)
#pragma unroll
                for (int s = 0; s < 4; ++s) pa[t][s] = *(const bf16x8*)(WSb + ((size_t)g * 128 + 32 * mi + r32) * 128 + 64 * t + 16 * s + 8 * hi);
            att::f32x16 od0 = {}, od1 = {};
#pragma unroll
            for (int t = 0; t < 2; ++t) { const int vb = (int)(unsigned)(size_t)Vb + t * 16384 + dh * 1024 + att::v_rd_base(lane);
                att::pv_one<0>(od0, vb, pa[t][0], pa[t][1], pa[t][2], pa[t][3]); att::pv_one<1>(od1, vb, pa[t][0], pa[t][1], pa[t][2], pa[t][3]); }
#pragma unroll
            for (int r = 0; r < 16; ++r) { const int pr = 32 * mi + att::crow(r, hi); const float bias = P.gmlp_b_s[g * 128 + pr];
                *(LAS bf16*)(Sb + pr * SP + (32 * (2 * dh) + r32) * 2) = (bf16)f2bf(od0[r] + bias);
                *(LAS bf16*)(Sb + pr * SP + (32 * (2 * dh + 1) + r32) * 2) = (bf16)f2bf(od1[r] + bias); }
            __syncthreads();
#pragma unroll
            for (int i = 0; i < 4; ++i) { const int pr = sr + 32 * i; const bf16x8 sv = *(const LAS bf16x8*)(Sb + pr * SP + sc * 2); const bf16x8 uu = us[i];
                v4u o; o.x = pk2(bf2f(uu[0]) * bf2f(sv[0]), bf2f(uu[1]) * bf2f(sv[1])); o.y = pk2(bf2f(uu[2]) * bf2f(sv[2]), bf2f(uu[3]) * bf2f(sv[3]));
                o.z = pk2(bf2f(uu[4]) * bf2f(sv[4]), bf2f(uu[5]) * bf2f(sv[5])); o.w = pk2(bf2f(uu[6]) * bf2f(sv[6]), bf2f(uu[7]) * bf2f(sv[7]));
                *(v4u*)(A2 + (size_t)(R0 + pr) * DM + c0 + sc) = o; }
        }
        __syncthreads();
    }
}

__device__ __forceinline__ void mla_thin_phase() {
    const Ctx C = make_ctx(); const Ptrs P = make_ptrs(); const int gw = C.gw, NGW = C.NGW, lane = C.lane;
    const bf16* ABF = (const bf16*)(P.ws + WS_ABF); bf16* QAN = (bf16*)(P.ws + WS_QAN); bf16* CKV = (bf16*)(P.ws + WS_CKV); bf16* KPE = (bf16*)(P.ws + WS_KPE); const float* rope = (const float*)(P.ws + WS_ROPE);
    const f32x4 gq0 = *(const f32x4*)(P.mla_g_q + lane * 8), gq1 = *(const f32x4*)(P.mla_g_q + lane * 8 + 4), gk0 = *(const f32x4*)(P.mla_g_kv + lane * 8), gk1 = *(const f32x4*)(P.mla_g_kv + lane * 8 + 4);
    for (int item = gw; item < NKVROWS; item += NGW) {
        if (item < NTOK) { const int row = item; const bf16* base = ABF + (size_t)row * 1280;
            const int dst = row < NPROMPT ? row : NPROMPT + ((row - NPROMPT) >> 11) * LKS + PAST + ((row - NPROMPT) & (SEQ_S - 1));
            { const bf16x8 x = *(const bf16x8*)(base + lane * 8); float f[8], ss = 0.f;
#pragma unroll
              for (int e = 0; e < 8; ++e) { f[e] = bf2f(x[e]); ss += f[e] * f[e]; }
              const float r = 1.0f / sqrtf(wave_sum(ss) * (1.f / 512) + EPS);
              v4u o; o.x = pk2(f[0] * r * gq0[0], f[1] * r * gq0[1]); o.y = pk2(f[2] * r * gq0[2], f[3] * r * gq0[3]); o.z = pk2(f[4] * r * gq1[0], f[5] * r * gq1[1]); o.w = pk2(f[6] * r * gq1[2], f[7] * r * gq1[3]);
              *(v4u*)(QAN + (size_t)row * 512 + lane * 8) = o; }
            { const bf16x8 x = *(const bf16x8*)(base + 512 + lane * 8); float f[8], ss = 0.f;
#pragma unroll
              for (int e = 0; e < 8; ++e) { f[e] = bf2f(x[e]); ss += f[e] * f[e]; }
              const float r = 1.0f / sqrtf(wave_sum(ss) * (1.f / 512) + EPS);
              f32x4 y0, y1;
#pragma unroll
              for (int e = 0; e < 4; ++e) { y0[e] = f[e] * r * gk0[e]; y1[e] = f[4 + e] * r * gk1[e]; }
              v4u o; o.x = pk2(y0[0], y0[1]); o.y = pk2(y0[2], y0[3]); o.z = pk2(y1[0], y1[1]); o.w = pk2(y1[2], y1[3]);
              *(v4u*)(CKV + (size_t)dst * 512 + lane * 8) = o;
              if (row < NPROMPT) { float* oc = P.out + OUT_CKV + (size_t)row * 512 + lane * 8; *(f32x4*)oc = y0; *(f32x4*)(oc + 4) = y1; } }
            { const float x = bf2f((short)base[1024 + lane]);
              if (row < NPROMPT) { P.out[OUT_KPE + (size_t)row * 64 + lane] = x; KPE[(size_t)dst * 64 + lane] = (bf16)f2bf(x); }
              else { const int t = (row - NPROMPT) & (SEQ_S - 1), w = lane & 31, j = w & 15, pos = (lane >> 5) ? (t & 63) : (t >> 6);
                  const float cs = rope[2 * (pos * 16 + j)], sn = rope[2 * (pos * 16 + j) + 1]; const float xo = __shfl_xor(x, 16);
                  const float y = (w >> 4) ? (xo * sn + x * cs) : (x * cs - xo * sn);
                  KPE[(size_t)dst * 64 + lane] = (bf16)f2bf(y); } }
        } else { const int cr = item - NTOK, b = cr >> 9, p = cr & (PAST - 1), dst = NPROMPT + b * LKS + p;
            const float* s = P.cache_ckv + (size_t)cr * 512 + lane * 8; const f32x4 a = *(const f32x4*)s, bb = *(const f32x4*)(s + 4);
            v4u o; o.x = pk2(a[0], a[1]); o.y = pk2(a[2], a[3]); o.z = pk2(bb[0], bb[1]); o.w = pk2(bb[2], bb[3]);
            *(v4u*)(CKV + (size_t)dst * 512 + lane * 8) = o;
            KPE[(size_t)dst * 64 + lane] = (bf16)f2bf(P.cache_kpe[(size_t)cr * 64 + lane]); }
    }
}

__device__ __forceinline__ void attn_phase(LAS unsigned char* lds) {
    const Ctx C = make_ctx(); const Ptrs P = make_ptrs(); const int G = C.G, c = C.bx;
    const bf16* Q = (const bf16*)(P.ws + WS_Q); const bf16* KV = (const bf16*)(P.ws + WS_KV); const bf16* KPE = (const bf16*)(P.ws + WS_KPE); bf16* O = (bf16*)(P.ws + WS_A2); const float* rope = (const float*)(P.ws + WS_ROPE);
    for (int id = c; id < 1024; id += G) {
        int h, qrow0, kvrow0, nkeys, rp, t0;
        if (id < 512) { const int x = id & 7, y = id >> 3, qb = y & 7, bh = x + 8 * (y >> 3), b = bh >> 4; h = bh & 15;
            qrow0 = NPROMPT + b * SEQ_S + qb * 256; kvrow0 = NPROMPT + b * LKS; nkeys = LKS; rp = 1; t0 = qb * 256; }
        else { const int i2 = id - 512, b = i2 >> 4; h = i2 & 15; qrow0 = b * 256; kvrow0 = b * 256; nkeys = 256; rp = 0; t0 = 0; }
        att::attn_unit(lds, Q + (size_t)qrow0 * att::LDQ + h * 192, KV + (size_t)kvrow0 * att::LDKV + h * 256, KPE + (size_t)kvrow0 * 64,
                       O + (size_t)qrow0 * att::LDO + h * 128, nkeys, rp, t0, rope);
    }
}

#ifndef W1_WGM
#define W1_WGM 4
#endif
#ifndef W2_WGM
#define W2_WGM 4
#endif
#ifndef MLP_SPLIT
#define MLP_SPLIT 1
#endif
#ifndef GEMM_ALIGN
#define GEMM_ALIGN 1
#endif
#ifndef GEMM_SP2
#define GEMM_SP2 1
#endif
#ifndef KREP_G1
#define KREP_G1 1
#endif
#ifndef KREP_G2
#define KREP_G2 1
#endif
#ifndef KREP_W1
#define KREP_W1 1
#endif
#ifndef KREP_W2
#define KREP_W2 1
#endif
#ifndef REP_P0
#define REP_P0 1
#endif
#ifndef REP_NORM
#define REP_NORM 1
#endif
#ifndef REP_G1
#define REP_G1 1
#endif
#ifndef REP_THIN
#define REP_THIN 1
#endif
#ifndef REP_QKV
#define REP_QKV 1
#endif
#ifndef REP_ATT
#define REP_ATT 1
#endif
#ifndef REP_G2
#define REP_G2 1
#endif
#ifndef REP_W1
#define REP_W1 1
#endif
#ifndef REP_W2
#define REP_W2 1
#endif
#ifndef EN_P0
#define EN_P0 1
#endif
#ifndef EN_NORM
#define EN_NORM 1
#endif
#ifndef EN_G1
#define EN_G1 1
#endif
#ifndef EN_THIN
#define EN_THIN 1
#endif
#ifndef EN_QKV
#define EN_QKV 1
#endif
#ifndef EN_ATT
#define EN_ATT 1
#endif
#ifndef EN_G2
#define EN_G2 1
#endif
#ifndef EN_W1
#define EN_W1 1
#endif
#ifndef EN_W2
#define EN_W2 1
#endif
constexpr int N_PHASE_IDS = 2 + 9 * NLAYER + 1;
__global__ void __launch_bounds__(NWAVES * 64, 2) mk_fwd(Args args) {
    extern __shared__ __attribute__((aligned(16))) unsigned char lds_raw[];
    LAS unsigned char* lds = (LAS unsigned char*)lds_raw;
    const int tid = threadIdx.x;
    unsigned char* ws0 = args.ws;
    if (tid < 4) ((LAS unsigned*)(lds + MISC_OFF))[tid] = 0u;
    __syncthreads();
    XcdBarrier bar = xcd_barrier_post((unsigned*)(ws0 + WS_CTL) + CW_BAR, (volatile LAS unsigned*)(lds + MISC_OFF), gridDim.x);
    const int lo = args.ph_lo, hi = args.ph_hi; const bool fused = (hi - lo) > 1;
#define PH(id) (lo <= (id) && (id) < hi)
#define SEAM() do { if (fused) xcd_barrier(bar); } while (0)

    if (EN_P0 && PH(0)) {
_Pragma("unroll 1") for (int rep = 0; rep < REP_P0; ++rep) { p0a_phase(lds); SEAM(); } }
    if (EN_P0 && PH(1)) {
_Pragma("unroll 1") for (int rep = 0; rep < REP_P0; ++rep) { p0b_phase(); SEAM(); } }

    for (int L = 0; L < NLAYER; ++L) {
        const int kind = L % 3, jl = L / 3, pb = 2 + 9 * L;
        if (EN_NORM && PH(pb + 0)) {
_Pragma("unroll 1") for (int rep = 0; rep < REP_NORM; ++rep) { norm_phase(L, 0, L == 0); SEAM(); } }
        if (EN_G1 && PH(pb + 1)) {
_Pragma("unroll 1") for (int rep = 0; rep < REP_G1; ++rep) {
            const Ctx C = make_ctx(); const Ptrs P = make_ptrs(); unsigned char* ws = P.ws; const int G = C.G, bx = C.bx; const float* modf = (const float*)(ws + WS_MODF); (void)modf;
            const bf16* Bt = kind == 0 ? (const bf16*)(ws + WS_CIN) + (size_t)jl * 6144 * DM : kind == 1 ? (const bf16*)(ws + WS_GIN) : (const bf16*)(ws + WS_MLA_A);
            const int N = kind == 0 ? 6144 : kind == 1 ? 4096 : 1280;
            pg8::Gemm g{(const bf16*)(ws + WS_H), Bt, NTOK, N, DM, KREP_G1}; pg8::StaticOrder S; S.init(NTOK, N, G, bx);
            pg8::EpiBf16 E{(bf16*)(ws + WS_BIG), kind == 0 ? 4096 : N, 0, 1.0f / KREP_G1, kind == 0};
            pg8::gemm_phase<pg8::EpiBf16, pg8::StaticOrder, GEMM_ALIGN, GEMM_SP2>(lds + RING_OFF, g, S, E);
            SEAM(); } }
        if (EN_THIN && PH(pb + 2)) {
_Pragma("unroll 1") for (int rep = 0; rep < REP_THIN; ++rep) {
            if (kind == 0) conv_elem_phase(jl);
            else if (kind == 1) gmlp_spatial_phase(lds + RING_OFF);
            else mla_thin_phase();
            SEAM(); } }
        if (kind == 2) {
            if (EN_QKV && PH(pb + 3)) {
_Pragma("unroll 1") for (int rep = 0; rep < REP_QKV; ++rep) {
                const Ctx C = make_ctx(); const Ptrs P = make_ptrs(); unsigned char* ws = P.ws; const int G = C.G, bx = C.bx; const float* modf = (const float*)(ws + WS_MODF); (void)modf;
                { pg8::Gemm g{(const bf16*)(ws + WS_QAN), (const bf16*)(ws + WS_QB), NTOK, 3072, 512, 1}; pg8::StaticOrder S; S.init(NTOK, 3072, G, bx);
                  pg8::EpiBf16 E{(bf16*)(ws + WS_Q), 3072, 0, 1.0f, 0};
                  pg8::gemm_phase<pg8::EpiBf16, pg8::StaticOrder, GEMM_ALIGN, GEMM_SP2>(lds + RING_OFF, g, S, E); }
                { pg8::Gemm g{(const bf16*)(ws + WS_CKV), (const bf16*)(ws + WS_KVB), NKVROWS, 4096, 512, 1}; pg8::StaticOrder S; S.init(NKVROWS, 4096, G, bx);
                  pg8::EpiBf16 E{(bf16*)(ws + WS_KV), 4096, 0, 1.0f, 0};
                  pg8::gemm_phase<pg8::EpiBf16, pg8::StaticOrder, GEMM_ALIGN, GEMM_SP2>(lds + RING_OFF, g, S, E); }
                SEAM(); } }
            if (EN_ATT && PH(pb + 4)) {
_Pragma("unroll 1") for (int rep = 0; rep < REP_ATT; ++rep) { attn_phase(lds + RING_OFF); SEAM(); } }
        }
        if (EN_G2 && PH(pb + 5)) {
_Pragma("unroll 1") for (int rep = 0; rep < REP_G2; ++rep) {
            const Ctx C = make_ctx(); const Ptrs P = make_ptrs(); unsigned char* ws = P.ws; const int G = C.G, bx = C.bx; const float* modf = (const float*)(ws + WS_MODF); (void)modf;
            const bf16* Bt = kind == 0 ? (const bf16*)(ws + WS_COUT) + (size_t)jl * DM * DM : kind == 1 ? (const bf16*)(ws + WS_GOUT) : (const bf16*)(ws + WS_WO);
            pg8::Gemm g{(const bf16*)(ws + WS_A2), Bt, NTOK, DM, DM, KREP_G2}; pg8::GroupOrder S; S.init(NTOK / 256, DM, G, bx, W2_WGM, NTOK / 256, 0, 0);
            pg8::EpiRes E{(bf16*)(ws + WS_X), rep ? (const float*)(ws + WS_CTL) : modf + (size_t)L * 5 * MODROW + 2 * DM, DM, rep ? 0 : MODROW, 1.0f / KREP_G2, 0};
            pg8::gemm_phase<pg8::EpiRes, pg8::GroupOrder, GEMM_ALIGN, GEMM_SP2>(lds + RING_OFF, g, S, E);
            SEAM(); } }
        if (EN_NORM && PH(pb + 6)) {
_Pragma("unroll 1") for (int rep = 0; rep < REP_NORM; ++rep) { norm_phase(L, 1, false); SEAM(); } }
        for (int hb = 0; hb < MLP_SPLIT; ++hb) {
        if (EN_W1 && PH(pb + 7)) {
_Pragma("unroll 1") for (int rep = 0; rep < REP_W1; ++rep) {
            const Ctx C = make_ctx(); const Ptrs P = make_ptrs(); unsigned char* ws = P.ws; const int G = C.G, bx = C.bx;
            constexpr int MS = NTOK / MLP_SPLIT;
            pg8::Gemm g{(const bf16*)(ws + WS_H) + (size_t)hb * MS * DM, (const bf16*)(ws + WS_W1) + (size_t)L * DFF * DM, MS, DFF, DM, KREP_W1}; pg8::GroupOrder S; S.init(MS / 256, DFF, G, bx, W1_WGM, MS / 256, 0, 0);
            pg8::EpiBf16 E{(bf16*)(ws + WS_BIG), DFF, 1, 1.0f / KREP_W1, 0};
            pg8::gemm_phase<pg8::EpiBf16, pg8::GroupOrder, GEMM_ALIGN, GEMM_SP2>(lds + RING_OFF, g, S, E);
            SEAM(); } }
        if (EN_W2 && PH(pb + 8)) {
_Pragma("unroll 1") for (int rep = 0; rep < REP_W2; ++rep) {
            const Ctx C = make_ctx(); const Ptrs P = make_ptrs(); unsigned char* ws = P.ws; const int G = C.G, bx = C.bx; const float* modf = (const float*)(ws + WS_MODF);
            constexpr int MS = NTOK / MLP_SPLIT;
            pg8::Gemm g{(const bf16*)(ws + WS_BIG), (const bf16*)(ws + WS_W2) + (size_t)L * DM * DFF, MS, DM, DFF, KREP_W2}; pg8::GroupOrder S; S.init(MS / 256, DM, G, bx, W2_WGM, MS / 256, 0, 0);
            pg8::EpiRes E{(bf16*)(ws + WS_X) + (size_t)hb * MS * DM, rep ? (const float*)(ws + WS_CTL) : modf + (size_t)L * 5 * MODROW + 5 * DM, DM, rep ? 0 : MODROW, 1.0f / KREP_W2, hb * (MS / 256)};
            pg8::gemm_phase<pg8::EpiRes, pg8::GroupOrder, GEMM_ALIGN, GEMM_SP2>(lds + RING_OFF, g, S, E);
            SEAM(); } }
        }
    }
    if (EN_NORM && PH(N_PHASE_IDS - 1)) final_norm_phase();
#undef PH
#undef SEAM
}

extern "C" void kernel_launch(void* const* d_in, const int* in_sizes, int n_in, void* d_out, int out_size, void* d_ws, size_t ws_size, hipStream_t stream) {
    static int grid = 0;
    if (grid == 0) {
        if (n_in != 28 || in_sizes[0] != NPROMPT * DM || (size_t)out_size != OUT_END || ws_size < WS_END) {
            fprintf(stderr, "kernel_launch: built for 28 inputs, out of %zu floats, >= %zu bytes of workspace; got n_in %d, in0 %d, out %d, ws %zu; nothing launched\n", (size_t)OUT_END, (size_t)WS_END, n_in, n_in > 0 ? in_sizes[0] : -1, out_size, ws_size); grid = -1; return; }
        int dev = 0, cus = 0, per_cu = 0;
        if (hipGetDevice(&dev) != hipSuccess || hipDeviceGetAttribute(&cus, hipDeviceAttributeMultiprocessorCount, dev) != hipSuccess) { fprintf(stderr, "kernel_launch: device query failed\n"); grid = -1; return; }
        if (hipFuncSetAttribute((const void*)mk_fwd, hipFuncAttributeMaxDynamicSharedMemorySize, LDS_BYTES) != hipSuccess) { fprintf(stderr, "kernel_launch: hipFuncSetAttribute failed\n"); grid = -1; return; }
        if (hipOccupancyMaxActiveBlocksPerMultiprocessor(&per_cu, (const void*)mk_fwd, NWAVES * 64, LDS_BYTES) != hipSuccess || per_cu < 1)
            fprintf(stderr, "kernel_launch: note: the occupancy query reports %d workgroups per CU\n", per_cu);
        (void)hipGetLastError();
        grid = cus;
    }
    if (grid < 0) return;
    if (hipMemsetAsync((char*)d_ws + WS_CTL, 0, CTL_ZERO_BYTES, stream) != hipSuccess) { fprintf(stderr, "kernel_launch: hipMemsetAsync failed\n"); return; }
    Args a{};
    for (int i = 0; i < 28; ++i) a.in[i] = (const float*)d_in[i];
    a.out = (float*)d_out; a.ws = (unsigned char*)d_ws;
#if MK_MULTI
    for (int id = 0; id < N_PHASE_IDS; ++id) {
        if (id >= 2 && id < N_PHASE_IDS - 1) { const int L = (id - 2) / 9, slot = (id - 2) % 9; if ((slot == 3 || slot == 4) && (L % 3) != 2) continue; }
        a.ph_lo = id; a.ph_hi = id + 1;
        hipLaunchKernelGGL(mk_fwd, dim3(grid), dim3(NWAVES * 64), LDS_BYTES, stream, a);
    }
#else
    a.ph_lo = 0; a.ph_hi = N_PHASE_IDS;
    hipLaunchKernelGGL(mk_fwd, dim3(grid), dim3(NWAVES * 64), LDS_BYTES, stream, a);
#endif
    const hipError_t le = hipPeekAtLastError();
    if (le != hipSuccess) fprintf(stderr, "kernel_launch: launch failed: %s\n", hipGetErrorName(le));
}
```

```cpp
#include <hip/hip_runtime.h>
#include <cstdio>
#include <cstdint>
namespace pg8 {
#define PG8_LAS __attribute__((address_space(3)))
typedef unsigned short bf16_t;
typedef short bf16x8 __attribute__((ext_vector_type(8)));
typedef float f32x4 __attribute__((ext_vector_type(4)));
typedef unsigned u32x4 __attribute__((ext_vector_type(4)));
constexpr int BM = 256, BK = 64, HALF = 128, HTB = HALF * BK * 2  , STAGE_BYTES = 8 * HTB, NXCD = 8, WGM = 8;

__host__ __device__ __forceinline__ int lds_byte(int r, int c) { const int st = (r >> 4) * 2 + (c >> 5), rr = r & 15, cc = c & 31, ob = rr * 64 + cc * 2; return st * 1024 + (ob ^ (((ob >> 9) & 1) << 5)); }
__host__ __device__ __forceinline__ void stage_rc(int b, int& R, int& C) { const int st = b / 1024, sb = b % 1024, swz = sb ^ (((sb >> 9) & 1) << 5); R = (st >> 1) * 16 + swz / 64; C = (st & 1) * 32 + (swz % 64) / 2; }
__host__ __device__ __forceinline__ int perm32(int rho) { const int n = rho >> 4, i = rho & 15; return 8 * (i >> 2) + 4 * n + (i & 3); }

struct Unit { int pm, pn; };
struct Gemm { const bf16_t* A; const bf16_t* Bt; int M, N, K, krep; };

struct StaticOrder {
    int nM, nN, nwg, G, c;
    __host__ __device__ void init(int M, int N, int G_, int c_) { nM = M / BM; nN = N / BM; nwg = nM * nN; G = G_; c = c_; }
    __host__ __device__ bool next(int i, Unit& u) const {
        const long L = (long)i * G + c; if (L >= nwg) return false;
        int wgid = (int)L; { const int q = nwg / NXCD, r = nwg % NXCD, xcd = wgid % NXCD, off = wgid / NXCD; wgid = (xcd < r ? xcd * (q + 1) : r * (q + 1) + (xcd - r) * q) + off; }
        const int nig = WGM * nN, gid = wgid / nig, fm = gid * WGM, gsz = (nM - fm) < WGM ? (nM - fm) : WGM;
        u.pm = fm + ((wgid % nig) % gsz); u.pn = (wgid % nig) / gsz; return true;
    }
    __device__ __forceinline__ void a_ready(const Unit&) const {}
    __device__ __forceinline__ void done(const Unit&) const {}
};

struct GroupOrder {
    int nM, nN, nwg, G, c, wgm, split, base0, base1, nx, split2, base2;
    __host__ __device__ void init(int nM_, int N, int G_, int c_, int wgm_, int split_, int base0_, int base1_, int nx_, int split2_ = 1 << 30, int base2_ = 0) { nx = nx_; split2 = split2_; base2 = base2_; nM = nM_; nN = N / BM; nwg = nM * nN; G = G_; c = c_; wgm = wgm_; split = split_; base0 = base0_; base1 = base1_; }
    __host__ __device__ bool next(int i, Unit& u) const {
        const long L = (long)i * G + c; if (L >= nwg) return false;
        int wgid = (int)L; if (nx > 1) { const int q = nwg / nx, r = nwg % nx, xcd = wgid % nx, off = wgid / nx; wgid = (xcd < r ? xcd * (q + 1) : r * (q + 1) + (xcd - r) * q) + off; }
        const int nig = wgm * nN, gid = wgid / nig, fm = gid * wgm, gsz = (nM - fm) < wgm ? (nM - fm) : wgm;
        const int pl = fm + ((wgid % nig) % gsz); u.pn = (wgid % nig) / gsz; u.pm = pl < split ? base0 + pl : pl < split2 ? base1 + (pl - split) : base2 + (pl - split2); return true;
    }
    __device__ __forceinline__ void a_ready(const Unit&) const {}
    __device__ __forceinline__ void done(const Unit&) const {}
};
#ifndef EPI_NT
#define EPI_NT 0
#endif
#ifndef EPI_REP
#define EPI_REP 1
#endif
__device__ __forceinline__ unsigned cvt_pk_bf16(float lo, float hi) { unsigned r; asm volatile("v_cvt_pk_bf16_f32 %0, %1, %2" : "=v"(r) : "v"(lo), "v"(hi)); return r; }
__device__ __forceinline__ int cond_of_tile(int pm) { return pm < 32 ? 0 : 1 + ((pm - 32) >> 3); }

struct EpiBf16 {
    static constexpr bool PERM = true, AFTER_DRAIN = false;
    bf16_t* O; int ldc; int act; float scale; int zf;
    __device__ __forceinline__ void operator()(const f32x4 (&acc)[2][2][4][2], const Unit& u, int wr, int wc, int fr, int fq) const {
        const int row0 = u.pm * BM + wr * 64 + fr, col0 = u.pn * BM + wc * 32 + 8 * fq;
        const f32x4 z4 = (f32x4){0.f, 0.f, 0.f, 0.f};
        if (zf && u.pn >= 8) {
            const int zc0 = 2048 + (u.pn - 8) * HALF + wc * 32 + 8 * fq;
#pragma unroll
            for (int ai = 0; ai < 2; ++ai)
#pragma unroll
                for (int m = 0; m < 4; ++m) { const f32x4 v0 = acc[ai][0][m][0] * acc[ai][1][m][0], v1 = acc[ai][0][m][1] * acc[ai][1][m][1];
                    u32x4 w; w.x = cvt_pk_bf16(v0[0], v0[1]); w.y = cvt_pk_bf16(v0[2], v0[3]); w.z = cvt_pk_bf16(v1[0], v1[1]); w.w = cvt_pk_bf16(v1[2], v1[3]);
                    *(u32x4*)(O + (size_t)(row0 + ai * HALF + m * 16) * ldc + zc0) = w; }
            return; }
        for (int erep = 0; erep < (act ? EPI_REP : 1); ++erep) {
        asm volatile("" ::: "memory");
#pragma unroll
        for (int ai = 0; ai < 2; ++ai)
#pragma unroll
            for (int m = 0; m < 4; ++m) { bf16_t* rowp = O + (size_t)(row0 + ai * HALF + m * 16) * ldc + col0;
#pragma unroll
                for (int bj = 0; bj < 2; ++bj) { f32x4 v0 = acc[ai][bj][m][0] * scale, v1 = acc[ai][bj][m][1] * scale;
                    if (act) { v0 = __builtin_elementwise_max(v0, z4); v1 = __builtin_elementwise_max(v1, z4); v0 = v0 * v0; v1 = v1 * v1; }
                    u32x4 w; w.x = cvt_pk_bf16(v0[0], v0[1]); w.y = cvt_pk_bf16(v0[2], v0[3]); w.z = cvt_pk_bf16(v1[0], v1[1]); w.w = cvt_pk_bf16(v1[2], v1[3]);
                    if (EPI_NT) __builtin_nontemporal_store(w, (u32x4*)(rowp + bj * HALF)); else *(u32x4*)(rowp + bj * HALF) = w; } }
        }
    }
};
struct EpiRes {
    static constexpr bool PERM = true, AFTER_DRAIN = false;
    bf16_t* X; const float* gate; int ldx; int gstride; float scale; int pm0;
    __device__ __forceinline__ void operator()(const f32x4 (&acc)[2][2][4][2], const Unit& u, int wr, int wc, int fr, int fq) const {
        const float* g = gate + (size_t)cond_of_tile(u.pm + pm0) * gstride;
        const int row0 = u.pm * BM + wr * 64 + fr, col0 = u.pn * BM + wc * 32 + 8 * fq;
        f32x4 gv[2][2];
#pragma unroll
        for (int bj = 0; bj < 2; ++bj)
#pragma unroll
            for (int n = 0; n < 2; ++n) gv[bj][n] = *(const f32x4*)(g + col0 + bj * HALF + 4 * n) * scale;
#pragma unroll
        for (int ai = 0; ai < 2; ++ai) {
            u32x4 old[4][2];
#pragma unroll
            for (int m = 0; m < 4; ++m)
#pragma unroll
                for (int bj = 0; bj < 2; ++bj) old[m][bj] = *(const u32x4*)(X + (size_t)(row0 + ai * HALF + m * 16) * ldx + col0 + bj * HALF);
#pragma unroll
            for (int m = 0; m < 4; ++m) { bf16_t* rowp = X + (size_t)(row0 + ai * HALF + m * 16) * ldx + col0;
#pragma unroll
                for (int bj = 0; bj < 2; ++bj) { const u32x4 o = old[m][bj]; const f32x4 a0 = acc[ai][bj][m][0], a1 = acc[ai][bj][m][1]; const f32x4 g0 = gv[bj][0], g1 = gv[bj][1];
                    u32x4 w;
                    w.x = cvt_pk_bf16(__uint_as_float(o.x << 16) + g0[0] * a0[0], __uint_as_float(o.x & 0xffff0000u) + g0[1] * a0[1]);
                    w.y = cvt_pk_bf16(__uint_as_float(o.y << 16) + g0[2] * a0[2], __uint_as_float(o.y & 0xffff0000u) + g0[3] * a0[3]);
                    w.z = cvt_pk_bf16(__uint_as_float(o.z << 16) + g1[0] * a1[0], __uint_as_float(o.z & 0xffff0000u) + g1[1] * a1[1]);
                    w.w = cvt_pk_bf16(__uint_as_float(o.w << 16) + g1[2] * a1[2], __uint_as_float(o.w & 0xffff0000u) + g1[3] * a1[3]);
                    *(u32x4*)(rowp + bj * HALF) = w; } }
            asm volatile("" ::: "memory"); }
    }
};

template <class Epi, class Sched, bool ALIGN_EPI = false, bool SP2 = false>
__device__ __forceinline__ void gemm_phase(PG8_LAS unsigned char* lds, const Gemm g, const Sched& S, const Epi& E) {
    int tid_l = threadIdx.x; asm volatile("" : "+v"(tid_l));
    const int tid = tid_l, wid = __builtin_amdgcn_readfirstlane(tid >> 6), lane = tid & 63, wr = wid >> 2, wc = wid & 3, fr = lane & 15, fq = lane >> 4;
    const int K = g.K, nt = K / BK, ntt = nt * g.krep;
    unsigned voffA[2], voffB[2];
#pragma unroll
    for (int i = 0; i < 2; ++i) { int R, C; stage_rc(tid * 16 + i * 8192, R, C); const int Rb = Epi::PERM ? ((R & ~31) + perm32(R & 31)) : R;
        voffA[i] = (unsigned)(R * K + C) * 2u; voffB[i] = (unsigned)(Rb * K + C) * 2u; }
    const size_t kstep = (size_t)(BK * 2);
    const size_t hstep = (size_t)HALF * K * 2;
    const size_t tstep = 2 * hstep;
    const unsigned ldsw = (unsigned)wid * 1024u;
    const int aoff = lds_byte(wr * 64 + fr, fq * 8), boff = lds_byte(wc * 32 + fr, fq * 8);
#define PG8_SA(b, h) (((b) * 2 + (h)) * HTB)
#define PG8_SB(b, h) ((4 + (b) * 2 + (h)) * HTB)
#define PG8_STAGE(bufoff, gbase, voff) do { _Pragma("unroll") for (int _i = 0; _i < 2; ++_i) \
        __builtin_amdgcn_global_load_lds((const unsigned*)((const char*)(gbase) + (voff)[_i]), (PG8_LAS unsigned*)(lds + (bufoff) + ldsw + _i * 8192), 16, 0, 0); } while (0)
#define PG8_LDA(dst, b, h) do { _Pragma("unroll") for (int m = 0; m < 4; ++m) _Pragma("unroll") for (int k = 0; k < 2; ++k) dst[m][k] = *(const PG8_LAS bf16x8*)(lds + PG8_SA(b, h) + aoff + m * 2048 + k * 1024); } while (0)
#define PG8_LDB(dst, b, h) do { _Pragma("unroll") for (int n = 0; n < 2; ++n) _Pragma("unroll") for (int k = 0; k < 2; ++k) dst[n][k] = *(const PG8_LAS bf16x8*)(lds + PG8_SB(b, h) + boff + n * 2048 + k * 1024); } while (0)
#define PG8_MMA(ai, bj, At, Bt) do { __builtin_amdgcn_s_setprio(1); _Pragma("unroll") for (int m = 0; m < 4; ++m) _Pragma("unroll") for (int n = 0; n < 2; ++n) _Pragma("unroll") for (int k = 0; k < 2; ++k) \
        acc[ai][bj][m][n] = __builtin_amdgcn_mfma_f32_16x16x32_bf16(Bt[n][k], At[m][k], acc[ai][bj][m][n], 0, 0, 0); __builtin_amdgcn_s_setprio(0); } while (0)
#define PG8_WAIT_V(n) asm volatile("s_waitcnt vmcnt(" #n ")" ::: "memory")
#define PG8_WAIT_L(n) asm volatile("s_waitcnt lgkmcnt(" #n ")" ::: "memory")
#define PG8_BAR __builtin_amdgcn_s_barrier()
#define PG8_SCHED __builtin_amdgcn_sched_barrier(0)
    Unit cur, nxt; int ui = 0;
    if (!S.next(0, cur)) return;
    f32x4 acc[2][2][4][2];
#pragma unroll
    for (int a = 0; a < 2; ++a)
#pragma unroll
        for (int b = 0; b < 2; ++b)
#pragma unroll
            for (int m = 0; m < 4; ++m)
#pragma unroll
                for (int n = 0; n < 2; ++n) acc[a][b][m][n] = (f32x4){0.f, 0.f, 0.f, 0.f};
    bf16x8 At[4][2], B0[2][2], B1[2][2];
    const char* cA = (const char*)g.A + (size_t)cur.pm * tstep; const char* cB = (const char*)g.Bt + (size_t)cur.pn * tstep;
    S.a_ready(cur);
    if constexpr (SP2) {
        PG8_STAGE(PG8_SB(0, 0), cB, voffB); PG8_STAGE(PG8_SB(0, 1), cB + hstep, voffB); PG8_STAGE(PG8_SA(0, 0), cA, voffA); PG8_STAGE(PG8_SA(0, 1), cA + hstep, voffA);
        if (wr == 1) PG8_BAR;
        PG8_WAIT_V(2); PG8_BAR;
        PG8_STAGE(PG8_SB(1, 0), cB + kstep, voffB); PG8_STAGE(PG8_SA(1, 0), cA + kstep, voffA); PG8_STAGE(PG8_SB(1, 1), cB + hstep + kstep, voffB);
        PG8_WAIT_V(6); PG8_BAR;
    } else {
        PG8_STAGE(PG8_SB(0, 0), cB, voffB); PG8_STAGE(PG8_SA(0, 0), cA, voffA); PG8_STAGE(PG8_SB(0, 1), cB + hstep, voffB); PG8_STAGE(PG8_SA(0, 1), cA + hstep, voffA);
        if (wr == 1) PG8_BAR;
        PG8_WAIT_V(4); PG8_BAR;
        PG8_STAGE(PG8_SB(1, 0), cB + kstep, voffB); PG8_STAGE(PG8_SA(1, 0), cA + kstep, voffA); PG8_STAGE(PG8_SB(1, 1), cB + hstep + kstep, voffB);
        PG8_WAIT_V(6); PG8_BAR;
    }
    for (;;) {
        const bool has_next = S.next(ui + 1, nxt);
        const char* nA = has_next ? (const char*)g.A + (size_t)nxt.pm * tstep : cA; const char* nB = has_next ? (const char*)g.Bt + (size_t)nxt.pn * tstep : cB;
        for (int t = 0, tm = 0; t < ntt; t += 2, tm = (tm + 2 == nt ? 0 : tm + 2)) {
            const bool last = (t == ntt - 2); const int tm2 = (tm + 2 == nt) ? 0 : tm + 2;
            const char* a1 = cA + (size_t)(tm + 1) * kstep;
            const char* a2 = last ? nA : cA + (size_t)tm2 * kstep; const char* b2 = last ? nB : cB + (size_t)tm2 * kstep;
            const char* a3 = a2 + kstep; const char* b3 = b2 + kstep;
            if (last && has_next) S.a_ready(nxt);
            if constexpr (SP2) {
            PG8_LDB(B0, 0, 0); PG8_LDB(B1, 0, 1); PG8_SCHED; PG8_LDA(At, 0, 0); PG8_STAGE(PG8_SA(1, 1), a1 + hstep, voffA);
            PG8_WAIT_V(8); PG8_WAIT_L(0); PG8_BAR; PG8_MMA(0, 0, At, B0); PG8_MMA(0, 1, At, B1); PG8_BAR; PG8_SCHED;
            PG8_LDA(At, 0, 1); PG8_STAGE(PG8_SB(0, 0), b2, voffB); PG8_STAGE(PG8_SB(0, 1), b2 + hstep, voffB); PG8_STAGE(PG8_SA(0, 0), a2, voffA);
            PG8_WAIT_V(8); PG8_WAIT_L(0); PG8_BAR; PG8_MMA(1, 0, At, B0); PG8_MMA(1, 1, At, B1); PG8_BAR; PG8_SCHED;
            PG8_LDB(B0, 1, 0); PG8_LDB(B1, 1, 1); PG8_SCHED; PG8_LDA(At, 1, 0); PG8_STAGE(PG8_SA(0, 1), a2 + hstep, voffA);
            PG8_WAIT_V(8); PG8_WAIT_L(0); PG8_BAR; PG8_MMA(0, 0, At, B0); PG8_MMA(0, 1, At, B1); PG8_BAR; PG8_SCHED;
            PG8_LDA(At, 1, 1); PG8_STAGE(PG8_SB(1, 0), b3, voffB); PG8_STAGE(PG8_SB(1, 1), b3 + hstep, voffB); PG8_STAGE(PG8_SA(1, 0), a3, voffA);
            PG8_WAIT_V(8); PG8_WAIT_L(0); PG8_BAR; PG8_MMA(1, 0, At, B0); PG8_MMA(1, 1, At, B1); PG8_BAR; PG8_SCHED;
            } else {
            PG8_LDB(B0, 0, 0); PG8_SCHED; PG8_LDA(At, 0, 0); PG8_STAGE(PG8_SA(1, 1), a1 + hstep, voffA);
            PG8_WAIT_L(8); PG8_BAR; PG8_WAIT_L(0); PG8_MMA(0, 0, At, B0); PG8_BAR; PG8_SCHED;
            PG8_LDB(B1, 0, 1); PG8_STAGE(PG8_SB(0, 0), b2, voffB);
            PG8_BAR; PG8_WAIT_L(0); PG8_MMA(0, 1, At, B1); PG8_BAR;
            PG8_LDA(At, 0, 1); PG8_STAGE(PG8_SA(0, 0), a2, voffA);
            PG8_BAR; PG8_WAIT_L(0); PG8_MMA(1, 0, At, B0); PG8_BAR; PG8_SCHED;
            PG8_STAGE(PG8_SB(0, 1), b2 + hstep, voffB);
            PG8_WAIT_V(6); PG8_BAR; PG8_MMA(1, 1, At, B1); PG8_BAR;
            PG8_LDB(B0, 1, 0); PG8_SCHED; PG8_LDA(At, 1, 0); PG8_STAGE(PG8_SA(0, 1), a2 + hstep, voffA);
            PG8_WAIT_L(8); PG8_BAR; PG8_WAIT_L(0); PG8_MMA(0, 0, At, B0); PG8_BAR; PG8_SCHED;
            PG8_LDB(B1, 1, 1); PG8_STAGE(PG8_SB(1, 0), b3, voffB);
            PG8_BAR; PG8_WAIT_L(0); PG8_MMA(0, 1, At, B1); PG8_BAR;
            PG8_LDA(At, 1, 1); PG8_STAGE(PG8_SA(1, 0), a3, voffA);
            PG8_BAR; PG8_WAIT_L(0); PG8_MMA(1, 0, At, B0); PG8_BAR; PG8_SCHED;
            PG8_STAGE(PG8_SB(1, 1), b3 + hstep, voffB);
            PG8_WAIT_V(6); PG8_BAR; PG8_MMA(1, 1, At, B1); PG8_BAR;
            }
        }
        if constexpr (ALIGN_EPI) { if (wr == 0) PG8_BAR; }
        if constexpr (!Epi::AFTER_DRAIN) { E(acc, cur, wr, wc, fr, fq); S.done(cur); }
        if (!has_next) break;
#pragma unroll
        for (int a = 0; a < 2; ++a)
#pragma unroll
            for (int b = 0; b < 2; ++b)
#pragma unroll
                for (int m = 0; m < 4; ++m)
#pragma unroll
                    for (int n = 0; n < 2; ++n) acc[a][b][m][n] = (f32x4){0.f, 0.f, 0.f, 0.f};
        cur = nxt; cA = nA; cB = nB; ++ui;
        if constexpr (ALIGN_EPI) { if (wr == 1) PG8_BAR; }
    }
    PG8_WAIT_V(0);
    if constexpr (!ALIGN_EPI) { if (wr == 0) PG8_BAR; }
    PG8_BAR;
    if constexpr (Epi::AFTER_DRAIN) { E.fused(acc, cur, wr, wc, fr, fq, lds, wid, lane); S.done(cur); }
#undef PG8_SA
#undef PG8_SB
#undef PG8_STAGE
#undef PG8_LDA
#undef PG8_LDB
#undef PG8_MMA
#undef PG8_WAIT_V
#undef PG8_WAIT_L
#undef PG8_BAR
#undef PG8_SCHED
}
}
namespace att {
#define ATT_LAS __attribute__((address_space(3)))
typedef unsigned short bf16_t;
using bf16x8 = __attribute__((ext_vector_type(8))) short;
using s16x4  = __attribute__((ext_vector_type(4))) short;
using f32x16 = __attribute__((ext_vector_type(16))) float;
using f32x4  = __attribute__((ext_vector_type(4))) float;
using u32x4  = __attribute__((ext_vector_type(4))) unsigned;
constexpr int NW = 8, QBLK = 32, KVBLK = 64;
constexpr int LDQ = 3072, LDKV = 4096, LDO = 2048, LDKPE = 64;
constexpr float SCALE = 0.07216878364870322f;
constexpr float THR = 8.f;
constexpr int SHM_V = KVBLK * 128 * 2, SHM_KN = KVBLK * 128 * 2, SHM_KP = KVBLK * 64 * 2;
constexpr int NVB = 3, NKB = 2;
constexpr int OFF_V = 0, OFF_KN = NVB * SHM_V, OFF_KP = OFF_KN + NKB * SHM_KN, OFF_WS = OFF_KP + NKB * SHM_KP, LDS_BYTES = OFF_WS + NW * 64 * 4;
#define ATT_KNSWZ(row, colB) ((row) * 256 + ((colB) ^ (((row) & 7) << 4)))
#define ATT_KPSWZ(row, colB) ((row) * 128 + ((colB) ^ (((row) & 7) << 4)))
#define ATT_SBAR() __builtin_amdgcn_sched_barrier(0)
__device__ __forceinline__ int crow(int r, int hi) { return (r & 3) + 8 * (r >> 2) + 4 * hi; }
__device__ __forceinline__ unsigned cvtpk(float lo, float hi) { unsigned r; asm volatile("v_cvt_pk_bf16_f32 %0, %1, %2" : "=v"(r) : "v"(lo), "v"(hi)); return r; }
__device__ __forceinline__ float bf2f(short s) { return __uint_as_float(((unsigned)(unsigned short)s) << 16); }

__device__ __forceinline__ void partialSM(f32x16& p0, f32x16& p1, float& m_reg, float& mn, float& alpha) {
  constexpr float C = SCALE * 1.4426950408889634f;
  float pmax = p0[0];
#pragma unroll
  for (int r = 1; r < 16; ++r) pmax = fmaxf(pmax, p0[r]);
#pragma unroll
  for (int r = 0; r < 16; ++r) pmax = fmaxf(pmax, p1[r]);
  { auto rr = __builtin_amdgcn_permlane32_swap(__float_as_uint(pmax), __float_as_uint(pmax), false, false);
    pmax = fmaxf(__uint_as_float(rr[0]), __uint_as_float(rr[1])); }
  if (__builtin_expect(__all(pmax - m_reg <= THR / SCALE), 1)) { mn = m_reg; alpha = 1.f; }
  else { mn = fmaxf(m_reg, pmax); alpha = __builtin_amdgcn_exp2f((m_reg - mn) * C); m_reg = mn; }
  float mnC = -mn * C;
#pragma unroll
  for (int r = 0; r < 16; ++r) p0[r] = fmaf(p0[r], C, mnC);
#pragma unroll
  for (int r = 0; r < 16; ++r) p1[r] = fmaf(p1[r], C, mnC);
#pragma unroll
  for (int r = 0; r < 16; ++r) p0[r] = __builtin_amdgcn_exp2f(p0[r]);
}
__device__ __forceinline__ void finishSM(f32x16& p0, f32x16& p1, float alpha, float& l_reg, bf16x8& pa0, bf16x8& pa1, bf16x8& pa2, bf16x8& pa3) {
#pragma unroll
  for (int r = 0; r < 16; ++r) p1[r] = __builtin_amdgcn_exp2f(p1[r]);
  float ps = 0;
#pragma unroll
  for (int r = 0; r < 16; ++r) ps += p0[r];
#pragma unroll
  for (int r = 0; r < 16; ++r) ps += p1[r];
  { auto rr = __builtin_amdgcn_permlane32_swap(__float_as_uint(ps), __float_as_uint(ps), false, false);
    ps = __uint_as_float(rr[0]) + __uint_as_float(rr[1]); }
  l_reg = l_reg * alpha + ps;
#define ATT_PK4(P, BASE, OUT) do { unsigned a0 = cvtpk(P[BASE + 0], P[BASE + 1]), a1 = cvtpk(P[BASE + 2], P[BASE + 3]);   \
    unsigned b0 = cvtpk(P[BASE + 4], P[BASE + 5]), b1 = cvtpk(P[BASE + 6], P[BASE + 7]);                              \
    auto r0 = __builtin_amdgcn_permlane32_swap(a0, b0, false, false); auto r1 = __builtin_amdgcn_permlane32_swap(a1, b1, false, false); \
    u32x4 w = {r0[0], r1[0], r0[1], r1[1]}; OUT = __builtin_bit_cast(bf16x8, w); } while (0)
  ATT_PK4(p0, 0, pa0); ATT_PK4(p0, 8, pa1); ATT_PK4(p1, 0, pa2); ATT_PK4(p1, 8, pa3);
#undef ATT_PK4
}
__device__ __forceinline__ void qkt(f32x16& p0, f32x16& p1, const ATT_LAS char* Kn, const ATT_LAS char* Kp, const bf16x8 (&qr)[12], int r32, int hi) {
  p0 = f32x16{}; p1 = f32x16{};
#pragma unroll
  for (int d0 = 0; d0 < 8; ++d0) { const int cb = (d0 * 16 + hi * 8) * 2;
    const bf16x8 b0 = *reinterpret_cast<const ATT_LAS bf16x8*>(Kn + ATT_KNSWZ(r32, cb));
    const bf16x8 b1 = *reinterpret_cast<const ATT_LAS bf16x8*>(Kn + ATT_KNSWZ(32 + r32, cb));
    p0 = __builtin_amdgcn_mfma_f32_32x32x16_bf16(b0, qr[d0], p0, 0, 0, 0);
    p1 = __builtin_amdgcn_mfma_f32_32x32x16_bf16(b1, qr[d0], p1, 0, 0, 0);
    if ((d0 & 3) == 3) ATT_SBAR(); }
#pragma unroll
  for (int d0 = 8; d0 < 12; ++d0) { const int cb = ((d0 - 8) * 16 + hi * 8) * 2;
    const bf16x8 b0 = *reinterpret_cast<const ATT_LAS bf16x8*>(Kp + ATT_KPSWZ(r32, cb));
    const bf16x8 b1 = *reinterpret_cast<const ATT_LAS bf16x8*>(Kp + ATT_KPSWZ(32 + r32, cb));
    p0 = __builtin_amdgcn_mfma_f32_32x32x16_bf16(b0, qr[d0], p0, 0, 0, 0);
    p1 = __builtin_amdgcn_mfma_f32_32x32x16_bf16(b1, qr[d0], p1, 0, 0, 0); }
}
__device__ __forceinline__ int v_st(int k, int c) { const int kk = (k & ~0xC) | ((k & 4) << 1) | ((k & 8) >> 1); return ((kk >> 3) * 4 + (c >> 5)) * 512 + ((kk & 7) * 32 + (c & 31)) * 2; }
__device__ __forceinline__ int v_rd_base(int lane) { return ((lane & 3) << 3) | (((lane >> 2) & 3) << 6) | (((lane >> 4) & 1) << 5) | (((lane >> 5) & 1) << 8); }
constexpr int v_rd_off(int d0, int ks, int half) { return d0 * 512 + ks * 4096 + half * 2048; }
template <int OFF> __device__ __forceinline__ s16x4 tr_read(int vb) {
  s16x4 r; asm volatile("ds_read_b64_tr_b16 %0, %1 offset:%2" : "=&v"(r) : "v"(vb), "i"(OFF) : "memory"); return r;
}
template <int D0> __device__ __forceinline__ void pv_one(f32x16& od, int vb, bf16x8 pa0, bf16x8 pa1, bf16x8 pa2, bf16x8 pa3) {
  const s16x4 l0 = tr_read<v_rd_off(D0, 0, 0)>(vb), h0 = tr_read<v_rd_off(D0, 0, 1)>(vb), l1 = tr_read<v_rd_off(D0, 1, 0)>(vb), h1 = tr_read<v_rd_off(D0, 1, 1)>(vb);
  const s16x4 l2 = tr_read<v_rd_off(D0, 2, 0)>(vb), h2 = tr_read<v_rd_off(D0, 2, 1)>(vb), l3 = tr_read<v_rd_off(D0, 3, 0)>(vb), h3 = tr_read<v_rd_off(D0, 3, 1)>(vb);
  asm volatile("s_waitcnt lgkmcnt(0)" ::: "memory"); ATT_SBAR();
#define ATT_PK(L, H) (bf16x8){L[0], L[1], L[2], L[3], H[0], H[1], H[2], H[3]}
  od = __builtin_amdgcn_mfma_f32_32x32x16_bf16(pa0, ATT_PK(l0, h0), od, 0, 0, 0);
  od = __builtin_amdgcn_mfma_f32_32x32x16_bf16(pa1, ATT_PK(l1, h1), od, 0, 0, 0);
  od = __builtin_amdgcn_mfma_f32_32x32x16_bf16(pa2, ATT_PK(l2, h2), od, 0, 0, 0);
  od = __builtin_amdgcn_mfma_f32_32x32x16_bf16(pa3, ATT_PK(l3, h3), od, 0, 0, 0);
#undef ATT_PK
}

template <int S> __device__ __forceinline__ void qkt_h(f32x16& p, const ATT_LAS char* Kn, const ATT_LAS char* Kp, const bf16x8 (&qr)[12], int r32, int hi) {
  p = f32x16{};
#pragma unroll
  for (int d0 = 0; d0 < 8; ++d0) { const int cb = (d0 * 16 + hi * 8) * 2;
    const bf16x8 b = *reinterpret_cast<const ATT_LAS bf16x8*>(Kn + ATT_KNSWZ(32 * S + r32, cb));
    p = __builtin_amdgcn_mfma_f32_32x32x16_bf16(b, qr[d0], p, 0, 0, 0); }
#pragma unroll
  for (int d0 = 8; d0 < 12; ++d0) { const int cb = ((d0 - 8) * 16 + hi * 8) * 2;
    const bf16x8 b = *reinterpret_cast<const ATT_LAS bf16x8*>(Kp + ATT_KPSWZ(32 * S + r32, cb));
    p = __builtin_amdgcn_mfma_f32_32x32x16_bf16(b, qr[d0], p, 0, 0, 0); }
}
__device__ __forceinline__ void partialSM_h(f32x16& p, float& m_reg, float& alpha) {
  constexpr float C = SCALE * 1.4426950408889634f;
  float pmax = p[0];
#pragma unroll
  for (int r = 1; r < 16; ++r) pmax = fmaxf(pmax, p[r]);
  { auto rr = __builtin_amdgcn_permlane32_swap(__float_as_uint(pmax), __float_as_uint(pmax), false, false);
    pmax = fmaxf(__uint_as_float(rr[0]), __uint_as_float(rr[1])); }
  float mn;
  if (__builtin_expect(__all(pmax - m_reg <= THR / SCALE), 1)) { mn = m_reg; alpha = 1.f; }
  else { mn = fmaxf(m_reg, pmax); alpha = __builtin_amdgcn_exp2f((m_reg - mn) * C); m_reg = mn; }
  const float mnC = -mn * C;
#pragma unroll
  for (int r = 0; r < 16; ++r) p[r] = fmaf(p[r], C, mnC);
#pragma unroll
  for (int r = 0; r < 8; ++r) p[r] = __builtin_amdgcn_exp2f(p[r]);
}
__device__ __forceinline__ void finishSM_h(f32x16& p, float alpha, float& l_reg, bf16x8& pa0, bf16x8& pa1) {
#pragma unroll
  for (int r = 8; r < 16; ++r) p[r] = __builtin_amdgcn_exp2f(p[r]);
  float ps = 0;
#pragma unroll
  for (int r = 0; r < 16; ++r) ps += p[r];
  { auto rr = __builtin_amdgcn_permlane32_swap(__float_as_uint(ps), __float_as_uint(ps), false, false);
    ps = __uint_as_float(rr[0]) + __uint_as_float(rr[1]); }
  l_reg = l_reg * alpha + ps;
#define ATT_PK4(P, BASE, OUT) do { unsigned a0 = cvtpk(P[BASE + 0], P[BASE + 1]), a1 = cvtpk(P[BASE + 2], P[BASE + 3]);   \
    unsigned b0 = cvtpk(P[BASE + 4], P[BASE + 5]), b1 = cvtpk(P[BASE + 6], P[BASE + 7]);                              \
    auto r0 = __builtin_amdgcn_permlane32_swap(a0, b0, false, false); auto r1 = __builtin_amdgcn_permlane32_swap(a1, b1, false, false); \
    u32x4 w = {r0[0], r1[0], r0[1], r1[1]}; OUT = __builtin_bit_cast(bf16x8, w); } while (0)
  ATT_PK4(p, 0, pa0); ATT_PK4(p, 8, pa1);
#undef ATT_PK4
}
template <int S, int D0> __device__ __forceinline__ void pv_h_one(f32x16& od, int vb, bf16x8 pa0, bf16x8 pa1) {
  const s16x4 l0 = tr_read<v_rd_off(D0, 2 * S, 0)>(vb), h0 = tr_read<v_rd_off(D0, 2 * S, 1)>(vb), l1 = tr_read<v_rd_off(D0, 2 * S + 1, 0)>(vb), h1 = tr_read<v_rd_off(D0, 2 * S + 1, 1)>(vb);
  asm volatile("s_waitcnt lgkmcnt(0)" ::: "memory"); ATT_SBAR();
#define ATT_PK(L, H) (bf16x8){L[0], L[1], L[2], L[3], H[0], H[1], H[2], H[3]}
  od = __builtin_amdgcn_mfma_f32_32x32x16_bf16(pa0, ATT_PK(l0, h0), od, 0, 0, 0);
  od = __builtin_amdgcn_mfma_f32_32x32x16_bf16(pa1, ATT_PK(l1, h1), od, 0, 0, 0);
#undef ATT_PK
}
template <int S> __device__ __forceinline__ void pv_h(f32x16 (&o)[4], int vb, bf16x8 pa0, bf16x8 pa1) {
  pv_h_one<S, 0>(o[0], vb, pa0, pa1); pv_h_one<S, 1>(o[1], vb, pa0, pa1); pv_h_one<S, 2>(o[2], vb, pa0, pa1); pv_h_one<S, 3>(o[3], vb, pa0, pa1);
}

__device__ __forceinline__ void attn_unit(ATT_LAS unsigned char* lds, const bf16_t* __restrict__ Q, const bf16_t* __restrict__ KV, const bf16_t* __restrict__ KPE,
                                          bf16_t* __restrict__ O, int nkeys, int rope, int t0, const float* __restrict__ ROPE) {
  int tid_l = threadIdx.x; asm volatile("" : "+v"(tid_l));
  const int tid = tid_l, wid = tid >> 6, lane = tid & 63, r32 = lane & 31, hi = lane >> 5;
  ATT_LAS float* wsf = (ATT_LAS float*)((ATT_LAS char*)lds + OFF_WS) + wid * 64; ATT_LAS float* li_l = wsf; ATT_LAS float* al_l = wsf + 32;
  float m_reg = -1e30f, l_reg = 0.f; f32x16 o[4] = {}; bf16x8 qr[12];
  const bf16_t* Qw = Q + (size_t)(wid * QBLK + r32) * LDQ + hi * 8;
#pragma unroll
  for (int d0 = 0; d0 < 12; ++d0) qr[d0] = *reinterpret_cast<const bf16x8*>(Qw + d0 * 16);
  if (rope) {
    const int t = t0 + wid * QBLK + r32;
#pragma unroll
    for (int hf = 0; hf < 2; ++hf) {
      const int pos = hf ? (t & 63) : (t >> 6);
      const f32x4* tp = reinterpret_cast<const f32x4*>(ROPE + (size_t)(pos * 16 + hi * 8) * 2);
      const bf16x8 a = qr[8 + 2 * hf], b = qr[9 + 2 * hf]; u32x4 na, nb;
#pragma unroll
      for (int q = 0; q < 4; ++q) { const f32x4 cs = tp[q];
        const float x1a = bf2f(a[2 * q]), x2a = bf2f(b[2 * q]), x1b = bf2f(a[2 * q + 1]), x2b = bf2f(b[2 * q + 1]);
        na[q] = cvtpk(x1a * cs[0] - x2a * cs[1], x1b * cs[2] - x2b * cs[3]);
        nb[q] = cvtpk(x1a * cs[1] + x2a * cs[0], x1b * cs[3] + x2b * cs[2]); }
      qr[8 + 2 * hf] = __builtin_bit_cast(bf16x8, na); qr[9 + 2 * hf] = __builtin_bit_cast(bf16x8, nb);
    }
  }
  const int widu = __builtin_amdgcn_readfirstlane(wid);
  unsigned oKn[2], oV[2], oKp;
#pragma unroll
  for (int i = 0; i < 2; ++i) { const int pc = 2 * widu + i;
    { const int row = pc * 4 + (lane >> 4), col = ((lane & 15) ^ (row & 7)) * 8; oKn[i] = (unsigned)(row * LDKV + col) * 2u; }
    { const int st = pc * 2 + (lane >> 5), kk = ((st >> 2) << 3) | ((lane & 31) >> 2), k = (kk & ~0xC) | ((kk & 4) << 1) | ((kk & 8) >> 1), c = (st & 3) * 32 + (lane & 3) * 8; oV[i] = (unsigned)(k * LDKV + 128 + c) * 2u; } }
  { const int row = widu * 8 + (lane >> 3), col = ((lane & 7) ^ (row & 7)) * 8; oKp = (unsigned)(row * LDKPE + col) * 2u; }
  ATT_LAS char* V_lds = (ATT_LAS char*)lds + OFF_V; ATT_LAS char* Kn_lds = (ATT_LAS char*)lds + OFF_KN; ATT_LAS char* Kp_lds = (ATT_LAS char*)lds + OFF_KP;
  const int vb0 = (int)(unsigned)(size_t)V_lds + v_rd_base(lane);
#define ATT_DMA(t, kb, vbuf) do { const char* kvt = (const char*)KV + (size_t)(t) * (KVBLK * LDKV * 2); const char* kpt = (const char*)KPE + (size_t)(t) * (KVBLK * LDKPE * 2); \
    _Pragma("unroll") for (int _i = 0; _i < 2; ++_i) { \
      __builtin_amdgcn_global_load_lds((const unsigned*)(kvt + oKn[_i]), (ATT_LAS unsigned*)(Kn_lds + (kb) * SHM_KN + (2 * widu + _i) * 1024), 16, 0, 0); \
      __builtin_amdgcn_global_load_lds((const unsigned*)(kvt + oV[_i]), (ATT_LAS unsigned*)(V_lds + (vbuf) * SHM_V + (2 * widu + _i) * 1024), 16, 0, 0); } \
    __builtin_amdgcn_global_load_lds((const unsigned*)(kpt + oKp), (ATT_LAS unsigned*)(Kp_lds + (kb) * SHM_KP + widu * 1024), 16, 0, 0); } while (0)
#define ATT_LANDED() do { asm volatile("s_waitcnt vmcnt(0)" ::: "memory"); __builtin_amdgcn_s_barrier(); asm volatile("" ::: "memory"); } while (0)
#define ATT_RESC(a) do { if (__any((a) < 1.f)) { if (hi == 0) al_l[r32] = (a); asm volatile("s_waitcnt lgkmcnt(0)" ::: "memory"); \
    _Pragma("unroll") for (int r = 0; r < 16; ++r) { const float av = al_l[crow(r, hi)]; _Pragma("unroll") for (int d = 0; d < 4; ++d) o[d][r] *= av; } } } while (0)
#define ATT_PV(vsel) do { const int vb = vb0 + (vsel) * SHM_V; pv_one<0>(o[0], vb, pa0, pa1, pa2, pa3); pv_one<1>(o[1], vb, pa0, pa1, pa2, pa3); pv_one<2>(o[2], vb, pa0, pa1, pa2, pa3); pv_one<3>(o[3], vb, pa0, pa1, pa2, pa3); } while (0)
  const int NT = nkeys / KVBLK;
#ifndef ATT_DOUBLE
#define ATT_DOUBLE 0
#endif
#if ATT_DOUBLE
  f32x16 pA, pB; float alA, alB; bf16x8 pa0, pa1;
  ATT_DMA(0, 0, 0);
  ATT_LANDED(); if (NT > 1) ATT_DMA(1, 1, 1);
  qkt_h<0>(pA, Kn_lds, Kp_lds, qr, r32, hi); partialSM_h(pA, m_reg, alA); ATT_RESC(alA);
  int kj = 0, vj = 0;
  for (int j = 0; j < NT; ++j) {
    const int vb = vb0 + vj * SHM_V;
    ATT_SBAR(); qkt_h<1>(pB, Kn_lds + kj * SHM_KN, Kp_lds + kj * SHM_KP, qr, r32, hi);
    finishSM_h(pA, alA, l_reg, pa0, pa1); ATT_SBAR();
    pv_h<0>(o, vb, pa0, pa1); partialSM_h(pB, m_reg, alB); ATT_RESC(alB);
    if (j + 1 < NT) {
      const int vn = vj == 2 ? 0 : vj + 1, vnn = vn == 2 ? 0 : vn + 1;
      ATT_LANDED(); if (j + 2 < NT) ATT_DMA(j + 2, kj, vnn);
      ATT_SBAR(); qkt_h<0>(pA, Kn_lds + (kj ^ 1) * SHM_KN, Kp_lds + (kj ^ 1) * SHM_KP, qr, r32, hi);
      finishSM_h(pB, alB, l_reg, pa0, pa1); ATT_SBAR();
      pv_h<1>(o, vb, pa0, pa1); partialSM_h(pA, m_reg, alA); ATT_RESC(alA);
      kj ^= 1; vj = vn;
    } else {
      finishSM_h(pB, alB, l_reg, pa0, pa1); ATT_SBAR();
      pv_h<1>(o, vb, pa0, pa1);
    }
  }
#else
  ATT_DMA(0, 0, 0);
  for (int j = 0; j < NT; ++j) {
    const int b = j & 1;
    ATT_LANDED(); if (j + 1 < NT) ATT_DMA(j + 1, b ^ 1, b ^ 1);
    f32x16 p0, p1; float mn, alpha; bf16x8 pa0, pa1, pa2, pa3;
    qkt(p0, p1, Kn_lds + b * SHM_KN, Kp_lds + b * SHM_KP, qr, r32, hi);
    partialSM(p0, p1, m_reg, mn, alpha);
    ATT_RESC(alpha);
    finishSM(p0, p1, alpha, l_reg, pa0, pa1, pa2, pa3); ATT_SBAR();
    ATT_PV(b);
  }
#endif
  asm volatile("s_waitcnt lgkmcnt(0)" ::: "memory"); __builtin_amdgcn_s_barrier(); asm volatile("" ::: "memory");
  if (hi == 0) li_l[r32] = l_reg;
  asm volatile("s_waitcnt lgkmcnt(0)" ::: "memory");
  bf16_t* Ow = O + (size_t)(wid * QBLK) * LDO;
#pragma unroll
  for (int r = 0; r < 16; ++r) { const int orow = crow(r, hi); const float rl = __builtin_amdgcn_rcpf(li_l[orow]);
#pragma unroll
    for (int d0 = 0; d0 < 4; ++d0) { const float v = o[d0][r] * rl; unsigned u = __float_as_uint(v); u += 0x7fffu + ((u >> 16) & 1u);
      Ow[(size_t)orow * LDO + d0 * 32 + r32] = (bf16_t)(u >> 16); } }
  asm volatile("s_waitcnt lgkmcnt(0)" ::: "memory");
#undef ATT_DMA
#undef ATT_LANDED
#undef ATT_RESC
#undef ATT_PV
}
}

constexpr int NWAVES = 8;
constexpr int DM = 2048, NTOK = 16384, NPROMPT = 8192, DFF = 8192, NLAYER = 4;
constexpr int SEQ_S = 2048, PAST = 512, LKS = PAST + SEQ_S, NKVROWS = NPROMPT + 4 * LKS;
constexpr int MODROW = 6 * DM;
constexpr int KS_MOD = 16;
constexpr float EPS = 1e-6f;
#ifndef MK_MULTI
#define MK_MULTI 0
#endif

constexpr size_t MiB = 1u << 20;
constexpr size_t WS_CTL = 0, CTL_ZERO_BYTES = 524288;
constexpr size_t WS_MODF = 1 * MiB;
constexpr size_t WS_ROPE = WS_MODF + (size_t)NLAYER * 5 * MODROW * 4;
constexpr size_t WS_MODP = 2 * MiB;
constexpr size_t WS_WS = 17 * MiB;
constexpr size_t WS_MLA_A = 18 * MiB;
constexpr size_t WS_QB = 23 * MiB, WS_KVB = 26 * MiB, WS_WO = 30 * MiB;
constexpr size_t WS_GIN = 38 * MiB, WS_GOUT = 54 * MiB;
constexpr size_t WS_COUT = 62 * MiB, WS_CIN = 78 * MiB;
constexpr size_t WS_W1 = 126 * MiB, WS_W2 = 254 * MiB;
constexpr size_t WS_X = 382 * MiB;
constexpr size_t WS_H = 446 * MiB;
constexpr size_t WS_A2 = 510 * MiB;
constexpr size_t WS_HID = 574 * MiB;
constexpr size_t WS_U = 830 * MiB;
constexpr size_t WS_UV = 958 * MiB;
constexpr size_t WS_MLA = 1086 * MiB;
constexpr size_t WS_ABF = WS_MLA, WS_Q = WS_MLA + 40 * MiB, WS_QAN = WS_MLA + 136 * MiB, WS_CKV = WS_MLA + 152 * MiB, WS_KPE = WS_MLA + 170 * MiB;
constexpr size_t WS_KV = 1262 * MiB;
constexpr size_t WS_END = 1406 * MiB;
static_assert(WS_ROPE + 64 * 16 * 2 * 4 <= WS_MODP && WS_MODP + (size_t)KS_MOD * NLAYER * 5 * MODROW * 4 <= WS_WS && WS_KPE + (size_t)NKVROWS * 64 * 2 <= WS_KV, "d_ws map");
constexpr int CW_BAR = 4096;
constexpr int NCLS = 4, NSG = 8, SGSZ = 32, GROWS = NTOK / NSG;
#ifndef GRP_DELAY_US
#define GRP_DELAY_US 0
#endif
constexpr size_t OUT_Y = 0, OUT_CKV = (size_t)NTOK * DM, OUT_KPE = OUT_CKV + (size_t)NPROMPT * 512, OUT_END = OUT_KPE + (size_t)NPROMPT * 64;

constexpr int RING_OFF = 0, RING_BYTES = 131072;
constexpr int MISC_OFF = RING_BYTES;
constexpr int LDS_BYTES = 147456;
static_assert(att::LDS_BYTES <= RING_BYTES, "attention LDS");

#define GAS __attribute__((address_space(1)))
#define LAS __attribute__((address_space(3)))
typedef unsigned short bf16;
typedef unsigned v4u __attribute__((ext_vector_type(4)));
typedef unsigned v2u __attribute__((ext_vector_type(2)));
typedef float f32x4 __attribute__((ext_vector_type(4)));
typedef short bf16x8 __attribute__((ext_vector_type(8)));
#define LDS_WAIT() asm volatile("s_waitcnt lgkmcnt(0)" ::: "memory")
#define VM_WAIT() asm volatile("s_waitcnt vmcnt(0)" ::: "memory")
__device__ __forceinline__ unsigned f2bf(float f) { unsigned u = __builtin_bit_cast(unsigned, f); return (u + 0x7fffu + ((u >> 16) & 1u)) >> 16; }
__device__ __forceinline__ unsigned pk2(float lo, float hi) { return f2bf(lo) | (f2bf(hi) << 16); }
__device__ __forceinline__ float bf2f(short s) { return __uint_as_float(((unsigned)(unsigned short)s) << 16); }
__device__ __forceinline__ float wave_sum(float v) {
#pragma unroll
    for (int o = 1; o < 64; o <<= 1) v += __shfl_xor(v, o);
    return v;
}
__device__ __forceinline__ int cond_of_row(int row) { return row < NPROMPT ? 0 : 1 + ((row - NPROMPT) >> 11); }

#define XB_TMO      128
#define XB_XCNT(j)  (256  + 64 * (j))
#define XB_XSUB(j)  (1280 + 64 * (j))
#define XB_XGEN(j)  (2304 + 64 * (j))
#define XB_TOP      3328
#define XB_TOPGEN   3392
#define XCD_BAR_WORDS 3456
#define XB_SPIN_CAP (1u << 18)

__device__ __forceinline__ unsigned xb_ld(unsigned* p)              { return __hip_atomic_load(p, __ATOMIC_RELAXED, __HIP_MEMORY_SCOPE_AGENT); }
__device__ __forceinline__ unsigned xb_add(unsigned* p, unsigned v) { return __hip_atomic_fetch_add(p, v, __ATOMIC_RELAXED, __HIP_MEMORY_SCOPE_AGENT); }
__device__ __forceinline__ unsigned xb_xcc_id() { return (unsigned)__builtin_amdgcn_s_getreg((3 << 11) | 20) & 0xFu; }
#define XB_SPIN(cond, bar) do { unsigned _sp = 0; while (cond) { __builtin_amdgcn_s_sleep(1); \
    if ((++_sp & 255u) == 0u) { if (xb_ld(&(bar)[XB_TMO])) break; if (_sp > XB_SPIN_CAP) { atomicAdd(&(bar)[XB_TMO], 1u); break; } } } } while (0)

struct XcdBarrier {
    unsigned* bar; unsigned x; unsigned gsize;
    volatile LAS unsigned* st;
};

__device__ __forceinline__ XcdBarrier xcd_barrier_post(unsigned* bar, volatile LAS unsigned* st, unsigned gsize) {
    XcdBarrier b; b.bar = bar; b.x = xb_xcc_id(); b.st = st; b.gsize = gsize;
    if (threadIdx.x == 0) (void)xb_add(&bar[XB_XCNT(b.x)], 1u);
    return b;
}
__device__ __forceinline__ void xcd_barrier_complete(unsigned* bar, unsigned x, unsigned& nloc, unsigned& nx, const unsigned G) {
    unsigned sum, cnt, mine, sp = 0u;
    for (;;) {
        sum = 0u; cnt = 0u; mine = 0u;
#pragma unroll
        for (unsigned j = 0; j < 16; ++j) { const unsigned c = xb_ld(&bar[XB_XCNT(j)]); sum += c; cnt += (c > 0u) ? 1u : 0u; mine = (j == x) ? c : mine; }
        if (sum == G) break;
        __builtin_amdgcn_s_sleep(1);
        if ((++sp & 255u) == 0u) { if (xb_ld(&bar[XB_TMO])) break; if (sp > XB_SPIN_CAP) { atomicAdd(&bar[XB_TMO], 1u); break; } }
    }
    nloc = mine > 0u ? mine : 1u; nx = cnt > 0u ? cnt : 1u;
}

__device__ __forceinline__ void xcd_barrier(const XcdBarrier& b) {
    asm volatile("s_waitcnt vmcnt(0)" ::: "memory");
    __syncthreads();
    if (threadIdx.x == 0) {
        unsigned* bar = b.bar;
        __builtin_amdgcn_s_waitcnt(0);
        unsigned nloc = b.st[0], nx = b.st[1];
        if (nloc == 0u) { xcd_barrier_complete(bar, b.x, nloc, nx, b.gsize); b.st[0] = nloc; b.st[1] = nx; }
        const unsigned old = xb_add(&bar[XB_XSUB(b.x)], 1u);
        const unsigned gen = old / nloc;
        if (old + 1u == (gen + 1u) * nloc) {
            __builtin_amdgcn_fence(__ATOMIC_RELEASE, "agent");
            asm volatile("s_waitcnt vmcnt(0)" ::: "memory");
            const unsigned og = xb_add(&bar[XB_TOP], 1u);
            const unsigned tg = og / nx;
            if (og + 1u == (tg + 1u) * nx) xb_add(&bar[XB_TOPGEN], 1u);
            else XB_SPIN(xb_ld(&bar[XB_TOPGEN]) == tg, bar);
            __builtin_amdgcn_fence(__ATOMIC_ACQUIRE, "agent");
            xb_add(&bar[XB_XGEN(b.x)], 1u);
            asm volatile("s_waitcnt vmcnt(0)" ::: "memory");
        } else {
            XB_SPIN(xb_ld(&bar[XB_XGEN(b.x)]) == gen, bar);
            __builtin_amdgcn_fence(__ATOMIC_ACQUIRE, "agent");
            asm volatile("s_waitcnt vmcnt(0)" ::: "memory");
        }
    }
    __syncthreads();
}
constexpr int N_MOD = NLAYER * (MODROW / 256) * KS_MOD;
constexpr int I_CIN = (DM / 64) * (6144 / 32), I_SQ = (DM / 64) * (DM / 32), I_GIN = (DM / 64) * (4096 / 32), I_QA = (DM / 64) * (512 / 32), I_KVA = (DM / 64) * (576 / 32),
              I_QB = (512 / 64) * (3072 / 32), I_KVB = (512 / 64) * (4096 / 32), I_W1 = (DM / 64) * (DFF / 32), I_W2 = (DFF / 64) * (DM / 32);
constexpr int N_TR = 2 * I_CIN + 2 * I_SQ + I_GIN + I_SQ + I_QA + I_KVA + I_QB + I_KVB + I_SQ + 4 * I_W1 + 4 * I_W2;
constexpr int N_WSI = 512, N_ZI = 768, N_P0 = N_MOD + N_TR + N_WSI + N_ZI;

struct Ptrs {
    const float *xp, *xs, *cache_ckv, *cache_kpe, *c, *c_ctx, *ada_w, *ada_b, *norm1, *norm2, *conv_w_in, *conv_w, *conv_w_out, *gmlp_w_in, *gmlp_g_v, *gmlp_w_s, *gmlp_b_s, *gmlp_w_out,
                *mla_w_q_a, *mla_g_q, *mla_w_q_b, *mla_w_kv_a, *mla_g_kv, *mla_w_kv_b, *mla_w_o, *mlp_w1, *mlp_w2, *final_norm;
    float* out; unsigned char* ws;
};

struct Args { const float* in[28]; float* out; unsigned char* ws; int ph_lo, ph_hi; };
__device__ __forceinline__ Ptrs make_ptrs() {
    const __attribute__((address_space(4))) Args* ap = (const __attribute__((address_space(4))) Args*)__builtin_amdgcn_kernarg_segment_ptr();
    asm volatile("" : "+s"(ap));
    Ptrs P;
    P.xp = ap->in[0]; P.xs = ap->in[1]; P.cache_ckv = ap->in[2]; P.cache_kpe = ap->in[3]; P.c = ap->in[4]; P.c_ctx = ap->in[5]; P.ada_w = ap->in[6]; P.ada_b = ap->in[7];
    P.norm1 = ap->in[8]; P.norm2 = ap->in[9]; P.conv_w_in = ap->in[10]; P.conv_w = ap->in[11]; P.conv_w_out = ap->in[12]; P.gmlp_w_in = ap->in[13]; P.gmlp_g_v = ap->in[14];
    P.gmlp_w_s = ap->in[15]; P.gmlp_b_s = ap->in[16]; P.gmlp_w_out = ap->in[17]; P.mla_w_q_a = ap->in[18]; P.mla_g_q = ap->in[19]; P.mla_w_q_b = ap->in[20]; P.mla_w_kv_a = ap->in[21];
    P.mla_g_kv = ap->in[22]; P.mla_w_kv_b = ap->in[23]; P.mla_w_o = ap->in[24]; P.mlp_w1 = ap->in[25]; P.mlp_w2 = ap->in[26]; P.final_norm = ap->in[27];
    P.out = ap->out; P.ws = ap->ws;
    return P;
}
struct Ctx { int tid, lane, wave, G, bx, gw, NGW, cls, mem, li, gwl, NGWL; };
__device__ __forceinline__ Ctx make_ctx() {
    int t = threadIdx.x; asm volatile("" : "+v"(t));
    int b = blockIdx.x; asm volatile("" : "+s"(b));
    Ctx C; C.tid = t; C.lane = t & 63; C.wave = __builtin_amdgcn_readfirstlane(t >> 6); int g_ = gridDim.x; asm volatile("" : "+s"(g_)); C.G = g_; C.bx = b;
    const int vcu = (C.G % 8 == 0) ? (b % 8) * (C.G / 8) + b / 8 : b;
    C.gw = vcu * NWAVES + C.wave; C.NGW = C.G * NWAVES;
    const int x = b & 7;
    C.cls = x >> 1; C.mem = x & 1; C.li = b >> 3;
    C.gwl = C.li * NWAVES + C.wave; C.NGWL = SGSZ * NWAVES;
    return C;
}
__device__ __forceinline__ int grow(int c, int m, int r) { return 2048 * c + 1024 * m + r + (r >= 1024 ? 8192 - 1024 : 0); }

__device__ __forceinline__ void p0_transpose_item(const float* W, int K, int N, bf16* WT, int row_off, LAS float* scr, int item, int lane, bool zmap = false) {
    const int nblk = N / 32, kb = item / nblk, nb = item - kb * nblk, k0 = 64 * kb, n0 = 32 * nb;
    const int nd0 = (zmap && n0 >= 2048) ? 2048 + (((n0 - 2048) & 2047) >> 7) * 256 + ((n0 - 2048) >> 11) * 128 + (n0 & 127) : n0;
    const int lk = lane >> 3, ln = (lane & 7) * 4;
    f32x4 v[8];
#pragma unroll
    for (int i = 0; i < 8; ++i) v[i] = *(const f32x4*)(W + (size_t)(k0 + 8 * i + lk) * N + n0 + ln);
#pragma unroll
    for (int i = 0; i < 8; ++i) { LAS float* d = scr + (8 * i + lk) * 33 + ln; d[0] = v[i][0]; d[1] = v[i][1]; d[2] = v[i][2]; d[3] = v[i][3]; }
    LDS_WAIT(); asm volatile("" ::: "memory");
    const int c = lane & 7;
#pragma unroll
    for (int j = 0; j < 4; ++j) { const int n = (lane >> 3) + 8 * j; const LAS float* s = scr + (8 * c) * 33 + n;
        v4u o; o.x = pk2(s[0 * 33], s[1 * 33]); o.y = pk2(s[2 * 33], s[3 * 33]); o.z = pk2(s[4 * 33], s[5 * 33]); o.w = pk2(s[6 * 33], s[7 * 33]);
        *(v4u*)(WT + (size_t)(row_off + nd0 + n) * K + k0 + 8 * c) = o; }
    LDS_WAIT(); asm volatile("" ::: "memory");
}


__device__ __forceinline__ void p0a_phase(LAS unsigned char* lds) {
    const Ctx C = make_ctx(); const Ptrs P = make_ptrs(); const int gw = C.gw, NGW = C.NGW, tid = C.tid, wave = C.wave, lane = C.lane;
    LAS float* silu = (LAS float*)lds;
    for (int i = tid; i < 5 * DM; i += NWAVES * 64) { const int cd = i >> 11, k = i & (DM - 1); const float x = cd == 0 ? P.c_ctx[k] : P.c[(cd - 1) * DM + k]; silu[i] = x / (1.f + expf(-x)); }
    __syncthreads();
    LAS float* scr = (LAS float*)(lds + 40960 + wave * 8448);
    float* modp = (float*)(P.ws + WS_MODP);
    for (int it = gw; it < N_P0; it += NGW) {
        if (it < N_MOD) {
            const int L = it / (N_MOD / NLAYER), rem = it - L * (N_MOD / NLAYER), jb = rem / KS_MOD, ks = rem - jb * KS_MOD;
            const float* W = P.ada_w + ((size_t)L * DM + (size_t)ks * 128) * MODROW + jb * 256 + lane * 4;
            f32x4 acc[5];
#pragma unroll
            for (int cd = 0; cd < 5; ++cd) acc[cd] = (f32x4){0.f, 0.f, 0.f, 0.f};
            for (int k = 0; k < 128; k += 16) { f32x4 w[16];
#pragma unroll
                for (int i = 0; i < 16; ++i) w[i] = *(const f32x4*)(W + (size_t)(k + i) * MODROW);
#pragma unroll
                for (int i = 0; i < 16; ++i)
#pragma unroll
                    for (int cd = 0; cd < 5; ++cd) acc[cd] += w[i] * silu[cd * DM + ks * 128 + k + i]; }
#pragma unroll
            for (int cd = 0; cd < 5; ++cd) *(f32x4*)(modp + ((size_t)(ks * NLAYER + L) * 5 + cd) * MODROW + jb * 256 + lane * 4) = acc[cd];
            continue; }
        int r = it - N_MOD;
        if (r < N_TR) {
            const float* W; int K, N, ro = 0; size_t dst;
            if (r < 2 * I_CIN) { const int l = r / I_CIN; r -= l * I_CIN; W = P.conv_w_in + (size_t)l * DM * 6144; K = DM; N = 6144; dst = WS_CIN + (size_t)l * 6144 * DM * 2; }
            else if ((r -= 2 * I_CIN) < 2 * I_SQ) { const int l = r / I_SQ; r -= l * I_SQ; W = P.conv_w_out + (size_t)l * DM * DM; K = DM; N = DM; dst = WS_COUT + (size_t)l * DM * DM * 2; }
            else if ((r -= 2 * I_SQ) < I_GIN) { W = P.gmlp_w_in; K = DM; N = 4096; dst = WS_GIN; }
            else if ((r -= I_GIN) < I_SQ) { W = P.gmlp_w_out; K = DM; N = DM; dst = WS_GOUT; }
            else if ((r -= I_SQ) < I_QA) { W = P.mla_w_q_a; K = DM; N = 512; dst = WS_MLA_A; }
            else if ((r -= I_QA) < I_KVA) { W = P.mla_w_kv_a; K = DM; N = 576; dst = WS_MLA_A; ro = 512; }
            else if ((r -= I_KVA) < I_QB) { W = P.mla_w_q_b; K = 512; N = 3072; dst = WS_QB; }
            else if ((r -= I_QB) < I_KVB) { W = P.mla_w_kv_b; K = 512; N = 4096; dst = WS_KVB; }
            else if ((r -= I_KVB) < I_SQ) { W = P.mla_w_o; K = DM; N = DM; dst = WS_WO; }
            else if ((r -= I_SQ) < 4 * I_W1) { const int l = r / I_W1; r -= l * I_W1; W = P.mlp_w1 + (size_t)l * DM * DFF; K = DM; N = DFF; dst = WS_W1 + (size_t)l * DFF * DM * 2; }
            else { r -= 4 * I_W1; const int l = r / I_W2; r -= l * I_W2; W = P.mlp_w2 + (size_t)l * DFF * DM; K = DFF; N = DM; dst = WS_W2 + (size_t)l * DM * DFF * 2; }
            p0_transpose_item(W, K, N, (bf16*)(P.ws + dst), ro, scr, r, lane, N == 6144);
            continue; }
        r -= N_TR;
        if (r < N_WSI) { const float* s = P.gmlp_w_s + (size_t)r * 512 + lane * 8; const f32x4 a = *(const f32x4*)s, b = *(const f32x4*)(s + 4);
            v4u o; o.x = pk2(a[0], a[1]); o.y = pk2(a[2], a[3]); o.z = pk2(b[0], b[1]); o.w = pk2(b[2], b[3]); *(v4u*)((bf16*)(P.ws + WS_WS) + (size_t)r * 512 + lane * 8) = o; continue; }
        r -= N_WSI;
        { v4u z; z.x = 0u; z.y = 0u; z.z = 0u; z.w = 0u; *(v4u*)((bf16*)(P.ws + WS_MLA_A) + (size_t)1088 * DM + (size_t)r * 512 + lane * 8) = z; }
    }
    __syncthreads();
}

__device__ __forceinline__ void sincos_d(double a, double& sn, double& cs) {
    const double k = rint(a * 0.63661977236758134308); double r = fma(-k, 1.57079632679489655800, a); r = fma(-k, 6.12323399573676603587e-17, r);
    const double r2 = r * r;
    const double s = r * (1.0 + r2 * (-1.0 / 6 + r2 * (1.0 / 120 + r2 * (-1.0 / 5040 + r2 * (1.0 / 362880 + r2 * (-1.0 / 39916800 + r2 * (1.0 / 6227020800.0 + r2 * (-1.0 / 1307674368000.0))))))));
    const double c = 1.0 + r2 * (-0.5 + r2 * (1.0 / 24 + r2 * (-1.0 / 720 + r2 * (1.0 / 40320 + r2 * (-1.0 / 3628800 + r2 * (1.0 / 479001600 + r2 * (-1.0 / 87178291200.0 + r2 * (1.0 / 20922789888000.0))))))));
    const int q = ((int)k) & 3;
    sn = q == 0 ? s : q == 1 ? c : q == 2 ? -s : -c;
    cs = q == 0 ? c : q == 1 ? -s : q == 2 ? -c : s;
}
__device__ __forceinline__ void p0b_phase() {
    const Ctx C = make_ctx(); const Ptrs P = make_ptrs(); const int gtid = C.bx * (NWAVES * 64) + C.tid, NT = C.G * NWAVES * 64;
    const float* modp = (const float*)(P.ws + WS_MODP); float* modf = (float*)(P.ws + WS_MODF);
    for (int i = gtid; i < NLAYER * 5 * MODROW; i += NT) {
        const int cidx = i & (DM - 1), lcs = i >> 11, slot = lcs % 6, lc = lcs / 6, L = lc / 5, cd = lc - 5 * L, j = slot * DM + cidx;
        float v = P.ada_b[L * MODROW + j];
#pragma unroll
        for (int ks = 0; ks < KS_MOD; ++ks) v += modp[((size_t)(ks * NLAYER + L) * 5 + cd) * MODROW + j];
        if (slot == 1) v = P.norm1[L * DM + cidx] * (1.f + v);
        if (slot == 4) v = P.norm2[L * DM + cidx] * (1.f + v);
        modf[i] = v; }
    float* rope = (float*)(P.ws + WS_ROPE);
    for (int i = gtid; i < 64 * 16; i += NT) { const int pos = i >> 4, j = i & 15;
        double inv = 1.0; for (int q = 0; q < j; ++q) inv *= 0.56234132519034908039;
        const float ang = (float)pos * (float)inv; double sn, cs; sincos_d((double)ang, sn, cs);
        rope[2 * i] = (float)cs; rope[2 * i + 1] = (float)sn; }
}

__device__ __forceinline__ void norm_phase(int L, int which, bool first) {
    const Ctx C = make_ctx(); const Ptrs P = make_ptrs(); const int gw = C.gwl, NGW = C.NGWL, lane = C.lane, cls = C.cls, mem = C.mem;
    const float* modf = (const float*)(P.ws + WS_MODF); bf16* X = (bf16*)(P.ws + WS_X); bf16* H = (bf16*)(P.ws + WS_H);
    for (int rl = gw * 8; rl < GROWS; rl += NGW * 8) { const int r0 = grow(cls, mem, rl);
        const int cd = cond_of_row(r0);
        const float* wp = modf + ((size_t)(L * 5 + cd) * 6 + (which ? 4 : 1)) * DM + lane * 8;
        const float* sp = modf + ((size_t)(L * 5 + cd) * 6 + (which ? 3 : 0)) * DM + lane * 8;
        f32x4 wv[4][2], sv[4][2];
#pragma unroll
        for (int j = 0; j < 4; ++j) { wv[j][0] = *(const f32x4*)(wp + 512 * j); wv[j][1] = *(const f32x4*)(wp + 512 * j + 4); sv[j][0] = *(const f32x4*)(sp + 512 * j); sv[j][1] = *(const f32x4*)(sp + 512 * j + 4); }
        for (int rr = 0; rr < 8; rr += 2) {
            f32x4 v[2][4][2];
            if (first) {
#pragma unroll
                for (int q = 0; q < 2; ++q) { const int row = r0 + rr + q; const float* src = (row < NPROMPT ? P.xp + (size_t)row * DM : P.xs + (size_t)(row - NPROMPT) * DM) + lane * 8;
#pragma unroll
                    for (int j = 0; j < 4; ++j) { v[q][j][0] = *(const f32x4*)(src + 512 * j); v[q][j][1] = *(const f32x4*)(src + 512 * j + 4); } }
#pragma unroll
                for (int q = 0; q < 2; ++q) { const int row = r0 + rr + q;
#pragma unroll
                    for (int j = 0; j < 4; ++j) { v4u o; o.x = pk2(v[q][j][0][0], v[q][j][0][1]); o.y = pk2(v[q][j][0][2], v[q][j][0][3]); o.z = pk2(v[q][j][1][0], v[q][j][1][1]); o.w = pk2(v[q][j][1][2], v[q][j][1][3]);
                        *(v4u*)(X + (size_t)row * DM + lane * 8 + 512 * j) = o;
                        v[q][j][0] = (f32x4){__uint_as_float(o.x << 16), __uint_as_float(o.x & 0xffff0000u), __uint_as_float(o.y << 16), __uint_as_float(o.y & 0xffff0000u)};
                        v[q][j][1] = (f32x4){__uint_as_float(o.z << 16), __uint_as_float(o.z & 0xffff0000u), __uint_as_float(o.w << 16), __uint_as_float(o.w & 0xffff0000u)}; } }
            } else { v4u o[2][4];
#pragma unroll
                for (int q = 0; q < 2; ++q) { const bf16* src = X + (size_t)(r0 + rr + q) * DM + lane * 8;
#pragma unroll
                    for (int j = 0; j < 4; ++j) o[q][j] = *(const v4u*)(src + 512 * j); }
#pragma unroll
                for (int q = 0; q < 2; ++q)
#pragma unroll
                    for (int j = 0; j < 4; ++j) {
                        v[q][j][0] = (f32x4){__uint_as_float(o[q][j].x << 16), __uint_as_float(o[q][j].x & 0xffff0000u), __uint_as_float(o[q][j].y << 16), __uint_as_float(o[q][j].y & 0xffff0000u)};
                        v[q][j][1] = (f32x4){__uint_as_float(o[q][j].z << 16), __uint_as_float(o[q][j].z & 0xffff0000u), __uint_as_float(o[q][j].w << 16), __uint_as_float(o[q][j].w & 0xffff0000u)}; } }
#pragma unroll
            for (int q = 0; q < 2; ++q) { const int row = r0 + rr + q; float ss = 0.f;
#pragma unroll
                for (int j = 0; j < 4; ++j)
#pragma unroll
                    for (int h = 0; h < 2; ++h) ss += (v[q][j][h][0] * v[q][j][h][0] + v[q][j][h][1] * v[q][j][h][1]) + (v[q][j][h][2] * v[q][j][h][2] + v[q][j][h][3] * v[q][j][h][3]);
                const float rstd = 1.0f / sqrtf(wave_sum(ss) * (1.f / DM) + EPS);
#pragma unroll
                for (int j = 0; j < 4; ++j) { const f32x4 h0 = v[q][j][0] * rstd * wv[j][0] + sv[j][0], h1 = v[q][j][1] * rstd * wv[j][1] + sv[j][1];
                    v4u o; o.x = pk2(h0[0], h0[1]); o.y = pk2(h0[2], h0[3]); o.z = pk2(h1[0], h1[1]); o.w = pk2(h1[2], h1[3]);
                    *(v4u*)(H + (size_t)row * DM + lane * 8 + 512 * j) = o; } }
        }
    }
}
__device__ __forceinline__ void final_norm_phase() {
    const Ctx C = make_ctx(); const Ptrs P = make_ptrs(); const int gw = C.gwl, NGW = C.NGWL, lane = C.lane, cls = C.cls, mem = C.mem;
    const bf16* X = (const bf16*)(P.ws + WS_X);
    f32x4 wv[4][2];
#pragma unroll
    for (int j = 0; j < 4; ++j) { wv[j][0] = *(const f32x4*)(P.final_norm + lane * 8 + 512 * j); wv[j][1] = *(const f32x4*)(P.final_norm + lane * 8 + 512 * j + 4); }
    for (int rl = gw; rl < GROWS; rl += NGW) { const int row = grow(cls, mem, rl);
        const bf16* src = X + (size_t)row * DM + lane * 8;
        v4u o[4]; f32x4 v[4][2]; float ss = 0.f;
#pragma unroll
        for (int j = 0; j < 4; ++j) o[j] = *(const v4u*)(src + 512 * j);
#pragma unroll
        for (int j = 0; j < 4; ++j) {
            v[j][0] = (f32x4){__uint_as_float(o[j].x << 16), __uint_as_float(o[j].x & 0xffff0000u), __uint_as_float(o[j].y << 16), __uint_as_float(o[j].y & 0xffff0000u)};
            v[j][1] = (f32x4){__uint_as_float(o[j].z << 16), __uint_as_float(o[j].z & 0xffff0000u), __uint_as_float(o[j].w << 16), __uint_as_float(o[j].w & 0xffff0000u)};
#pragma unroll
            for (int h = 0; h < 2; ++h) ss += (v[j][h][0] * v[j][h][0] + v[j][h][1] * v[j][h][1]) + (v[j][h][2] * v[j][h][2] + v[j][h][3] * v[j][h][3]); }
        const float rstd = 1.0f / sqrtf(wave_sum(ss) * (1.f / DM) + EPS);
        float* yo = P.out + OUT_Y + (size_t)row * DM + lane * 8;
#pragma unroll
        for (int j = 0; j < 4; ++j) { *(f32x4*)(yo + 512 * j) = v[j][0] * rstd * wv[j][0]; *(f32x4*)(yo + 512 * j + 4) = v[j][1] * rstd * wv[j][1]; }
    }
}

__device__ __forceinline__ void conv_elem_phase(int jl) {
    const Ctx C = make_ctx(); const Ptrs P = make_ptrs(); const int gw = C.gwl, NGW = C.NGWL, lane = C.lane, cls = C.cls, mem = C.mem;
    const bf16* U = (const bf16*)(P.ws + WS_U); bf16* A2 = (bf16*)(P.ws + WS_A2); const float* cw = P.conv_w + (size_t)jl * 3 * DM;
    for (int item = gw; item < (GROWS / 8) * 4; item += NGW) {
        const int s = item >> 2, cb = item & 3, r0 = grow(cls, mem, s * 8), c = cb * 512 + lane * 8;
        const int seqlen = r0 < NPROMPT ? 256 : SEQ_S, t0 = r0 & (seqlen - 1);
        float w0[8], w1[8], w2[8];
#pragma unroll
        for (int e = 0; e < 8; ++e) { w0[e] = cw[c + e]; w1[e] = cw[DM + c + e]; w2[e] = cw[2 * DM + c + e]; }
        bf16x8 zr[10], bg[8];
        const bf16x8 zero8 = {0, 0, 0, 0, 0, 0, 0, 0};
        zr[0] = (t0 == 0) ? zero8 : *(const bf16x8*)(U + (size_t)(r0 - 1) * 4096 + DM + c);
#pragma unroll
        for (int rr = 0; rr < 8; ++rr) { zr[1 + rr] = *(const bf16x8*)(U + (size_t)(r0 + rr) * 4096 + DM + c); bg[rr] = *(const bf16x8*)(U + (size_t)(r0 + rr) * 4096 + c); }
        zr[9] = (t0 + 8 == seqlen) ? zero8 : *(const bf16x8*)(U + (size_t)(r0 + 8) * 4096 + DM + c);
#pragma unroll
        for (int rr = 0; rr < 8; ++rr) { float a[8];
#pragma unroll
            for (int e = 0; e < 8; ++e) a[e] = bf2f(bg[rr][e]) * (w0[e] * bf2f(zr[rr][e]) + w1[e] * bf2f(zr[rr + 1][e]) + w2[e] * bf2f(zr[rr + 2][e]));
            v4u o; o.x = pk2(a[0], a[1]); o.y = pk2(a[2], a[3]); o.z = pk2(a[4], a[5]); o.w = pk2(a[6], a[7]);
            *(v4u*)(A2 + (size_t)(r0 + rr) * DM + c) = o; }
    }
}

__device__ __forceinline__ void gmlp_spatial_phase(LAS unsigned char* lds) {
    const Ctx C = make_ctx(); const Ptrs P = make_ptrs(); const int G = SGSZ, c = C.li, cls = C.cls, mem = C.mem;
    const int tid = C.tid, wid = tid >> 6, lane = tid & 63, r32 = lane & 31, hi = lane >> 5;
    const bf16* UV = (const bf16*)(P.ws + WS_UV); bf16* A2 = (bf16*)(P.ws + WS_A2); const bf16* WSb = (const bf16*)(P.ws + WS_WS);
    LAS float* rs = (LAS float*)(lds + 65536); LAS unsigned char* Sb = lds + 66048; constexpr int SP = 272;
    for (int u = c; u < 2 * (GROWS / 128); u += G) {
        const int n = u >> 1, hh = u & 1, R0 = grow(cls, mem, n * 128);
        for (int qq = 0; qq < 16; qq += 4) {
            v4u x[4][4];
#pragma unroll
            for (int k = 0; k < 4; ++k) { const bf16* vr = UV + (size_t)(R0 + wid * 16 + qq + k) * 4096 + DM + lane * 8;
#pragma unroll
                for (int j = 0; j < 4; ++j) x[k][j] = *(const v4u*)(vr + 512 * j); }
#pragma unroll
            for (int k = 0; k < 4; ++k) { float ss = 0.f;
#pragma unroll
                for (int j = 0; j < 4; ++j)
#pragma unroll
                    for (int e = 0; e < 4; ++e) { const float lo = __uint_as_float(x[k][j][e] << 16), hv = __uint_as_float(x[k][j][e] & 0xffff0000u); ss += lo * lo + hv * hv; }
                ss = wave_sum(ss); if (lane == 0) rs[wid * 16 + qq + k] = 1.0f / sqrtf(ss * (1.f / DM) + EPS); } }
        __syncthreads();
        const int sr = tid >> 4, sc = (tid & 15) * 8, mi = wid & 3, dh = wid >> 2;
        for (int gi = 0; gi < 8; ++gi) { const int g = hh * 8 + gi, c0 = g * 128; LAS unsigned char* Vb = lds + (gi & 1) * 32768;
            const f32x4 ga = *(const f32x4*)(P.gmlp_g_v + c0 + sc), gb = *(const f32x4*)(P.gmlp_g_v + c0 + sc + 4);
            bf16x8 xs[4];
#pragma unroll
            for (int i = 0; i < 4; ++i) xs[i] = *(const bf16x8*)(UV + (size_t)(R0 + sr + 32 * i) * 4096 + DM + c0 + sc);
#pragma unroll
            for (int i = 0; i < 4; ++i) { const int q = sr + 32 * i; const bf16x8 x = xs[i]; const float r = rs[q];
                v4u o; o.x = pk2(bf2f(x[0]) * r * ga[0], bf2f(x[1]) * r * ga[1]); o.y = pk2(bf2f(x[2]) * r * ga[2], bf2f(x[3]) * r * ga[3]);
                o.z = pk2(bf2f(x[4]) * r * gb[0], bf2f(x[5]) * r * gb[1]); o.w = pk2(bf2f(x[6]) * r * gb[2], bf2f(x[7]) * r * gb[3]);
                *(LAS v4u*)(Vb + (q >> 6) * 16384 + att::v_st(q & 63, sc)) = o; }
            bf16x8 us[4];
#pragma unroll
            for (int i = 0; i < 4; ++i) us[i] = *(const bf16x8*)(UV + (size_t)(R0 + sr + 32 * i) * 4096 + c0 + sc);
            __syncthreads();
            bf16x8 pa[2][4];
#pragma unroll
            for (int t = 0; t < 2; ++t)
#pragma unroll
                for (int s = 0; s < 4; ++s) pa[t][s] = *(const bf16x8*)(WSb + ((size_t)g * 128 + 32 * mi + r32) * 128 + 64 * t + 16 * s + 8 * hi);
            att::f32x16 od0 = {}, od1 = {};
#pragma unroll
            for (int t = 0; t < 2; ++t) { const int vb = (int)(unsigned)(size_t)Vb + t * 16384 + dh * 1024 + att::v_rd_base(lane);
                att::pv_one<0>(od0, vb, pa[t][0], pa[t][1], pa[t][2], pa[t][3]); att::pv_one<1>(od1, vb, pa[t][0], pa[t][1], pa[t][2], pa[t][3]); }
#pragma unroll
            for (int r = 0; r < 16; ++r) { const int pr = 32 * mi + att::crow(r, hi); const float bias = P.gmlp_b_s[g * 128 + pr];
                *(LAS bf16*)(Sb + pr * SP + (32 * (2 * dh) + r32) * 2) = (bf16)f2bf(od0[r] + bias);
                *(LAS bf16*)(Sb + pr * SP + (32 * (2 * dh + 1) + r32) * 2) = (bf16)f2bf(od1[r] + bias); }
            __syncthreads();
#pragma unroll
            for (int i = 0; i < 4; ++i) { const int pr = sr + 32 * i; const bf16x8 sv = *(const LAS bf16x8*)(Sb + pr * SP + sc * 2); const bf16x8 uu = us[i];
                v4u o; o.x = pk2(bf2f(uu[0]) * bf2f(sv[0]), bf2f(uu[1]) * bf2f(sv[1])); o.y = pk2(bf2f(uu[2]) * bf2f(sv[2]), bf2f(uu[3]) * bf2f(sv[3]));
                o.z = pk2(bf2f(uu[4]) * bf2f(sv[4]), bf2f(uu[5]) * bf2f(sv[5])); o.w = pk2(bf2f(uu[6]) * bf2f(sv[6]), bf2f(uu[7]) * bf2f(sv[7]));
                *(v4u*)(A2 + (size_t)(R0 + pr) * DM + c0 + sc) = o; }
        }
        __syncthreads();
    }
}

__device__ __forceinline__ void mla_thin_phase() {
    const Ctx C = make_ctx(); const Ptrs P = make_ptrs(); const int gw = C.gwl, NGW = C.NGWL, lane = C.lane, cls = C.cls, mem = C.mem;
    const bf16* ABF = (const bf16*)(P.ws + WS_ABF); bf16* QAN = (bf16*)(P.ws + WS_QAN); bf16* CKV = (bf16*)(P.ws + WS_CKV); bf16* KPE = (bf16*)(P.ws + WS_KPE); const float* rope = (const float*)(P.ws + WS_ROPE);
    const f32x4 gq0 = *(const f32x4*)(P.mla_g_q + lane * 8), gq1 = *(const f32x4*)(P.mla_g_q + lane * 8 + 4), gk0 = *(const f32x4*)(P.mla_g_kv + lane * 8), gk1 = *(const f32x4*)(P.mla_g_kv + lane * 8 + 4);
    for (int item = gw; item < GROWS + PAST / 2; item += NGW) {
        if (item < GROWS) { const int row = grow(cls, mem, item); const bf16* base = ABF + (size_t)row * 1280;
            const int dst = row < NPROMPT ? row : NPROMPT + ((row - NPROMPT) >> 11) * LKS + PAST + ((row - NPROMPT) & (SEQ_S - 1));
            { const bf16x8 x = *(const bf16x8*)(base + lane * 8); float f[8], ss = 0.f;
#pragma unroll
              for (int e = 0; e < 8; ++e) { f[e] = bf2f(x[e]); ss += f[e] * f[e]; }
              const float r = 1.0f / sqrtf(wave_sum(ss) * (1.f / 512) + EPS);
              v4u o; o.x = pk2(f[0] * r * gq0[0], f[1] * r * gq0[1]); o.y = pk2(f[2] * r * gq0[2], f[3] * r * gq0[3]); o.z = pk2(f[4] * r * gq1[0], f[5] * r * gq1[1]); o.w = pk2(f[6] * r * gq1[2], f[7] * r * gq1[3]);
              *(v4u*)(QAN + (size_t)row * 512 + lane * 8) = o; }
            { const bf16x8 x = *(const bf16x8*)(base + 512 + lane * 8); float f[8], ss = 0.f;
#pragma unroll
              for (int e = 0; e < 8; ++e) { f[e] = bf2f(x[e]); ss += f[e] * f[e]; }
              const float r = 1.0f / sqrtf(wave_sum(ss) * (1.f / 512) + EPS);
              f32x4 y0, y1;
#pragma unroll
              for (int e = 0; e < 4; ++e) { y0[e] = f[e] * r * gk0[e]; y1[e] = f[4 + e] * r * gk1[e]; }
              v4u o; o.x = pk2(y0[0], y0[1]); o.y = pk2(y0[2], y0[3]); o.z = pk2(y1[0], y1[1]); o.w = pk2(y1[2], y1[3]);
              *(v4u*)(CKV + (size_t)dst * 512 + lane * 8) = o;
              if (row < NPROMPT) { float* oc = P.out + OUT_CKV + (size_t)row * 512 + lane * 8; *(f32x4*)oc = y0; *(f32x4*)(oc + 4) = y1; } }
            { const float x = bf2f((short)base[1024 + lane]);
              if (row < NPROMPT) { P.out[OUT_KPE + (size_t)row * 64 + lane] = x; KPE[(size_t)dst * 64 + lane] = (bf16)f2bf(x); }
              else { const int t = (row - NPROMPT) & (SEQ_S - 1), w = lane & 31, j = w & 15, pos = (lane >> 5) ? (t & 63) : (t >> 6);
                  const float cs = rope[2 * (pos * 16 + j)], sn = rope[2 * (pos * 16 + j) + 1]; const float xo = __shfl_xor(x, 16);
                  const float y = (w >> 4) ? (xo * sn + x * cs) : (x * cs - xo * sn);
                  KPE[(size_t)dst * 64 + lane] = (bf16)f2bf(y); } }
        } else { const int cr = cls * PAST + mem * (PAST / 2) + (item - GROWS), b = cr >> 9, p = cr & (PAST - 1), dst = NPROMPT + b * LKS + p;
            const float* s = P.cache_ckv + (size_t)cr * 512 + lane * 8; const f32x4 a = *(const f32x4*)s, bb = *(const f32x4*)(s + 4);
            v4u o; o.x = pk2(a[0], a[1]); o.y = pk2(a[2], a[3]); o.z = pk2(bb[0], bb[1]); o.w = pk2(bb[2], bb[3]);
            *(v4u*)(CKV + (size_t)dst * 512 + lane * 8) = o;
            KPE[(size_t)dst * 64 + lane] = (bf16)f2bf(P.cache_kpe[(size_t)cr * 64 + lane]); }
    }
}

__device__ __forceinline__ void attn_phase(LAS unsigned char* lds) {
    const Ctx C = make_ctx(); const Ptrs P = make_ptrs(); const int c = C.li, cls = C.cls, mem = C.mem;
    const bf16* Q = (const bf16*)(P.ws + WS_Q); const bf16* KV = (const bf16*)(P.ws + WS_KV); const bf16* KPE = (const bf16*)(P.ws + WS_KPE); bf16* O = (bf16*)(P.ws + WS_A2); const float* rope = (const float*)(P.ws + WS_ROPE);
    for (int id = c; id < 128; id += SGSZ) {
        int h, qrow0, kvrow0, nkeys, rp, t0;
        if (id < 64) { const int qb = 4 * mem + (id & 3), b = cls; h = id >> 2;
            qrow0 = NPROMPT + b * SEQ_S + qb * 256; kvrow0 = NPROMPT + b * LKS; nkeys = LKS; rp = 1; t0 = qb * 256; }
        else { const int i2 = id - 64, b = 8 * cls + 4 * mem + (i2 >> 4); h = i2 & 15; qrow0 = b * 256; kvrow0 = b * 256; nkeys = 256; rp = 0; t0 = 0; }
        att::attn_unit(lds, Q + (size_t)qrow0 * att::LDQ + h * 192, KV + (size_t)kvrow0 * att::LDKV + h * 256, KPE + (size_t)kvrow0 * 64,
                       O + (size_t)qrow0 * att::LDO + h * 128, nkeys, rp, t0, rope);
    }
}

#ifndef G1_WGM
#define G1_WGM 4
#endif
#ifndef W1_WGM
#define W1_WGM 4
#endif
#ifndef W2_WGM
#define W2_WGM 4
#endif
#ifndef GEMM_ALIGN
#define GEMM_ALIGN 1
#endif
#ifndef GEMM_SP2
#define GEMM_SP2 1
#endif
#ifndef KREP_G1
#define KREP_G1 1
#endif
#ifndef KREP_G2
#define KREP_G2 1
#endif
#ifndef KREP_W1
#define KREP_W1 1
#endif
#ifndef KREP_W2
#define KREP_W2 1
#endif
#ifndef REP_P0
#define REP_P0 1
#endif
#ifndef REP_NORM
#define REP_NORM 1
#endif
#ifndef REP_G1
#define REP_G1 1
#endif
#ifndef REP_THIN
#define REP_THIN 1
#endif
#ifndef REP_QKV
#define REP_QKV 1
#endif
#ifndef REP_ATT
#define REP_ATT 1
#endif
#ifndef REP_G2
#define REP_G2 1
#endif
#ifndef REP_W1
#define REP_W1 1
#endif
#ifndef REP_W2
#define REP_W2 1
#endif
#ifndef EN_P0
#define EN_P0 1
#endif
#ifndef EN_NORM
#define EN_NORM 1
#endif
#ifndef EN_G1
#define EN_G1 1
#endif
#ifndef EN_THIN
#define EN_THIN 1
#endif
#ifndef EN_QKV
#define EN_QKV 1
#endif
#ifndef EN_ATT
#define EN_ATT 1
#endif
#ifndef EN_G2
#define EN_G2 1
#endif
#ifndef EN_W1
#define EN_W1 1
#endif
#ifndef EN_W2
#define EN_W2 1
#endif
__global__ void __launch_bounds__(NWAVES * 64, 2) mk_fwd(Args args) {
    extern __shared__ __attribute__((aligned(16))) unsigned char lds_raw[];
    LAS unsigned char* lds = (LAS unsigned char*)lds_raw;
    const int tid = threadIdx.x;
    unsigned char* ws0 = args.ws;
    const int x0 = (int)blockIdx.x & 7, cls0 = x0 >> 1, mem0 = x0 & 1, s0 = mem0;
    if (tid < 8) ((LAS unsigned*)(lds + MISC_OFF))[tid] = 0u;
    __syncthreads();
    XcdBarrier gbar = xcd_barrier_post((unsigned*)(ws0 + WS_CTL) + CW_BAR, (volatile LAS unsigned*)(lds + MISC_OFF), gridDim.x);
    XcdBarrier cbar = xcd_barrier_post((unsigned*)(ws0 + WS_CTL) + CW_BAR + (1 + cls0) * XCD_BAR_WORDS, (volatile LAS unsigned*)(lds + MISC_OFF + 8), 2 * SGSZ);
    XcdBarrier bar = xcd_barrier_post((unsigned*)(ws0 + WS_CTL) + CW_BAR + (5 + 2 * cls0 + mem0) * XCD_BAR_WORDS, (volatile LAS unsigned*)(lds + MISC_OFF + 16), SGSZ);
#define SEAM() xcd_barrier(bar)
#define CSEAM() xcd_barrier(cbar)

    if (EN_P0) {
_Pragma("unroll 1") for (int rep = 0; rep < REP_P0; ++rep) {
        p0a_phase(lds); xcd_barrier(gbar);
        p0b_phase(); xcd_barrier(gbar); } }
    if (GRP_DELAY_US > 0 && s0 > 0) {
        const unsigned long long t0 = __builtin_amdgcn_s_memrealtime(), dt = (unsigned long long)(GRP_DELAY_US) * 100ull;
        while (__builtin_amdgcn_s_memrealtime() - t0 < dt) __builtin_amdgcn_s_sleep(16);
    }

    for (int L = 0; L < NLAYER; ++L) {
        const int kind = L % 3, jl = L / 3;
        if (EN_NORM) {
_Pragma("unroll 1") for (int rep = 0; rep < REP_NORM; ++rep) { norm_phase(L, 0, L == 0); SEAM(); } }
        if (EN_G1) {
_Pragma("unroll 1") for (int rep = 0; rep < REP_G1; ++rep) {
            const Ctx C = make_ctx(); const Ptrs P = make_ptrs(); unsigned char* ws = P.ws;
            const bf16* Bt = kind == 0 ? (const bf16*)(ws + WS_CIN) + (size_t)jl * 6144 * DM : kind == 1 ? (const bf16*)(ws + WS_GIN) : (const bf16*)(ws + WS_MLA_A);
            const int N = kind == 0 ? 6144 : kind == 1 ? 4096 : 1280;
            pg8::Gemm g{(const bf16*)(ws + WS_H), Bt, NTOK, N, DM, KREP_G1}; pg8::GroupOrder S; S.init(8, N, SGSZ, C.li, G1_WGM, 4, 8 * C.cls + 4 * C.mem, 32 + 8 * C.cls + 4 * C.mem, 1);
            pg8::EpiBf16 E{(bf16*)(ws + (kind == 0 ? WS_U : kind == 1 ? WS_UV : WS_ABF)), kind == 0 ? 4096 : N, 0, 1.0f / KREP_G1, kind == 0};
            pg8::gemm_phase<pg8::EpiBf16, pg8::GroupOrder, GEMM_ALIGN, GEMM_SP2>(lds + RING_OFF, g, S, E);
            if (kind == 0) CSEAM(); else SEAM(); } }
        if (EN_THIN) {
_Pragma("unroll 1") for (int rep = 0; rep < REP_THIN; ++rep) {
            if (kind == 0) conv_elem_phase(jl);
            else if (kind == 1) gmlp_spatial_phase(lds + RING_OFF);
            else mla_thin_phase();
            SEAM(); } }
        if (kind == 2) {
            if (EN_QKV) {
_Pragma("unroll 1") for (int rep = 0; rep < REP_QKV; ++rep) {
                const Ctx C = make_ctx(); const Ptrs P = make_ptrs(); unsigned char* ws = P.ws;
                { pg8::Gemm g{(const bf16*)(ws + WS_QAN), (const bf16*)(ws + WS_QB), NTOK, 3072, 512, 1}; pg8::GroupOrder S; S.init(8, 3072, SGSZ, C.li, 8, 4, 8 * C.cls + 4 * C.mem, 32 + 8 * C.cls + 4 * C.mem, 1);
                  pg8::EpiBf16 E{(bf16*)(ws + WS_Q), 3072, 0, 1.0f, 0};
                  pg8::gemm_phase<pg8::EpiBf16, pg8::GroupOrder, GEMM_ALIGN, GEMM_SP2>(lds + RING_OFF, g, S, E); }
                { const int nkt = 9;
                  pg8::Gemm g{(const bf16*)(ws + WS_CKV), (const bf16*)(ws + WS_KVB), NKVROWS, 4096, 512, 1}; pg8::GroupOrder S; S.init(nkt, 4096, SGSZ, C.li, nkt, 4, 8 * C.cls + 4 * C.mem, 32 + 10 * C.cls + 2 + 4 * C.mem, 1, 8, 32 + 10 * C.cls + C.mem);
                  pg8::EpiBf16 E{(bf16*)(ws + WS_KV), 4096, 0, 1.0f, 0};
                  pg8::gemm_phase<pg8::EpiBf16, pg8::GroupOrder, GEMM_ALIGN, GEMM_SP2>(lds + RING_OFF, g, S, E); }
                CSEAM(); } }
            if (EN_ATT) {
_Pragma("unroll 1") for (int rep = 0; rep < REP_ATT; ++rep) { attn_phase(lds + RING_OFF); SEAM(); } }
        }
        if (EN_G2) {
_Pragma("unroll 1") for (int rep = 0; rep < REP_G2; ++rep) {
            const Ctx C = make_ctx(); const Ptrs P = make_ptrs(); unsigned char* ws = P.ws; const float* modf = (const float*)(ws + WS_MODF);
            const bf16* Bt = kind == 0 ? (const bf16*)(ws + WS_COUT) + (size_t)jl * DM * DM : kind == 1 ? (const bf16*)(ws + WS_GOUT) : (const bf16*)(ws + WS_WO);
            pg8::Gemm g{(const bf16*)(ws + WS_A2), Bt, NTOK, DM, DM, KREP_G2}; pg8::GroupOrder S; S.init(8, DM, SGSZ, C.li, W2_WGM, 4, 8 * C.cls + 4 * C.mem, 32 + 8 * C.cls + 4 * C.mem, 1);
            pg8::EpiRes E{(bf16*)(ws + WS_X), rep ? (const float*)(ws + WS_CTL) : modf + (size_t)L * 5 * MODROW + 2 * DM, DM, rep ? 0 : MODROW, 1.0f / KREP_G2, 0};
            pg8::gemm_phase<pg8::EpiRes, pg8::GroupOrder, GEMM_ALIGN, GEMM_SP2>(lds + RING_OFF, g, S, E);
            SEAM(); } }
        if (EN_NORM) {
_Pragma("unroll 1") for (int rep = 0; rep < REP_NORM; ++rep) { norm_phase(L, 1, false); SEAM(); } }
        if (EN_W1) {
_Pragma("unroll 1") for (int rep = 0; rep < REP_W1; ++rep) {
            const Ctx C = make_ctx(); const Ptrs P = make_ptrs(); unsigned char* ws = P.ws;
            pg8::Gemm g{(const bf16*)(ws + WS_H), (const bf16*)(ws + WS_W1) + (size_t)L * DFF * DM, NTOK, DFF, DM, KREP_W1}; pg8::GroupOrder S; S.init(8, DFF, SGSZ, C.li, W1_WGM, 4, 8 * C.cls + 4 * C.mem, 32 + 8 * C.cls + 4 * C.mem, 1);
            pg8::EpiBf16 E{(bf16*)(ws + WS_HID), DFF, 1, 1.0f / KREP_W1, 0};
            pg8::gemm_phase<pg8::EpiBf16, pg8::GroupOrder, GEMM_ALIGN, GEMM_SP2>(lds + RING_OFF, g, S, E);
            SEAM(); } }
        if (EN_W2) {
_Pragma("unroll 1") for (int rep = 0; rep < REP_W2; ++rep) {
            const Ctx C = make_ctx(); const Ptrs P = make_ptrs(); unsigned char* ws = P.ws; const float* modf = (const float*)(ws + WS_MODF);
            pg8::Gemm g{(const bf16*)(ws + WS_HID), (const bf16*)(ws + WS_W2) + (size_t)L * DM * DFF, NTOK, DM, DFF, KREP_W2}; pg8::GroupOrder S; S.init(8, DM, SGSZ, C.li, W2_WGM, 4, 8 * C.cls + 4 * C.mem, 32 + 8 * C.cls + 4 * C.mem, 1);
            pg8::EpiRes E{(bf16*)(ws + WS_X), rep ? (const float*)(ws + WS_CTL) : modf + (size_t)L * 5 * MODROW + 5 * DM, DM, rep ? 0 : MODROW, 1.0f / KREP_W2, 0};
            pg8::gemm_phase<pg8::EpiRes, pg8::GroupOrder, GEMM_ALIGN, GEMM_SP2>(lds + RING_OFF, g, S, E);
            SEAM(); } }
    }
    if (EN_NORM) final_norm_phase();
#undef SEAM
#undef CSEAM
}

extern "C" void kernel_launch(void* const* d_in, const int* in_sizes, int n_in, void* d_out, int out_size, void* d_ws, size_t ws_size, hipStream_t stream) {
    static int grid = 0;
    if (grid == 0) {
        if (n_in != 28 || in_sizes[0] != NPROMPT * DM || (size_t)out_size != OUT_END || ws_size < WS_END) {
            fprintf(stderr, "kernel_launch: built for 28 inputs, out of %zu floats, >= %zu bytes of workspace; got n_in %d, in0 %d, out %d, ws %zu; nothing launched\n", (size_t)OUT_END, (size_t)WS_END, n_in, n_in > 0 ? in_sizes[0] : -1, out_size, ws_size); grid = -1; return; }
        int dev = 0, cus = 0, per_cu = 0;
        if (hipGetDevice(&dev) != hipSuccess || hipDeviceGetAttribute(&cus, hipDeviceAttributeMultiprocessorCount, dev) != hipSuccess) { fprintf(stderr, "kernel_launch: device query failed\n"); grid = -1; return; }
        if (hipFuncSetAttribute((const void*)mk_fwd, hipFuncAttributeMaxDynamicSharedMemorySize, LDS_BYTES) != hipSuccess) { fprintf(stderr, "kernel_launch: hipFuncSetAttribute failed\n"); grid = -1; return; }
        if (hipOccupancyMaxActiveBlocksPerMultiprocessor(&per_cu, (const void*)mk_fwd, NWAVES * 64, LDS_BYTES) != hipSuccess || per_cu < 1)
            fprintf(stderr, "kernel_launch: note: the occupancy query reports %d workgroups per CU\n", per_cu);
        (void)hipGetLastError();
        if (cus < NSG * SGSZ) { fprintf(stderr, "kernel_launch: needs %d CUs (one resident workgroup each), device has %d; nothing launched\n", NSG * SGSZ, cus); grid = -1; return; }
        grid = NSG * SGSZ;
    }
    if (grid < 0) return;
    if (hipMemsetAsync((char*)d_ws + WS_CTL, 0, CTL_ZERO_BYTES, stream) != hipSuccess) { fprintf(stderr, "kernel_launch: hipMemsetAsync failed\n"); return; }
    Args a{};
    for (int i = 0; i < 28; ++i) a.in[i] = (const float*)d_in[i];
    a.out = (float*)d_out; a.ws = (unsigned char*)d_ws; a.ph_lo = 0; a.ph_hi = 0;
    hipLaunchKernelGGL(mk_fwd, dim3(grid), dim3(NWAVES * 64), LDS_BYTES, stream, a);
    const hipError_t le = hipPeekAtLastError();
    if (le != hipSuccess) fprintf(stderr, "kernel_launch: launch failed: %s\n", hipGetErrorName(le));
}
```
